# Optimizing an MI355X kernel written in HIP

```python
import math
import jax, jax.numpy as jnp
from jax import lax
import numpy as np

D_MODEL = 1024
BATCH = 8
SEQ = 2048
DEPTH = 1

D_MIX = D_MODEL
D_POOL = D_MIX // 2
POOL_WINDOWS = (2, 4, 8, 16)
N_POOL_GROUPS = len(POOL_WINDOWS)
POOL_GROUP = D_POOL // N_POOL_GROUPS
D_ATTN = D_MIX - D_POOL
HEAD_DIM = 64
N_HEADS = D_ATTN // HEAD_DIM
Q_BLOCK = 128
D_IN = D_POOL + 3 * D_ATTN + N_HEADS
N_EXPERTS = 64
N_EXPERT_GROUPS = 8
TOPK_GROUPS = 4
TOP_K = 8
D_EXPERT = 256
D_SHARED = 256
ROUTED_SCALE = 2.5
EXPERT_BLOCK = 128
EPS = 1e-6

kernel_name = 'hybrid_pool_fox_moe_block'


def rms_norm(x, g):
    xf = x.astype(jnp.float32)
    y = xf * lax.rsqrt(jnp.mean(xf * xf, axis=-1, keepdims=True) + EPS)
    return (y * g.astype(jnp.float32)).astype(x.dtype)


def modulate(h, shift, scale):
    return h * (1 + scale[:, None, :]) + shift[:, None, :]


def pool_mixer(u, w_pool, pool_scale):
    b, s, _ = u.shape
    ug = u.astype(jnp.float32).reshape(b, s, N_POOL_GROUPS, POOL_GROUP)
    cs = jnp.cumsum(ug, axis=1)
    pos = jnp.arange(1, s + 1, dtype=jnp.float32)
    outs = []
    for g, w in enumerate(POOL_WINDOWS):
        csg = cs[:, :, g]
        prev = jnp.pad(csg, ((0, 0), (w, 0), (0, 0)))[:, :s]
        mean = (csg - prev) / jnp.minimum(pos, float(w))[None, :, None]
        outs.append(mean - ug[:, :, g])
    pooled = jnp.stack(outs, axis=2).astype(u.dtype)
    y = jnp.einsum('bsgc,gcd->bsgd', pooled, w_pool)
    return y.reshape(b, s, D_POOL) * pool_scale


def fox_attention(q, k, v, logf):
    b, s, h, dh = q.shape
    cum = jnp.cumsum(logf.astype(jnp.float32), axis=1).transpose(0, 2, 1)
    qh = q.transpose(0, 2, 1, 3)
    kh = k.transpose(0, 2, 1, 3)
    vh = v.transpose(0, 2, 1, 3)
    scale = HEAD_DIM ** -0.5
    outs = []
    for i in range(s // Q_BLOCK):
        q0, q1 = i * Q_BLOCK, (i + 1) * Q_BLOCK
        qb, kb, vb = qh[:, :, q0:q1], kh[:, :, :q1], vh[:, :, :q1]
        logits = jnp.einsum('bhqd,bhkd->bhqk', qb, kb).astype(jnp.float32) * scale
        logits = logits + cum[:, :, q0:q1, None] - cum[:, :, None, :q1]
        causal = jnp.arange(q0, q1)[:, None] >= jnp.arange(q1)[None, :]
        logits = jnp.where(causal[None, None], logits, -jnp.inf)
        p = jax.nn.softmax(logits, axis=-1)
        outs.append(jnp.einsum('bhqk,bhkd->bhqd', p.astype(vb.dtype), vb))
    o = jnp.concatenate(outs, axis=2)
    return o.transpose(0, 2, 1, 3).reshape(b, s, h * dh)


def swiglu(x, wg, wu, wd):
    return (jax.nn.silu(x @ wg) * (x @ wu)) @ wd


def moe_ffn(h, w_router, router_bias, w_gate, w_up, w_down, ws_gate, ws_up, ws_down):
    b, s, d = h.shape
    t = b * s
    xf = h.reshape(t, d)
    scores = jax.nn.sigmoid((xf @ w_router).astype(jnp.float32))
    sel = scores + router_bias.astype(jnp.float32)
    grp = sel.reshape(t, N_EXPERT_GROUPS, N_EXPERTS // N_EXPERT_GROUPS)
    group_score = lax.top_k(grp, 2)[0].sum(-1)
    _, top_groups = lax.top_k(group_score, TOPK_GROUPS)
    group_mask = jnp.any(top_groups[:, :, None] == jnp.arange(N_EXPERT_GROUPS)[None, None, :], axis=1)
    expert_mask = jnp.repeat(group_mask, N_EXPERTS // N_EXPERT_GROUPS, axis=1)
    _, idx = lax.top_k(jnp.where(expert_mask, sel, -jnp.inf), TOP_K)
    wts = jnp.take_along_axis(scores, idx, axis=1)
    wts = wts / jnp.sum(wts, axis=-1, keepdims=True) * ROUTED_SCALE
    a = t * TOP_K
    flat_e = idx.reshape(a)
    flat_tok = jnp.arange(a, dtype=jnp.int32) // TOP_K
    flat_w = wts.reshape(a)
    order = jnp.argsort(flat_e, stable=True)
    sorted_e = flat_e[order]
    counts = jnp.zeros((N_EXPERTS,), jnp.int32).at[flat_e].add(1)
    start = jnp.cumsum(counts) - counts
    padded = (counts + EXPERT_BLOCK - 1) // EXPERT_BLOCK * EXPERT_BLOCK
    pend = jnp.cumsum(padded)
    pstart = pend - padded
    dest = pstart[sorted_e] + (jnp.arange(a, dtype=jnp.int32) - start[sorted_e])
    n_blocks = -(-a // EXPERT_BLOCK) + N_EXPERTS
    p = n_blocks * EXPERT_BLOCK
    slot_tok = jnp.full((p,), t, jnp.int32).at[dest].set(flat_tok[order])
    slot_w = jnp.zeros((p,), jnp.float32).at[dest].set(flat_w[order])
    block_start = jnp.arange(n_blocks, dtype=jnp.int32) * EXPERT_BLOCK
    block_expert = jnp.clip(jnp.searchsorted(pend, block_start, side='right'), 0, N_EXPERTS - 1)
    x_pad = jnp.concatenate([xf, jnp.zeros((1, d), xf.dtype)], axis=0)

    def expert_block(args):
        tok, e, wt = args
        xb = x_pad[tok]
        yb = swiglu(xb, w_gate[e], w_up[e], w_down[e])
        return yb * wt[:, None].astype(yb.dtype)

    yb = lax.map(expert_block, (slot_tok.reshape(n_blocks, EXPERT_BLOCK), block_expert,
                                slot_w.reshape(n_blocks, EXPERT_BLOCK)))
    routed = jax.ops.segment_sum(yb.reshape(p, d), slot_tok, num_segments=t + 1)[:t]
    shared = swiglu(xf, ws_gate, ws_up, ws_down)
    return (routed + shared).reshape(b, s, d)


def setup_inputs(seed: int = 0) -> dict:
    key = jax.random.key(seed)
    ks = jax.random.split(key, 24)
    f32 = jnp.float32

    def nrm(k, shape, scale):
        return jax.random.normal(k, shape, f32) * scale

    def gain(k, n):
        return 1.0 + 0.05 * jax.random.normal(k, (DEPTH, n), f32)

    return {
        'x': nrm(ks[0], (BATCH, SEQ, D_MODEL), 1.0),
        'c': nrm(ks[1], (BATCH, D_MODEL), 1.0),
        'w_ada': nrm(ks[2], (DEPTH, D_MODEL, 6 * D_MODEL), 0.5 * D_MODEL ** -0.5),
        'b_ada': nrm(ks[3], (DEPTH, 6 * D_MODEL), 0.02),
        'g_pre_mix': gain(ks[4], D_MODEL),
        'g_post_mix': gain(ks[5], D_MODEL),
        'g_pre_ffn': gain(ks[6], D_MODEL),
        'g_post_ffn': gain(ks[7], D_MODEL),
        'w_in': nrm(ks[8], (DEPTH, D_MODEL, D_IN), D_MODEL ** -0.5),
        'b_forget': jax.random.uniform(ks[9], (DEPTH, N_HEADS), f32, 1.0, 5.0),
        'w_pool': nrm(ks[10], (DEPTH, N_POOL_GROUPS, POOL_GROUP, POOL_GROUP), POOL_GROUP ** -0.5),
        'pool_scale': gain(ks[11], D_POOL) + 0.05 * jax.random.normal(ks[12], (DEPTH, D_POOL), f32),
        'g_pool_out': gain(ks[13], D_POOL),
        'g_attn_out': gain(ks[14], D_ATTN),
        'w_out': nrm(ks[15], (DEPTH, D_MIX, D_MODEL), D_MIX ** -0.5),
        'w_router': nrm(ks[16], (DEPTH, D_MODEL, N_EXPERTS), D_MODEL ** -0.5),
        'router_bias': nrm(ks[17], (DEPTH, N_EXPERTS), 0.01),
        'w_gate': nrm(ks[18], (DEPTH, N_EXPERTS, D_MODEL, D_EXPERT), D_MODEL ** -0.5),
        'w_up': nrm(ks[19], (DEPTH, N_EXPERTS, D_MODEL, D_EXPERT), D_MODEL ** -0.5),
        'w_down': nrm(ks[20], (DEPTH, N_EXPERTS, D_EXPERT, D_MODEL), D_EXPERT ** -0.5),
        'ws_gate': nrm(ks[21], (DEPTH, D_MODEL, D_SHARED), D_MODEL ** -0.5),
        'ws_up': nrm(ks[22], (DEPTH, D_MODEL, D_SHARED), D_MODEL ** -0.5),
        'ws_down': nrm(ks[23], (DEPTH, D_SHARED, D_MODEL), D_SHARED ** -0.5),
    }


def reference(x, c, w_ada, b_ada, g_pre_mix, g_post_mix, g_pre_ffn, g_post_ffn, w_in, b_forget,
              w_pool, pool_scale, g_pool_out, g_attn_out, w_out, w_router, router_bias,
              w_gate, w_up, w_down, ws_gate, ws_up, ws_down):
    b, s, _ = x.shape
    for l in range(DEPTH):
        mod = c @ w_ada[l] + b_ada[l]
        shift_m, scale_m, gate_m, shift_f, scale_f, gate_f = jnp.split(mod, 6, axis=-1)

        h = modulate(rms_norm(x, g_pre_mix[l]), shift_m, scale_m)
        proj = h @ w_in[l]
        u = proj[..., :D_POOL]
        q = proj[..., D_POOL:D_POOL + D_ATTN].reshape(b, s, N_HEADS, HEAD_DIM)
        k = proj[..., D_POOL + D_ATTN:D_POOL + 2 * D_ATTN].reshape(b, s, N_HEADS, HEAD_DIM)
        v = proj[..., D_POOL + 2 * D_ATTN:D_POOL + 3 * D_ATTN].reshape(b, s, N_HEADS, HEAD_DIM)
        logf = jax.nn.log_sigmoid((proj[..., D_POOL + 3 * D_ATTN:] + b_forget[l]).astype(jnp.float32))
        y_pool = pool_mixer(u, w_pool[l], pool_scale[l])
        y_attn = fox_attention(q, k, v, logf)
        mixed = jnp.concatenate([rms_norm(y_pool, g_pool_out[l]), rms_norm(y_attn, g_attn_out[l])], axis=-1)
        mixed = mixed @ w_out[l]
        x = x + gate_m[:, None, :] * rms_norm(mixed, g_post_mix[l])

        h2 = modulate(rms_norm(x, g_pre_ffn[l]), shift_f, scale_f)
        ff = moe_ffn(h2, w_router[l], router_bias[l], w_gate[l], w_up[l], w_down[l],
                     ws_gate[l], ws_up[l], ws_down[l])
        x = x + gate_f[:, None, :] * rms_norm(ff, g_post_ffn[l])
    return x
```

```cpp
#include <hip/hip_runtime.h>
#include <cstdio>
#include <cstdint>
namespace nv {
constexpr int T = 16384, D = 1024, S = 2048, B = 8, DIN = 2056, NH = 8, HD = 64, NE = 64;
constexpr float EPS = 1e-6f;

__global__ void k_mod(const float* c, const float* w_ada, const float* b_ada, float* mod) {
    const int j = blockIdx.x * 256 + threadIdx.x, b = blockIdx.y;
    float s = b_ada[j];
    for (int k = 0; k < D; ++k) s += c[b * D + k] * w_ada[(size_t)k * 6144 + j];
    mod[b * 6144 + j] = s;
}
__device__ __forceinline__ float block_sum256(float v, float* red) {
    for (int o = 32; o > 0; o >>= 1) v += __shfl_xor(v, o);
    __syncthreads();
    if ((threadIdx.x & 63) == 0) red[threadIdx.x >> 6] = v;
    __syncthreads();
    return red[0] + red[1] + red[2] + red[3];
}
__global__ void k_norm_mod(const float* in, const float* g, const float* mod, int shift_off, int scale_off, float* out) {
    __shared__ float red[4];
    const int t = blockIdx.x, b = t / S;
    float v[4], ss = 0.f;
    for (int i = 0; i < 4; ++i) { v[i] = in[(size_t)t * D + threadIdx.x + 256 * i]; ss += v[i] * v[i]; }
    ss = block_sum256(ss, red);
    const float r = rsqrtf(ss / D + EPS);
    for (int i = 0; i < 4; ++i) { const int c = threadIdx.x + 256 * i;
        out[(size_t)t * D + c] = v[i] * r * g[c] * (1.f + mod[b * 6144 + scale_off + c]) + mod[b * 6144 + shift_off + c]; }
}
__global__ void k_gemm(const float* A, int lda, const float* Bm, int ldb, float* C, int ldc, int M, int N, int K) {
    __shared__ float sA[16][65], sB[16][65];
    const int tx = threadIdx.x & 15, ty = threadIdx.x >> 4, m0 = blockIdx.y * 64, n0 = blockIdx.x * 64;
    float acc[4][4] = {};
    for (int k0 = 0; k0 < K; k0 += 16) {
        for (int i = threadIdx.x; i < 1024; i += 256) { const int r = i >> 4, kk = i & 15; sA[kk][r] = (m0 + r < M) ? A[(size_t)(m0 + r) * lda + k0 + kk] : 0.f; }
        for (int i = threadIdx.x; i < 1024; i += 256) { const int kk = i >> 6, cc = i & 63; sB[kk][cc] = (n0 + cc < N) ? Bm[(size_t)(k0 + kk) * ldb + n0 + cc] : 0.f; }
        __syncthreads();
        for (int kk = 0; kk < 16; ++kk) { float a[4], b[4];
            for (int i = 0; i < 4; ++i) { a[i] = sA[kk][ty * 4 + i]; b[i] = sB[kk][tx * 4 + i]; }
            for (int i = 0; i < 4; ++i) for (int j = 0; j < 4; ++j) acc[i][j] += a[i] * b[j]; }
        __syncthreads();
    }
    for (int i = 0; i < 4; ++i) for (int j = 0; j < 4; ++j) { const int m = m0 + ty * 4 + i, n = n0 + tx * 4 + j; if (m < M && n < N) C[(size_t)m * ldc + n] = acc[i][j]; }
}
__global__ void k_cum(const float* proj, const float* b_forget, float* cum) {
    const int i = threadIdx.x; if (i >= B * NH) return; const int b = i / NH, h = i % NH;
    float s = 0.f;
    for (int t = 0; t < S; ++t) { const float v = proj[(size_t)(b * S + t) * DIN + 2048 + h] + b_forget[h];
        const float lf = fminf(v, 0.f) - log1pf(expf(-fabsf(v))); s += lf; cum[(size_t)i * S + t] = s; }
}
__global__ void k_pool(const float* proj, float* pooled) {
    const int t = blockIdx.x, tl = t % S;
    for (int c = threadIdx.x; c < 512; c += 256) { const int g = c >> 7, w = 2 << g; const int n = (tl + 1 < w) ? tl + 1 : w;
        float s = 0.f; for (int i = 0; i < n; ++i) s += proj[(size_t)(t - i) * DIN + c];
        pooled[(size_t)t * 512 + c] = s / (float)n - proj[(size_t)t * DIN + c]; }
}
__global__ void __launch_bounds__(64) k_attn(const float* proj, const float* cum, float* ycat  ) {
    const int tl = blockIdx.x * 64 + threadIdx.x, h = blockIdx.y, b = blockIdx.z; const size_t t = (size_t)b * S + tl;
    float q[64], o[64];
#pragma unroll
    for (int d = 0; d < 64; ++d) { q[d] = proj[t * DIN + 512 + h * 64 + d] * 0.125f; o[d] = 0.f; }
    const float* cm = cum + (size_t)(b * NH + h) * S; const float cq = cm[tl];
    float m = -INFINITY, l = 0.f;
    for (int k = 0; k <= tl; ++k) { const float* kr = proj + ((size_t)b * S + k) * DIN + 1024 + h * 64; const float* vr = kr + 512;
        float s = 0.f;
#pragma unroll
        for (int d = 0; d < 64; ++d) s += q[d] * kr[d];
        s += cq - cm[k];
        const float mn = fmaxf(m, s), al = expf(m - mn), p = expf(s - mn);
        l = l * al + p;
#pragma unroll
        for (int d = 0; d < 64; ++d) o[d] = o[d] * al + p * vr[d];
        m = mn; }
#pragma unroll
    for (int d = 0; d < 64; ++d) ycat[t * D + 512 + h * 64 + d] = o[d] / l;
}
__global__ void k_mixnorm(float* ycat, const float* pool_scale, const float* g_pool, const float* g_attn) {
    __shared__ float red[4];
    const int t = blockIdx.x; float v[4], s0 = 0.f, s1 = 0.f;
    for (int i = 0; i < 4; ++i) { const int c = threadIdx.x + 256 * i; v[i] = ycat[(size_t)t * D + c]; if (c < 512) { v[i] *= pool_scale[c]; s0 += v[i] * v[i]; } else s1 += v[i] * v[i]; }
    s0 = block_sum256(s0, red); s1 = block_sum256(s1, red);
    const float r0 = rsqrtf(s0 / 512.f + EPS), r1 = rsqrtf(s1 / 512.f + EPS);
    for (int i = 0; i < 4; ++i) { const int c = threadIdx.x + 256 * i; ycat[(size_t)t * D + c] = (c < 512) ? v[i] * r0 * g_pool[c] : v[i] * r1 * g_attn[c - 512]; }
}
__global__ void k_resid(const float* base, const float* y, const float* g, const float* mod, int gate_off, float* out) {
    __shared__ float red[4];
    const int t = blockIdx.x, b = t / S; float v[4], ss = 0.f;
    for (int i = 0; i < 4; ++i) { v[i] = y[(size_t)t * D + threadIdx.x + 256 * i]; ss += v[i] * v[i]; }
    ss = block_sum256(ss, red); const float r = rsqrtf(ss / D + EPS);
    for (int i = 0; i < 4; ++i) { const int c = threadIdx.x + 256 * i; out[(size_t)t * D + c] = base[(size_t)t * D + c] + mod[b * 6144 + gate_off + c] * v[i] * r * g[c]; }
}
__global__ void k_route(const float* logits, const float* rbias, int* idx, float* wts) {
    __shared__ float sc[64][65], sel[64][65];
    const int x = threadIdx.x, t = blockIdx.x * 64 + x;
    for (int e = 0; e < 64; ++e) { const float s = 1.f / (1.f + expf(-logits[(size_t)t * 64 + e])); sc[e][x] = s; sel[e][x] = s + rbias[e]; }
    unsigned gmask = 0u;
    float gs[8];
#pragma unroll
    for (int g = 0; g < 8; ++g) { float a = -INFINITY, b2 = -INFINITY; for (int j = 0; j < 8; ++j) { const float v = sel[g * 8 + j][x]; if (v > a) { b2 = a; a = v; } else if (v > b2) b2 = v; } gs[g] = a + b2; }
    for (int it = 0; it < 4; ++it) { int bi = 0; float bv = -INFINITY;
#pragma unroll
        for (int g = 0; g < 8; ++g) if (!((gmask >> g) & 1u) && gs[g] > bv) { bv = gs[g]; bi = g; }
        gmask |= 1u << bi; }
    unsigned long long used = 0ull; float wsum = 0.f;
    for (int it = 0; it < 8; ++it) { int bi = 0; float bv = -INFINITY;
        for (int e = 0; e < 64; ++e) if (((gmask >> (e >> 3)) & 1u) && !((used >> e) & 1ull) && sel[e][x] > bv) { bv = sel[e][x]; bi = e; }
        used |= 1ull << bi; idx[t * 8 + it] = bi; wsum += sc[bi][x]; }
    for (int it = 0; it < 8; ++it) { const int e = idx[t * 8 + it]; wts[t * 8 + it] = sc[e][x] / wsum * 2.5f; }
}
__global__ void k_moe(const float* h2, const int* idx, const float* wts, const float* w_gate, const float* w_up, const float* w_down,
                      const float* ws_gate, const float* ws_up, const float* ws_down, const float* x1, const float* g, const float* mod, float* out) {
    __shared__ float sh[1024], hid[256], red[4];
    const int t = blockIdx.x, b = t / S, j = threadIdx.x;
    for (int i = 0; i < 4; ++i) sh[j + 256 * i] = h2[(size_t)t * D + j + 256 * i];
    __syncthreads();
    float ff[4] = {0.f, 0.f, 0.f, 0.f};
    for (int s = 0; s < 9; ++s) {
        const float* wg; const float* wu; const float* wd; float w;
        if (s < 8) { const int e = idx[t * 8 + s]; w = wts[t * 8 + s]; wg = w_gate + (size_t)e * D * 256; wu = w_up + (size_t)e * D * 256; wd = w_down + (size_t)e * 256 * D; }
        else { w = 1.f; wg = ws_gate; wu = ws_up; wd = ws_down; }
        float a = 0.f, u = 0.f;
        for (int k = 0; k < D; ++k) { a += sh[k] * wg[(size_t)k * 256 + j]; u += sh[k] * wu[(size_t)k * 256 + j]; }
        __syncthreads();
        hid[j] = a / (1.f + expf(-a)) * u;
        __syncthreads();
        for (int i = 0; i < 4; ++i) { float y = 0.f; for (int k = 0; k < 256; ++k) y += hid[k] * wd[(size_t)k * D + j + 256 * i]; ff[i] += w * y; }
    }
    float ss = 0.f; for (int i = 0; i < 4; ++i) ss += ff[i] * ff[i];
    ss = block_sum256(ss, red); const float r = rsqrtf(ss / D + EPS);
    for (int i = 0; i < 4; ++i) { const int c = j + 256 * i; out[(size_t)t * D + c] = x1[(size_t)t * D + c] + mod[b * 6144 + 5 * 1024 + c] * ff[i] * r * g[c]; }
}

enum { I_X = 0, I_C, I_WADA, I_BADA, I_GPREMIX, I_GPOSTMIX, I_GPREFFN, I_GPOSTFFN, I_WIN, I_BFORGET, I_WPOOL, I_POOLSCALE, I_GPOOLOUT, I_GATTNOUT, I_WOUT,
       I_WROUTER, I_RBIAS, I_WGATE, I_WUP, I_WDOWN, I_WSGATE, I_WSUP, I_WSDOWN };

static void forward(void* const* d_in, float* out, float* ws, hipStream_t st) {
    auto in = [&](int i) { return (const float*)d_in[i]; };
    float* mod = ws; float* cum = mod + 8 * 6144; int* idx = (int*)(cum + B * NH * S); float* wts = (float*)(idx + T * 8); float* logits = wts + T * 8;
    float* bufA = logits + (size_t)T * 64; float* bufB = bufA + (size_t)T * D; float* bufC = bufB + (size_t)T * DIN;
    k_mod<<<dim3(24, 8), 256, 0, st>>>(in(I_C), in(I_WADA), in(I_BADA), mod);
    k_norm_mod<<<T, 256, 0, st>>>(in(I_X), in(I_GPREMIX), mod, 0, 1024, bufA);
    k_gemm<<<dim3((DIN + 63) / 64, T / 64), 256, 0, st>>>(bufA, D, in(I_WIN), DIN, bufB, DIN, T, DIN, D);
    k_cum<<<1, 64, 0, st>>>(bufB, in(I_BFORGET), cum);
    k_pool<<<T, 256, 0, st>>>(bufB, bufA);
    for (int g = 0; g < 4; ++g)
        k_gemm<<<dim3(2, T / 64), 256, 0, st>>>(bufA + g * 128, 512, in(I_WPOOL) + (size_t)g * 128 * 128, 128, bufC + g * 128, D, T, 128, 128);
    k_attn<<<dim3(S / 64, NH, B), 64, 0, st>>>(bufB, cum, bufC);
    k_mixnorm<<<T, 256, 0, st>>>(bufC, in(I_POOLSCALE), in(I_GPOOLOUT), in(I_GATTNOUT));
    k_gemm<<<dim3(D / 64, T / 64), 256, 0, st>>>(bufC, D, in(I_WOUT), D, bufA, D, T, D, D);
    k_resid<<<T, 256, 0, st>>>(in(I_X), bufA, in(I_GPOSTMIX), mod, 2048, out);
    k_norm_mod<<<T, 256, 0, st>>>(out, in(I_GPREFFN), mod, 3072, 4096, bufA);
    k_gemm<<<dim3(1, T / 64), 256, 0, st>>>(bufA, D, in(I_WROUTER), 64, logits, 64, T, 64, D);
    k_route<<<T / 64, 64, 0, st>>>(logits, in(I_RBIAS), idx, wts);
    k_moe<<<T, 256, 0, st>>>(bufA, idx, wts, in(I_WGATE), in(I_WUP), in(I_WDOWN), in(I_WSGATE), in(I_WSUP), in(I_WSDOWN), out, in(I_GPOSTFFN), mod, out);
}
}

extern "C" void kernel_launch(void* const* d_in, const int* in_sizes, int n_in, void* d_out, int out_size, void* d_ws, size_t ws_size, hipStream_t stream) {
    nv::forward(d_in, (float*)d_out, (float*)d_ws, stream);
}
```

```cpp
#include <hip/hip_runtime.h>
#include <cstdio>
#include <cstdint>
#include <cmath>
#include <hip/hip_bf16.h>
#define MK_NPHASES_DONE 11
namespace pg8 {
#define PG8_LAS __attribute__((address_space(3)))
typedef unsigned short bf16_t;
typedef short bf16x8 __attribute__((ext_vector_type(8)));
typedef float f32x4 __attribute__((ext_vector_type(4)));
typedef unsigned u32x4 __attribute__((ext_vector_type(4)));
typedef unsigned u32x2 __attribute__((ext_vector_type(2)));
constexpr int BM = 256, BK = 64, HALF = 128, HTB = HALF * BK * 2, STAGE_BYTES = 8 * HTB;

__host__ __device__ __forceinline__ int lds_byte(int r, int c) { const int st = (r >> 4) * 2 + (c >> 5), rr = r & 15, cc = c & 31, ob = rr * 64 + cc * 2; return st * 1024 + (ob ^ (((ob >> 9) & 1) << 5)); }
__host__ __device__ __forceinline__ void stage_rc(int b, int& R, int& C) { const int st = b / 1024, sb = b % 1024, swz = sb ^ (((sb >> 9) & 1) << 5); R = (st >> 1) * 16 + swz / 64; C = (st & 1) * 32 + (swz % 64) / 2; }
__host__ __device__ __forceinline__ int perm32(int rho) { const int n = rho >> 4, i = rho & 15; return 8 * (i >> 2) + 4 * n + (i & 3); }

struct Unit { const char* A; const char* B; int tab; int orow; int ocol; int aux; };
struct UnitRec { unsigned long long A, B; int tab, orow, ocol, aux; };
struct ListSched {
    const PG8_LAS UnitRec* list; int n;
    __device__ __forceinline__ bool next(int i, Unit& u) const {
        if (i >= n) return false;
        const PG8_LAS UnitRec* r = list + i;
        const unsigned long long a = r->A, b = r->B;
        const unsigned alo = __builtin_amdgcn_readfirstlane((unsigned)a), ahi = __builtin_amdgcn_readfirstlane((unsigned)(a >> 32));
        const unsigned blo = __builtin_amdgcn_readfirstlane((unsigned)b), bhi = __builtin_amdgcn_readfirstlane((unsigned)(b >> 32));
        u.A = (const char*)(((unsigned long long)ahi << 32) | alo); u.B = (const char*)(((unsigned long long)bhi << 32) | blo);
        u.tab = __builtin_amdgcn_readfirstlane(r->tab); u.orow = __builtin_amdgcn_readfirstlane(r->orow); u.ocol = __builtin_amdgcn_readfirstlane(r->ocol); u.aux = __builtin_amdgcn_readfirstlane(r->aux);
        return true;
    }
};
struct NoHook { __device__ __forceinline__ void at(int, f32x4 (&)[2][2][4][2], int, int, int) const {} };

__device__ __forceinline__ unsigned cvt_pk_bf16(float lo, float hi) { unsigned r; asm volatile("v_cvt_pk_bf16_f32 %0, %1, %2" : "=v"(r) : "v"(lo), "v"(hi)); return r; }

struct EpiBf16 {
    static constexpr bool PERM = true;
    bf16_t* O; int ldc;
    __device__ __forceinline__ void operator()(const f32x4 (&acc)[2][2][4][2], const Unit& u, int wr, int wc, int fr, int fq) const {
        const int row0 = u.orow + wr * 64 + fr, col0 = u.ocol + wc * 32 + 8 * fq;
#pragma unroll
        for (int ai = 0; ai < 2; ++ai)
#pragma unroll
            for (int m = 0; m < 4; ++m) { bf16_t* rowp = O + (size_t)(row0 + ai * HALF + m * 16) * ldc + col0;
#pragma unroll
                for (int bj = 0; bj < 2; ++bj) { const f32x4 v0 = acc[ai][bj][m][0], v1 = acc[ai][bj][m][1];
                    u32x4 w; w.x = cvt_pk_bf16(v0[0], v0[1]); w.y = cvt_pk_bf16(v0[2], v0[3]); w.z = cvt_pk_bf16(v1[0], v1[1]); w.w = cvt_pk_bf16(v1[2], v1[3]);
                    *(u32x4*)(rowp + bj * HALF) = w; } }
    }
};
struct EpiRowScaleBf16 {
    static constexpr bool PERM = true;
    bf16_t* O; int ldc; const PG8_LAS float* rs;
    __device__ __forceinline__ void operator()(const f32x4 (&acc)[2][2][4][2], const Unit& u, int wr, int wc, int fr, int fq) const {
        const int row0 = u.orow + wr * 64 + fr, col0 = u.ocol + wc * 32 + 8 * fq;
#pragma unroll
        for (int ai = 0; ai < 2; ++ai)
#pragma unroll
            for (int m = 0; m < 4; ++m) { bf16_t* rowp = O + (size_t)(row0 + ai * HALF + m * 16) * ldc + col0; const float s = rs[ai * HALF + wr * 64 + m * 16 + fr];
#pragma unroll
                for (int bj = 0; bj < 2; ++bj) { const f32x4 v0 = acc[ai][bj][m][0] * s, v1 = acc[ai][bj][m][1] * s;
                    u32x4 w; w.x = cvt_pk_bf16(v0[0], v0[1]); w.y = cvt_pk_bf16(v0[2], v0[3]); w.z = cvt_pk_bf16(v1[0], v1[1]); w.w = cvt_pk_bf16(v1[2], v1[3]);
                    *(u32x4*)(rowp + bj * HALF) = w; } }
    }
};
__device__ __forceinline__ float silu_mul(float g, float u) { return g * u * __builtin_amdgcn_rcpf(1.0f + __builtin_amdgcn_exp2f(-1.4426950408889634f * g)); }
struct EpiSwiglu {
    static constexpr bool PERM = true;
    bf16_t* O; int ldc;
    __device__ __forceinline__ void operator()(const f32x4 (&acc)[2][2][4][2], const Unit& u, int wr, int wc, int fr, int fq) const {
        const int row0 = u.orow + wr * 64 + fr, col0 = u.ocol + wc * 32 + 8 * fq;
#pragma unroll
        for (int ai = 0; ai < 2; ++ai)
#pragma unroll
            for (int m = 0; m < 4; ++m) { bf16_t* rowp = O + (size_t)(row0 + ai * HALF + m * 16) * ldc + col0;
                const f32x4 g0 = acc[ai][0][m][0], g1 = acc[ai][0][m][1], u0 = acc[ai][1][m][0], u1 = acc[ai][1][m][1];
                u32x4 w; w.x = cvt_pk_bf16(silu_mul(g0[0], u0[0]), silu_mul(g0[1], u0[1])); w.y = cvt_pk_bf16(silu_mul(g0[2], u0[2]), silu_mul(g0[3], u0[3]));
                w.z = cvt_pk_bf16(silu_mul(g1[0], u1[0]), silu_mul(g1[1], u1[1])); w.w = cvt_pk_bf16(silu_mul(g1[2], u1[2]), silu_mul(g1[3], u1[3]));
                *(u32x4*)rowp = w; }
    }
};

template <class Epi, class Sched, bool GATHER, class Hook>
__device__ __forceinline__ void gemm_phase(PG8_LAS unsigned char* lds, const int K, const Sched& S, const Epi& E, const Hook& H) {
    const int tid = threadIdx.x, wid = __builtin_amdgcn_readfirstlane(tid >> 6), lane = tid & 63, wr = wid >> 2, wc = wid & 3, fr = lane & 15, fq = lane >> 4;
    const int nt = K / BK;
    unsigned voffB[2];
#pragma unroll
    for (int i = 0; i < 2; ++i) { int R, C; stage_rc(tid * 16 + i * 8192, R, C); const int Rb = Epi::PERM ? ((R & ~31) + perm32(R & 31)) : R; voffB[i] = (unsigned)(Rb * K + C) * 2u; }
    const size_t kstep = (size_t)(BK * 2);
    const size_t hstep = (size_t)HALF * K * 2;
    const unsigned ldsw = (unsigned)wid * 1024u;
    const int aoff = lds_byte(wr * 64 + fr, fq * 8), boff = lds_byte(wc * 32 + fr, fq * 8);
    unsigned offC[2][2];
#define PG8_LOADOFF(dst, u) do { _Pragma("unroll") for (int _i = 0; _i < 2; ++_i) { int _R, _C; stage_rc(tid * 16 + _i * 8192, _R, _C); _Pragma("unroll") for (int _h = 0; _h < 2; ++_h) { \
        if constexpr (GATHER) { const unsigned _row = *(const PG8_LAS unsigned*)(lds + (u).tab + 4 * (_h * HALF + _R)); dst[_h][_i] = _row * (unsigned)(K * 2) + (unsigned)(_C * 2); } \
        else dst[_h][_i] = (unsigned)((_h * HALF + _R) * K + _C) * 2u; } } } while (0)
#define PG8_SA(b, h) (((b) * 2 + (h)) * HTB)
#define PG8_SB(b, h) ((4 + (b) * 2 + (h)) * HTB)
#define PG8_STAGE(bufoff, gbase, voff) do { _Pragma("unroll") for (int _i = 0; _i < 2; ++_i) \
        __builtin_amdgcn_global_load_lds((const unsigned*)((const char*)(gbase) + (voff)[_i]), (PG8_LAS unsigned*)(lds + (bufoff) + ldsw + _i * 8192), 16, 0, 0); } while (0)
#define PG8_LDA(dst, b, h) do { _Pragma("unroll") for (int m = 0; m < 4; ++m) _Pragma("unroll") for (int k = 0; k < 2; ++k) dst[m][k] = *(const PG8_LAS bf16x8*)(lds + PG8_SA(b, h) + aoff + m * 2048 + k * 1024); } while (0)
#define PG8_LDB(dst, b, h) do { _Pragma("unroll") for (int n = 0; n < 2; ++n) _Pragma("unroll") for (int k = 0; k < 2; ++k) dst[n][k] = *(const PG8_LAS bf16x8*)(lds + PG8_SB(b, h) + boff + n * 2048 + k * 1024); } while (0)
#define PG8_MMA(ai, bj, At, Bt) do { __builtin_amdgcn_s_setprio(1); _Pragma("unroll") for (int m = 0; m < 4; ++m) _Pragma("unroll") for (int n = 0; n < 2; ++n) _Pragma("unroll") for (int k = 0; k < 2; ++k) \
        acc[ai][bj][m][n] = __builtin_amdgcn_mfma_f32_16x16x32_bf16(Bt[n][k], At[m][k], acc[ai][bj][m][n], 0, 0, 0); __builtin_amdgcn_s_setprio(0); } while (0)
#define PG8_WAIT_V(n) asm volatile("s_waitcnt vmcnt(" #n ")" ::: "memory")
#define PG8_WAIT_L(n) asm volatile("s_waitcnt lgkmcnt(" #n ")" ::: "memory")
#define PG8_BAR __builtin_amdgcn_s_barrier()
#define PG8_SCHED __builtin_amdgcn_sched_barrier(0)
    Unit cur, nxt; int ui = 0;
    if (!S.next(0, cur)) return;
    f32x4 acc[2][2][4][2];
#pragma unroll
    for (int a = 0; a < 2; ++a)
#pragma unroll
        for (int b = 0; b < 2; ++b)
#pragma unroll
            for (int m = 0; m < 4; ++m)
#pragma unroll
                for (int n = 0; n < 2; ++n) acc[a][b][m][n] = (f32x4){0.f, 0.f, 0.f, 0.f};
    bf16x8 At[4][2], B0[2][2], B1[2][2];
    const char* cA = cur.A; const char* cB = cur.B;
    PG8_LOADOFF(offC, cur);
    PG8_STAGE(PG8_SB(0, 0), cB, voffB); PG8_STAGE(PG8_SB(0, 1), cB + hstep, voffB); PG8_STAGE(PG8_SA(0, 0), cA, offC[0]); PG8_STAGE(PG8_SA(0, 1), cA, offC[1]);
    if (wr == 1) PG8_BAR;
    PG8_WAIT_V(2); PG8_BAR;
    PG8_STAGE(PG8_SB(1, 0), cB + kstep, voffB); PG8_STAGE(PG8_SA(1, 0), cA + kstep, offC[0]); PG8_STAGE(PG8_SB(1, 1), cB + hstep + kstep, voffB);
    PG8_WAIT_V(6); PG8_BAR;
    for (;;) {
        const bool has_next = S.next(ui + 1, nxt);
        const char* nA = has_next ? nxt.A : cA; const char* nB = has_next ? nxt.B : cB;
        for (int t = 0; t < nt; t += 2) {
            const bool last = (t == nt - 2);
            H.at(t, acc, wr, fr, lane);
            const char* a1 = cA + (size_t)(t + 1) * kstep;
            const char* a2 = last ? nA : cA + (size_t)(t + 2) * kstep; const char* b2 = last ? nB : cB + (size_t)(t + 2) * kstep;
            const char* a3 = a2 + kstep; const char* b3 = b2 + kstep;
            PG8_LDB(B0, 0, 0); PG8_LDB(B1, 0, 1); PG8_SCHED; PG8_LDA(At, 0, 0); PG8_STAGE(PG8_SA(1, 1), a1, offC[1]);
            if constexpr (GATHER) { if (last && has_next) { PG8_LOADOFF(offC, nxt); } }
            PG8_WAIT_V(8); PG8_WAIT_L(0); PG8_BAR; PG8_MMA(0, 0, At, B0); PG8_MMA(0, 1, At, B1); PG8_BAR; PG8_SCHED;
            PG8_LDA(At, 0, 1); PG8_STAGE(PG8_SB(0, 0), b2, voffB); PG8_STAGE(PG8_SB(0, 1), b2 + hstep, voffB); PG8_STAGE(PG8_SA(0, 0), a2, offC[0]);
            PG8_WAIT_V(8); PG8_WAIT_L(0); PG8_BAR; PG8_MMA(1, 0, At, B0); PG8_MMA(1, 1, At, B1); PG8_BAR; PG8_SCHED;
            PG8_LDB(B0, 1, 0); PG8_LDB(B1, 1, 1); PG8_SCHED; PG8_LDA(At, 1, 0); PG8_STAGE(PG8_SA(0, 1), a2, offC[1]);
            PG8_WAIT_V(8); PG8_WAIT_L(0); PG8_BAR; PG8_MMA(0, 0, At, B0); PG8_MMA(0, 1, At, B1); PG8_BAR; PG8_SCHED;
            PG8_LDA(At, 1, 1); PG8_STAGE(PG8_SB(1, 0), b3, voffB); PG8_STAGE(PG8_SB(1, 1), b3 + hstep, voffB); PG8_STAGE(PG8_SA(1, 0), a3, offC[0]);
            PG8_WAIT_V(8); PG8_WAIT_L(0); PG8_BAR; PG8_MMA(1, 0, At, B0); PG8_MMA(1, 1, At, B1); PG8_BAR; PG8_SCHED;
        }
        if (wr == 0) PG8_BAR;
        E(acc, cur, wr, wc, fr, fq);
        if (!has_next) break;
#pragma unroll
        for (int a = 0; a < 2; ++a)
#pragma unroll
            for (int b = 0; b < 2; ++b)
#pragma unroll
                for (int m = 0; m < 4; ++m)
#pragma unroll
                    for (int n = 0; n < 2; ++n) acc[a][b][m][n] = (f32x4){0.f, 0.f, 0.f, 0.f};
        cur = nxt; cA = nA; cB = nB; ++ui;
        if (wr == 1) PG8_BAR;
    }
    PG8_WAIT_V(0);
    PG8_BAR;
#undef PG8_LOADOFF
#undef PG8_SA
#undef PG8_SB
#undef PG8_STAGE
#undef PG8_LDA
#undef PG8_LDB
#undef PG8_MMA
#undef PG8_WAIT_V
#undef PG8_WAIT_L
#undef PG8_BAR
#undef PG8_SCHED
}
}
namespace mk {
#define GAS __attribute__((address_space(1)))
#define LAS __attribute__((address_space(3)))
typedef unsigned short bf16;
typedef unsigned v4u __attribute__((ext_vector_type(4)));
typedef unsigned v2u __attribute__((ext_vector_type(2)));
typedef float f32x4 __attribute__((ext_vector_type(4)));
typedef short bf16x8 __attribute__((ext_vector_type(8)));

constexpr int T = 16384, D = 1024, S = 2048, NB = 8, NH = 8, HD = 64, NE = 64, DIN = 2056;
constexpr int NTHR = 512, NWAVES = 8;
constexpr float EPS = 1e-6f;
constexpr float LOG2E = 1.4426950408889634f;
constexpr float QSCALE = 0.125f * LOG2E;
constexpr int NLIST = 128, LIST_CAP = 8192;

constexpr size_t MiB = 1u << 20;
constexpr size_t WS_CTL = 0, CTL_ZERO_BYTES = 1 * MiB;
constexpr size_t WS_SMALL = 1 * MiB;
constexpr size_t WS_MOD = WS_SMALL, WS_WF = WS_SMALL + 256 * 1024, WS_LOGF = WS_SMALL + 512 * 1024, WS_SSQP = WS_SMALL + 1 * MiB, WS_SSQA = WS_SSQP + 512 * 1024,
                 WS_TOKMAP = WS_SSQA + 512 * 1024, WS_WTS = WS_TOKMAP + 512 * 1024, WS_LISTS = WS_WTS + 512 * 1024;
constexpr size_t WS_WD = 8 * MiB, WS_WSD = 40 * MiB;
constexpr size_t WS_H = 40 * MiB + 512 * 1024;
constexpr size_t WS_HB = 41 * MiB, WS_PROJ = 73 * MiB, WS_YCAT = 41 * MiB, WS_MIXED = 73 * MiB;
constexpr size_t WS_WIN = 190 * MiB, WS_WOUT = 194 * MiB, WS_WSGU = 196 * MiB, WS_WPOOL = 197 * MiB, WS_WRHI = WS_WPOOL + 128 * 1024, WS_WRLO = WS_WRHI + 128 * 1024;
constexpr size_t WS_H2 = 199 * MiB, WS_WGU = 231 * MiB, WS_END = 295 * MiB;
static_assert(WS_LISTS + (size_t)NLIST * LIST_CAP * 4 <= WS_WD && WS_WRLO + 128 * 1024 <= WS_H2, "ws map");
constexpr int CW_TMO = 0, CW_BAR = 4096, CW_CNT = 8192;

constexpr int RING_BYTES = 131072, LDSCTL_OFF = RING_BYTES, MISC_OFF = LDSCTL_OFF, ULIST_OFF = LDSCTL_OFF + 512, PRE_OFF = ULIST_OFF + 256, TAB_OFF = PRE_OFF + 528,
              RS_OFF = TAB_OFF + 8192, LDS_BYTES = 147456;
constexpr int MAXU = 8;
static_assert(RS_OFF + 2048 <= LDS_BYTES && (TAB_OFF % 16) == 0, "LDS map");

#define RLX_AGENT __ATOMIC_RELAXED, __HIP_MEMORY_SCOPE_AGENT
#define LDS_WAIT() asm volatile("s_waitcnt lgkmcnt(0)" ::: "memory")
#define VM_WAIT() asm volatile("s_waitcnt vmcnt(0)" ::: "memory")
__device__ __forceinline__ unsigned f2bf(float f) { unsigned u = __builtin_bit_cast(unsigned, f); return (u + 0x7fffu + ((u >> 16) & 1u)) >> 16; }
__device__ __forceinline__ unsigned pk2(float lo, float hi) { return f2bf(lo) | (f2bf(hi) << 16); }
__device__ __forceinline__ float bf2f(unsigned h) { return __builtin_bit_cast(float, h << 16); }
__device__ __forceinline__ float wave_sum(float v) {
#pragma unroll
    for (int o = 1; o < 64; o <<= 1) v += __shfl_xor(v, o);
    return v;
}

#define XB_TMO      128
#define XB_XCNT(j)  (256  + 64 * (j))
#define XB_XSUB(j)  (1280 + 64 * (j))
#define XB_XGEN(j)  (2304 + 64 * (j))
#define XB_TOP      3328
#define XB_TOPGEN   3392
#define XCD_BAR_WORDS 3456
#define XB_SPIN_CAP (1u << 18)
__device__ __forceinline__ unsigned xb_ld(unsigned* p)              { return __hip_atomic_load(p, __ATOMIC_RELAXED, __HIP_MEMORY_SCOPE_AGENT); }
__device__ __forceinline__ unsigned xb_add(unsigned* p, unsigned v) { return __hip_atomic_fetch_add(p, v, __ATOMIC_RELAXED, __HIP_MEMORY_SCOPE_AGENT); }
__device__ __forceinline__ unsigned xb_xcc_id() { return (unsigned)__builtin_amdgcn_s_getreg((3 << 11) | 20) & 0xFu; }
#define XB_SPIN(cond, bar) do { unsigned _sp = 0; while (cond) { __builtin_amdgcn_s_sleep(1); \
    if ((++_sp & 255u) == 0u) { if (xb_ld(&(bar)[XB_TMO])) break; if (_sp > XB_SPIN_CAP) { atomicAdd(&(bar)[XB_TMO], 1u); break; } } } } while (0)
struct XcdBarrier { unsigned* bar; unsigned x; volatile LAS unsigned* st; };
__device__ __forceinline__ XcdBarrier xcd_barrier_post(unsigned* bar, volatile LAS unsigned* st) {
    XcdBarrier b; b.bar = bar; b.x = xb_xcc_id(); b.st = st;
    if (threadIdx.x == 0) (void)xb_add(&bar[XB_XCNT(b.x)], 1u);
    return b;
}
__device__ __forceinline__ void xcd_barrier_complete(unsigned* bar, unsigned x, unsigned& nloc, unsigned& nx) {
    const unsigned G = gridDim.x * gridDim.y * gridDim.z;
    unsigned sum, cnt, mine, sp = 0u;
    for (;;) {
        sum = 0u; cnt = 0u; mine = 0u;
#pragma unroll
        for (unsigned j = 0; j < 16; ++j) { const unsigned c = xb_ld(&bar[XB_XCNT(j)]); sum += c; cnt += (c > 0u) ? 1u : 0u; mine = (j == x) ? c : mine; }
        if (sum == G) break;
        __builtin_amdgcn_s_sleep(1);
        if ((++sp & 255u) == 0u) { if (xb_ld(&bar[XB_TMO])) break; if (sp > XB_SPIN_CAP) { atomicAdd(&bar[XB_TMO], 1u); break; } }
    }
    nloc = mine > 0u ? mine : 1u; nx = cnt > 0u ? cnt : 1u;
}
__device__ __forceinline__ void xcd_barrier(const XcdBarrier& b) {
    asm volatile("s_waitcnt vmcnt(0)" ::: "memory");
    __syncthreads();
    if (threadIdx.x == 0) {
        unsigned* bar = b.bar;
        __builtin_amdgcn_s_waitcnt(0);
        unsigned nloc = b.st[0], nx = b.st[1];
        if (nloc == 0u) { xcd_barrier_complete(bar, b.x, nloc, nx); b.st[0] = nloc; b.st[1] = nx; }
        const unsigned old = xb_add(&bar[XB_XSUB(b.x)], 1u);
        const unsigned gen = old / nloc;
        if (old + 1u == (gen + 1u) * nloc) {
            __builtin_amdgcn_fence(__ATOMIC_RELEASE, "agent");
            asm volatile("s_waitcnt vmcnt(0)" ::: "memory");
            const unsigned og = xb_add(&bar[XB_TOP], 1u);
            const unsigned tg = og / nx;
            if (og + 1u == (tg + 1u) * nx) xb_add(&bar[XB_TOPGEN], 1u);
            else XB_SPIN(xb_ld(&bar[XB_TOPGEN]) == tg, bar);
            __builtin_amdgcn_fence(__ATOMIC_ACQUIRE, "agent");
            xb_add(&bar[XB_XGEN(b.x)], 1u);
            asm volatile("s_waitcnt vmcnt(0)" ::: "memory");
        } else {
            XB_SPIN(xb_ld(&bar[XB_XGEN(b.x)]) == gen, bar);
            __builtin_amdgcn_fence(__ATOMIC_ACQUIRE, "agent");
            asm volatile("s_waitcnt vmcnt(0)" ::: "memory");
        }
    }
    __syncthreads();
}

enum { I_X = 0, I_C, I_WADA, I_BADA, I_GPREMIX, I_GPOSTMIX, I_GPREFFN, I_GPOSTFFN, I_WIN, I_BFORGET, I_WPOOL, I_POOLSCALE, I_GPOOLOUT, I_GATTNOUT, I_WOUT,
       I_WROUTER, I_RBIAS, I_WGATE, I_WUP, I_WDOWN, I_WSGATE, I_WSUP, I_WSDOWN, N_IN };

struct Args { const float* in[N_IN]; float* out; unsigned char* ws; int ph_lo, ph_hi; };

struct Frame {
    LAS unsigned char* lds; unsigned* ctl; unsigned char* ws; const float* const* in; float* out;
    int tid, lane, wave, vcu, G;
};
}
namespace mk {
template <int MODE>
__device__ __forceinline__ void tr_item(const float* W, int ldn, int k0, int n0, bf16* WT, bf16* WT2, int Kd, int rowbase, const float* sc, float cmul, LAS float* scr, int lane) {
#pragma unroll 8
    for (int i = 0; i < 32; ++i) { const int kk = 2 * i + (lane >> 5); scr[kk * 33 + (lane & 31)] = W[(size_t)(k0 + kk) * ldn + n0 + (lane & 31)]; }
    LDS_WAIT(); asm volatile("" ::: "memory");
    const int c = lane & 7;
#pragma unroll
    for (int j = 0; j < 4; ++j) { const int n = (lane >> 3) + 8 * j; const LAS float* s = scr + (8 * c) * 33 + n;
        float v[8];
#pragma unroll
        for (int i = 0; i < 8; ++i) { v[i] = s[i * 33] * cmul; if (MODE == 1) v[i] *= sc[k0 + 8 * c + i]; if (MODE == 2) v[i] *= sc[n0 + n]; }
        v4u o; o.x = pk2(v[0], v[1]); o.y = pk2(v[2], v[3]); o.z = pk2(v[4], v[5]); o.w = pk2(v[6], v[7]);
        *(GAS v4u*)(WT + (size_t)(rowbase + n) * Kd + k0 + 8 * c) = o;
        if (MODE == 3) {
#pragma unroll
            for (int i = 0; i < 8; ++i) v[i] = v[i] - bf2f(f2bf(v[i]));
            v4u p; p.x = pk2(v[0], v[1]); p.y = pk2(v[2], v[3]); p.z = pk2(v[4], v[5]); p.w = pk2(v[6], v[7]);
            *(GAS v4u*)(WT2 + (size_t)(rowbase + n) * Kd + k0 + 8 * c) = p; } }
    LDS_WAIT(); asm volatile("" ::: "memory");
}

__device__ __forceinline__ void p0a(Frame& F) {
    const float* const* in = F.in; unsigned char* ws = F.ws;
    if (F.vcu < 192) {
        LAS float* red = (LAS float*)F.lds;
        const int col0 = 32 * F.vcu, kk = F.tid >> 3, c4 = F.tid & 7;
        const float* wa = in[I_WADA]; const float* cc = in[I_C];
        f32x4 acc[8];
#pragma unroll
        for (int b = 0; b < 8; ++b) acc[b] = (f32x4){0.f, 0.f, 0.f, 0.f};
#pragma unroll 4
        for (int i = 0; i < 16; ++i) { const int k = kk + 64 * i; const f32x4 w = *(const f32x4*)(wa + (size_t)k * 6144 + col0 + 4 * c4);
#pragma unroll
            for (int b = 0; b < 8; ++b) acc[b] += w * cc[b * D + k]; }
#pragma unroll
        for (int b = 0; b < 8; ++b) *(LAS f32x4*)(red + kk * 256 + b * 32 + 4 * c4) = acc[b];
        __syncthreads();
        if (F.tid < 256) { float s = 0.f;
#pragma unroll 8
            for (int k2 = 0; k2 < 64; ++k2) s += red[k2 * 256 + F.tid];
            const int b = F.tid >> 5, c = F.tid & 31; ((float*)(ws + WS_MOD))[b * 6144 + col0 + c] = s + in[I_BADA][col0 + c]; }
        __syncthreads();
    }
    if (F.vcu == 255) { float* wf = (float*)(ws + WS_WF); for (int i = F.tid; i < 8192; i += NTHR) { const int j = i >> 10, k = i & 1023; wf[i] = in[I_WIN][(size_t)k * DIN + 2048 + j]; } }
    LAS float* scr = (LAS float*)(F.lds + F.wave * 16384);
    const int gw = F.vcu * NWAVES + F.wave, NGW = F.G * NWAVES, lane = F.lane;
    constexpr int I_E = 8192, I_IN = 1024, I_OUT = 512, I_S = 128, I_P = 32, I_R = 32;
    constexpr int NITEMS = 3 * I_E + I_IN + I_OUT + 3 * I_S + I_P + I_R;
    bf16* Wgu = (bf16*)(ws + WS_WGU); bf16* Wd = (bf16*)(ws + WS_WD);
    for (int it = gw; it < NITEMS; it += NGW) {
        int r = it;
        if (r < 2 * I_E) { const int up = r >= I_E; if (up) r -= I_E; const int e = r >> 7, rem = r & 127, k0 = 64 * (rem >> 3), n0 = 32 * (rem & 7);
            tr_item<0>(in[up ? I_WUP : I_WGATE] + (size_t)e * D * 256, 256, k0, n0, Wgu + (size_t)e * 512 * D, nullptr, D, (n0 >> 7) * 256 + (n0 & 127) + (up ? 128 : 0), nullptr, 1.f, scr, lane); continue; }
        r -= 2 * I_E;
        if (r < I_E) { const int e = r >> 7, rem = r & 127, k0 = 64 * (rem >> 5), n0 = 32 * (rem & 31);
            tr_item<0>(in[I_WDOWN] + (size_t)e * 256 * D, D, k0, n0, Wd + (size_t)e * D * 256, nullptr, 256, n0, nullptr, 1.f, scr, lane); continue; }
        r -= I_E;
        if (r < I_IN) { const int k0 = 64 * (r >> 6), n0 = 32 * (r & 63);
            tr_item<0>(in[I_WIN], DIN, k0, n0, (bf16*)(ws + WS_WIN), nullptr, D, n0, nullptr, (n0 >= 512 && n0 < 1024) ? QSCALE : 1.f, scr, lane); continue; }
        r -= I_IN;
        if (r < I_OUT) { const int k0 = 64 * (r >> 5), n0 = 32 * (r & 31);
            tr_item<1>(in[I_WOUT], D, k0, n0, (bf16*)(ws + WS_WOUT), nullptr, D, n0, k0 < 512 ? in[I_GPOOLOUT] : in[I_GATTNOUT] - 512, 1.f, scr, lane); continue; }
        r -= I_OUT;
        if (r < 2 * I_S) { const int up = r >= I_S; if (up) r -= I_S; const int k0 = 64 * (r >> 3), n0 = 32 * (r & 7);
            tr_item<0>(in[up ? I_WSUP : I_WSGATE], 256, k0, n0, (bf16*)(ws + WS_WSGU), nullptr, D, (n0 >> 7) * 256 + (n0 & 127) + (up ? 128 : 0), nullptr, 1.f, scr, lane); continue; }
        r -= 2 * I_S;
        if (r < I_S) { const int k0 = 64 * (r >> 5), n0 = 32 * (r & 31);
            tr_item<0>(in[I_WSDOWN], D, k0, n0, (bf16*)(ws + WS_WSD), nullptr, 256, n0, nullptr, 1.f, scr, lane); continue; }
        r -= I_S;
        if (r < I_P) { const int g = r >> 3, rem = r & 7, k0 = 64 * (rem >> 2), n0 = 32 * (rem & 3);
            tr_item<2>(in[I_WPOOL] + (size_t)g * 16384, 128, k0, n0, (bf16*)(ws + WS_WPOOL) + (size_t)g * 16384, nullptr, 128, n0, in[I_POOLSCALE] + g * 128, 1.f, scr, lane); continue; }
        r -= I_P;
        { const int k0 = 64 * (r >> 1), n0 = 32 * (r & 1);
            tr_item<3>(in[I_WROUTER], 64, k0, n0, (bf16*)(ws + WS_WRHI), (bf16*)(ws + WS_WRLO), D, n0, nullptr, 1.f, scr, lane); }
    }
}

__device__ __forceinline__ void p0b(Frame& F) {
    const float* const* in = F.in; unsigned char* ws = F.ws;
    LAS float* wfl = (LAS float*)F.lds;
    { const float* wf = (const float*)(ws + WS_WF); for (int i = F.tid; i < 2048; i += NTHR) *(LAS f32x4*)(wfl + 4 * i) = *(const f32x4*)(wf + 4 * i); }
    __syncthreads();
    const int gw = F.vcu * NWAVES + F.wave, lane = F.lane, NGW = F.G * NWAVES;
    const float* mod = (const float*)(ws + WS_MOD);
    for (int r0 = 8 * gw; r0 < T; r0 += 8 * NGW) {
        const int b = r0 / S;
        f32x4 gs[4], sh[4];
#pragma unroll
        for (int j = 0; j < 4; ++j) { const int c = 4 * lane + 256 * j; const f32x4 g = *(const f32x4*)(in[I_GPREMIX] + c), sc = *(const f32x4*)(mod + b * 6144 + 1024 + c);
            gs[j] = g * (sc + 1.0f); sh[j] = *(const f32x4*)(mod + b * 6144 + c); }
        const float bfg = in[I_BFORGET][lane & 7];
        for (int rr = 0; rr < 8; ++rr) {
            const int row = r0 + rr; const GAS f32x4* xr = (const GAS f32x4*)(in[I_X] + (size_t)row * D) + lane;
            f32x4 v[4]; float ss = 0.f;
#pragma unroll
            for (int j = 0; j < 4; ++j) { v[j] = xr[64 * j]; ss += (v[j].x * v[j].x + v[j].y * v[j].y) + (v[j].z * v[j].z + v[j].w * v[j].w); }
            const float rstd = rsqrtf(wave_sum(ss) * (1.f / D) + EPS);
            GAS unsigned long long* o8 = (GAS unsigned long long*)((bf16*)(ws + WS_HB) + (size_t)row * D) + lane;
#pragma unroll
            for (int j = 0; j < 4; ++j) { v[j] = v[j] * rstd * gs[j] + sh[j]; o8[64 * j] = (unsigned long long)pk2(v[j].x, v[j].y) | ((unsigned long long)pk2(v[j].z, v[j].w) << 32); }
            float z = 0.f;
#pragma unroll
            for (int h = 0; h < 8; ++h) { float p = 0.f;
#pragma unroll
                for (int j = 0; j < 4; ++j) { const f32x4 w = *(const LAS f32x4*)(wfl + h * 1024 + 4 * lane + 256 * j); p += (v[j].x * w.x + v[j].y * w.y) + (v[j].z * w.z + v[j].w * w.w); }
                p = wave_sum(p); z = (lane == h) ? p : z; }
            if (lane < 8) { const float u = z + bfg; ((float*)(ws + WS_LOGF))[(size_t)row * 8 + lane] = fminf(u, 0.f) - log1pf(__expf(-fabsf(u))); }
        }
    }
}

__device__ __forceinline__ bool static_unit(int nM, int nN, int G, int c, int i, int& pm, int& pn) {
    const int nwg = nM * nN; const long L = (long)i * G + c; if (L >= nwg) return false;
    int wgid = (int)L; { const int q = nwg / 8, r = nwg % 8, xcd = wgid % 8, off = wgid / 8; wgid = (xcd < r ? xcd * (q + 1) : r * (q + 1) + (xcd - r) * q) + off; }
    const int nig = 8 * nN, gid = wgid / nig, fm = gid * 8, gsz = (nM - fm) < 8 ? (nM - fm) : 8;
    pm = fm + ((wgid % nig) % gsz); pn = (wgid % nig) / gsz; return true;
}
__device__ __forceinline__ void put_unit(Frame& F, int i, const void* A, const void* B, int tab, int orow, int ocol) {
    LAS pg8::UnitRec* r = (LAS pg8::UnitRec*)(F.lds + ULIST_OFF) + i;
    r->A = (unsigned long long)(uintptr_t)A; r->B = (unsigned long long)(uintptr_t)B; r->tab = tab; r->orow = orow; r->ocol = ocol; r->aux = 0;
}
__device__ __forceinline__ void p1(Frame& F) {
    unsigned char* ws = F.ws; int n = 0;
    for (int i = 0; i < MAXU; ++i) { int pm, pn; if (!static_unit(T / 256, 2048 / 256, F.G, (int)blockIdx.x, i, pm, pn)) break;
        if (F.tid == 0) put_unit(F, i, ws + WS_HB + (size_t)pm * 256 * D * 2, ws + WS_WIN + (size_t)pn * 256 * D * 2, -1, pm * 256, pn * 256);
        ++n; }
    __syncthreads();
    pg8::ListSched Sd{(const LAS pg8::UnitRec*)(F.lds + ULIST_OFF), n};
    pg8::EpiBf16 E{(bf16*)(ws + WS_PROJ), 2048};
    pg8::gemm_phase<pg8::EpiBf16, pg8::ListSched, false, pg8::NoHook>(F.lds, D, Sd, E, pg8::NoHook{});
}
}
namespace attn_body {
using bf16=__hip_bfloat16;
using bf16x8=__attribute__((ext_vector_type(8)))short;
using s16x4=__attribute__((ext_vector_type(4)))short;
using f32x16=__attribute__((ext_vector_type(16)))float;
using u32x4=__attribute__((ext_vector_type(4)))unsigned;
constexpr int BATCH=8,NHEAD=8,SEQ=2048,D=64,DM=2048,PO=1024;
constexpr int NW=8,QBLK=32,QB=QBLK*NW,KVBLK=64,NQB=SEQ/QB;
__device__ __forceinline__ int crow(int r,int hi){return (r&3)+8*(r>>2)+4*hi;}
#define SBAR() __builtin_amdgcn_sched_barrier(0)
__device__ __forceinline__ void cmask(f32x16&p0,f32x16&p1,int jb,int qrel,int hi){
  const float NEG=-INFINITY; int kb=64*jb+4*hi;
  #pragma unroll
  for(int r=0;r<16;++r){int kv=kb+(r&3)+8*(r>>2); if(kv>qrel)p0[r]=NEG; if(kv+32>qrel)p1[r]=NEG;}
}

constexpr int NSLOT=3, SLOTB=8192;
constexpr int LDS_K=0, LDS_V=NSLOT*SLOTB, LDS_WS=2*NSLOT*SLOTB, LDS_OST=LDS_WS+NW*64*4, LDS_CUM=LDS_OST+NW*4096, LDS_KB=LDS_CUM+SEQ*4, LDS_BYTES=LDS_KB+SEQ*4;
__device__ __forceinline__ void glds16(const void*gsrc,unsigned lds_dst){unsigned keep;
  asm volatile("s_mov_b32 %0, m0\n\ts_mov_b32 m0, %2\n\ts_nop 0\n\tglobal_load_lds_dwordx4 %1, off\n\ts_mov_b32 m0, %0":"=&s"(keep):"v"(gsrc),"s"(lds_dst):"memory");}
__device__ __forceinline__ float max3f(float a,float b,float c){float r;asm("v_max3_f32 %0, %1, %2, %3":"=v"(r):"v"(a),"v"(b),"v"(c));return r;}
__device__ __forceinline__ float max2f(float a,float b){float r;asm("v_max_f32_e32 %0, %1, %2":"=v"(r):"v"(a),"v"(b));return r;}
__device__ __forceinline__ float fadd_s(float a,float b){float r;asm("v_add_f32_e32 %0, %1, %2":"=v"(r):"v"(a),"v"(b));return r;}
__device__ __forceinline__ float fsub_s(float a,float b){float r;asm("v_sub_f32_e32 %0, %1, %2":"=v"(r):"v"(a),"v"(b));return r;}
typedef float f32x2_t __attribute__((ext_vector_type(2))); typedef __bf16 bf16x2_t __attribute__((ext_vector_type(2)));
__device__ __forceinline__ unsigned cvtpk_s(float lo,float hi){f32x2_t v={lo,hi};bf16x2_t b=__builtin_convertvector(v,bf16x2_t);return __builtin_bit_cast(unsigned,b);}
#define WAIT_BAR(N) asm volatile("s_waitcnt vmcnt(" #N ") lgkmcnt(0)\n\ts_barrier":::"memory")

__device__ __forceinline__ void qkt(f32x16&p0,f32x16&p1,const char*Kslot,const bf16x8*qr,bf16x8 kb0,bf16x8 kb1,bf16x8 qb,int r32,int hi){
  const char*kb=Kslot+hi*1024+r32*16;
  p0=__builtin_amdgcn_mfma_f32_32x32x16_bf16(kb0,qb,f32x16{},0,0,0);p1=__builtin_amdgcn_mfma_f32_32x32x16_bf16(kb1,qb,f32x16{},0,0,0);
  #pragma unroll
  for(int d0=0;d0<4;++d0){
    const bf16x8 b0=*reinterpret_cast<const bf16x8*>(kb+d0*2048);
    const bf16x8 b1=*reinterpret_cast<const bf16x8*>(kb+d0*2048+512);
    p0=__builtin_amdgcn_mfma_f32_32x32x16_bf16(b0,qr[d0],p0,0,0,0);p1=__builtin_amdgcn_mfma_f32_32x32x16_bf16(b1,qr[d0],p1,0,0,0);}
}
typedef __attribute__((address_space(3))) const char* lds_cptr;
typedef short v4i16_t __attribute__((ext_vector_type(4)));
__device__ __forceinline__ void kload8(bf16x8*kf,lds_cptr kp){
  kf[0]=*(const __attribute__((address_space(3))) bf16x8*)(kp);      kf[1]=*(const __attribute__((address_space(3))) bf16x8*)(kp+512);
  kf[2]=*(const __attribute__((address_space(3))) bf16x8*)(kp+2048); kf[3]=*(const __attribute__((address_space(3))) bf16x8*)(kp+2560);
  kf[4]=*(const __attribute__((address_space(3))) bf16x8*)(kp+4096); kf[5]=*(const __attribute__((address_space(3))) bf16x8*)(kp+4608);
  kf[6]=*(const __attribute__((address_space(3))) bf16x8*)(kp+6144); kf[7]=*(const __attribute__((address_space(3))) bf16x8*)(kp+6656);
}
__device__ __forceinline__ void kload2(bf16x8*kf,lds_cptr kp,int j){ kf[2*j]=*(const __attribute__((address_space(3))) bf16x8*)(kp+j*2048); kf[2*j+1]=*(const __attribute__((address_space(3))) bf16x8*)(kp+j*2048+512); }
__device__ __forceinline__ s16x4 vtr(lds_cptr p){ return __builtin_bit_cast(s16x4,__builtin_amdgcn_ds_read_tr16_b64_v4i16((__attribute__((address_space(3))) v4i16_t*)p)); }
__device__ __forceinline__ float rowmax(const f32x16&p0,const f32x16&p1){
  float a=max3f(p0[0],p0[1],p1[0]),b=max3f(p0[2],p0[3],p1[1]);a=max3f(a,p1[2],p1[3]);
  #pragma unroll
  for(int r=4;r<16;r+=4){a=max3f(a,p0[r],p0[r+1]);b=max3f(b,p0[r+2],p0[r+3]);a=max3f(a,p1[r],p1[r+1]);b=max3f(b,p1[r+2],p1[r+3]);}
  const float m=max2f(a,b);
  auto rr=__builtin_amdgcn_permlane32_swap(__float_as_uint(m),__float_as_uint(m),false,false);
  return max2f(__uint_as_float(rr[0]),__uint_as_float(rr[1]));
}
__device__ __forceinline__ void pv(f32x16*o,int vb,bf16x8 pa0,bf16x8 pa1,bf16x8 pa2,bf16x8 pa3){
  #pragma unroll
  for(int d0=0;d0<2;++d0){s16x4 lo[4],hi[4];
    #pragma unroll
    for(int ks=0;ks<4;++ks){
      asm volatile("ds_read_b64_tr_b16 %0,%1 offset:%c2":"=&v"(lo[ks]):"v"(vb),"i"(d0*4096+ks*1024):"memory");
      asm volatile("ds_read_b64_tr_b16 %0,%1 offset:%c2":"=&v"(hi[ks]):"v"(vb),"i"(d0*4096+ks*1024+512):"memory");}
    asm volatile("s_waitcnt lgkmcnt(0)":::"memory");SBAR();
    #define PK(k) (bf16x8){lo[k][0],lo[k][1],lo[k][2],lo[k][3],hi[k][0],hi[k][1],hi[k][2],hi[k][3]}
    o[d0]=__builtin_amdgcn_mfma_f32_32x32x16_bf16(pa0,PK(0),o[d0],0,0,0);
    o[d0]=__builtin_amdgcn_mfma_f32_32x32x16_bf16(pa1,PK(1),o[d0],0,0,0);
    o[d0]=__builtin_amdgcn_mfma_f32_32x32x16_bf16(pa2,PK(2),o[d0],0,0,0);
    o[d0]=__builtin_amdgcn_mfma_f32_32x32x16_bf16(pa3,PK(3),o[d0],0,0,0);
    #undef PK
  }
}

#ifndef ATTN_STORE16
#define ATTN_STORE16(p,v) (*(u32x4*)(p)=(v))
#endif
template<int THRL> __device__ __forceinline__ void attn_unit(int b,int h,int qb,const bf16*Q,const bf16*__restrict__ K,const bf16*__restrict__ V,bf16*O,float*ssq,char*shm){
  int lane; asm volatile("v_mbcnt_lo_u32_b32 %0, -1, 0\n\tv_mbcnt_hi_u32_b32 %0, -1, %0" : "=v"(lane));
  const int wid=__builtin_amdgcn_readfirstlane(threadIdx.x>>6), tid=wid*64+lane, r32=lane&31,hi=lane>>5;
  const long rowbase=(long)b*SEQ; const int q0=qb*QB;
  const bf16*Qw=Q+(rowbase+q0+wid*QBLK)*DM+h*D;
  const bf16*Kh=K+rowbase*DM+h*D,*Vh=V+rowbase*DM+h*D;
  const unsigned lds0=(unsigned)(uintptr_t)shm;
  float*wsf=(float*)(shm+LDS_WS)+wid*64;
  const bf16*ksrc=Kh+(long)lane*DM+wid*8;
  const bf16*vsrc=Vh+(long)(16*(wid&3)+(lane>>2))*DM+(wid>>2)*32+(lane&3)*8;
  const unsigned kdst=lds0+LDS_K+wid*1024, vdst=lds0+LDS_V+wid*1024;
  #define DMA_K(t,slot) glds16(ksrc+(long)(t)*KVBLK*DM,(unsigned)__builtin_amdgcn_readfirstlane(kdst+(slot)))
  #define DMA_V(t,slot) glds16(vsrc+(long)(t)*KVBLK*DM,(unsigned)__builtin_amdgcn_readfirstlane(vdst+(slot)))
  const int vb0=(int)(lds0+LDS_V)+((lane>>4)&1)*32+(lane&3)*8+(4*hi+((lane&15)>>2))*64;
  const char*Kbase=shm+LDS_K; bf16x8 kf[8];
  const lds_cptr shm3=(lds_cptr)shm; const lds_cptr kp0=shm3+LDS_K+hi*1024+r32*16; const lds_cptr vp0=shm3+LDS_V+((lane>>4)&1)*32+(lane&3)*8+(4*hi+((lane&15)>>2))*64;
  const int NT=(q0+QB)/KVBLK;
  { const float*cum=(const float*)(shm+LDS_CUM); unsigned*kbt_=(unsigned*)(shm+LDS_KB); const float ref=cum[q0+QB-1];
    for(int k=tid;k<NT*KVBLK;k+=NW*64){ const float v=(ref-cum[k])*1.4426950408889634f; const unsigned hb=mk::f2bf(v); kbt_[k]=hb|(mk::f2bf(v-mk::bf2f(hb))<<16); }
    __syncthreads(); }
  const __attribute__((address_space(3))) unsigned* kbt=(const __attribute__((address_space(3))) unsigned*)((lds_cptr)shm+LDS_KB);
  const unsigned kone1=hi?0u:0x3F803F80u;
  #define KBF(pk) __builtin_bit_cast(bf16x8,(u32x4){(pk),kone1,kone1,0u})
  unsigned kbr0,kbr1;
  #define KBRD(G,tt) do{ if(G){ const unsigned a_=kbt[(tt)*KVBLK+r32], b_=kbt[(tt)*KVBLK+32+r32]; kbr0=a_; kbr1=b_; } }while(0)
  bf16x8 qb_=__builtin_bit_cast(bf16x8,(u32x4){kone1,0u,0u,0u});
  #define SETREF() do{ const float nm_=-mhat; const unsigned h0_=__float_as_uint(nm_)&0xFFFF0000u; const float r1_=nm_-__uint_as_float(h0_); const unsigned h1_=__float_as_uint(r1_)&0xFFFF0000u; \
      const float r2_=r1_-__uint_as_float(h1_); const unsigned h2_=__float_as_uint(r2_)&0xFFFF0000u; \
      qb_=__builtin_bit_cast(bf16x8,(u32x4){kone1, hi?0u:((h0_>>16)|h1_), hi?0u:(h2_>>16), 0u}); }while(0)
  DMA_K(0,0);DMA_V(0,0);DMA_K(1,SLOTB);
  bf16x8 qr[4];
  #pragma unroll
  for(int d0=0;d0<4;++d0)qr[d0]=*reinterpret_cast<const bf16x8*>(&Qw[(long)r32*DM+d0*16+hi*8]);
  const lds_cptr qp0=shm3+LDS_OST+wid*4096+hi*512+r32*16;
  #pragma unroll
  for(int d0=0;d0<4;++d0)*(__attribute__((address_space(3))) bf16x8*)((__attribute__((address_space(3))) char*)(qp0+d0*1024))=qr[d0];
  #define QF(d0) (*(const __attribute__((address_space(3))) bf16x8*)(qp0+(d0)*1024))
  float mhat=0.f,l_reg=0.f;f32x16 o[2];o[0]=f32x16{};o[1]=f32x16{};
  const int qrel=wid*QBLK+r32;
  #define CMASK(P0,P1,t) do{int jb_=(t)-(NT-4); if(jb_>=0)cmask(P0,P1,jb_,qrel,hi);}while(0)
  bool resc=false;
  #define START(P0,P1) do{ const float rm=rowmax(P0,P1); resc=false; \
    { const float dl=rm; mhat=fadd_s(mhat,dl); \
      _Pragma("unroll") for(int r=0;r<16;++r){P0[r]=fsub_s(P0[r],dl);P1[r]=fsub_s(P1[r],dl);} \
      SETREF(); } \
    _Pragma("unroll") for(int r=0;r<16;++r)P0[r]=__builtin_amdgcn_exp2f(P0[r]); }while(0)
  #define RESC() do{ if(resc){ asm volatile("s_waitcnt lgkmcnt(0)":::"memory"); \
      _Pragma("unroll") for(int d_=0;d_<2;++d_) _Pragma("unroll") for(int r=0;r<16;++r)o[d_][r]*=wsf[crow(r,hi)]; } }while(0)
  f32x16 pA0,pA1,pB0,pB1;
  int sl_prev=0,sl_cur=0,sl_next=SLOTB;
  #define ROT() do{sl_prev=sl_cur;sl_cur=sl_next;sl_next=(sl_next==(NSLOT-1)*SLOTB)?0:sl_next+SLOTB;}while(0)
  DMA_K(2,2*SLOTB);
  WAIT_BAR(3);
  KBRD(true,0);
  qkt(pA0,pA1,Kbase,qr,KBF(kbr0),KBF(kbr1),qb_,r32,hi);asm volatile("s_nop 15\n\ts_nop 7":"+v"(pA0),"+v"(pA1));CMASK(pA0,pA1,0);
  START(pA0,pA1);
  _Pragma("unroll") for(int r=0;r<16;++r)pA1[r]=__builtin_amdgcn_exp2f(pA1[r]);
  WAIT_BAR(0);
  DMA_K(3,0);DMA_V(1,SLOTB);
  ROT();
  kload8(kf,kp0+sl_cur);
  KBRD(true,1);
  WAIT_BAR(2);
  s16x4 vlo[8],vhi[8]; u32x4 pw0,pw1,pw2,pw3;
  #define PKW(P,B) cvtpk_s(P[B],P[B+1])
  #define PAF(k) __builtin_bit_cast(bf16x8,pw##k)
  #define VFR(i) (bf16x8){vlo[i][0],vlo[i][1],vlo[i][2],vlo[i][3],vhi[i][0],vhi[i][1],vhi[i][2],vhi[i][3]}
  #define PIN(x) asm volatile("":"+v"(x))
  #define MX3(a,b,c) __builtin_fmaxf(__builtin_fmaxf((a),(b)),(c))
  #define GAPA(MF,A0,A1,A2,A3,W0,W1,PW) do{ MF; sacc+=A0; sacc+=A1; sacc+=A2; sacc+=A3; PIN(sacc); W0; W1; PIN(PW); SBAR(); }while(0)
  #define EX(v) __builtin_amdgcn_exp2f(v)
  #define GAPB(MF,X,B) do{ MF; X[B]=EX(X[B]); X[B+1]=EX(X[B+1]); X[B+2]=EX(X[B+2]); X[B+3]=EX(X[B+3]); PIN(X); SBAR(); }while(0)
  #define VRD(i) do{ vlo[i]=vtr(vp_+(((i)>>2)*4096+((i)&3)*1024)); vhi[i]=vtr(vp_+(((i)>>2)*4096+((i)&3)*1024+512)); }while(0)
  #define KRD(G,j) do{ if(G){ kload2(kf,kp0+sl_next,j); SBAR(); } }while(0)
  #define STEP(C0,C1,P0,P1,t,GK,GV,GL) do{ SBAR(); \
    const lds_cptr vp_=vp0+sl_prev; \
    C0=__builtin_amdgcn_mfma_f32_32x32x16_bf16(KBF(kbr0),qb_,f32x16{},0,0,0); C1=__builtin_amdgcn_mfma_f32_32x32x16_bf16(KBF(kbr1),qb_,f32x16{},0,0,0); SBAR(); \
    VRD(0); SBAR(); float sacc=(P0[0]+P0[1]); \
    bf16x8 qa_=QF(0), qc_=QF(1); \
    GAPA(C0=__builtin_amdgcn_mfma_f32_32x32x16_bf16(kf[0],qa_,C0,0,0,0), P0[2],P0[3],P0[4],P0[5],     pw0[0]=PKW(P0,0), pw0[1]=PKW(P0,2), pw0); \
    VRD(4); SBAR(); GAPA(C1=__builtin_amdgcn_mfma_f32_32x32x16_bf16(kf[1],qa_,C1,0,0,0), P0[6],P0[7],P0[8],P0[9],     pw0[2]=PKW(P0,4), pw0[3]=PKW(P0,6), pw0); \
    qa_=QF(2); VRD(1); SBAR(); GAPA(C0=__builtin_amdgcn_mfma_f32_32x32x16_bf16(kf[2],qc_,C0,0,0,0),   P0[10],P0[11],P0[12],P0[13], pw1[0]=PKW(P0,8), pw1[1]=PKW(P0,10), pw1); \
    VRD(5); SBAR(); GAPA(C1=__builtin_amdgcn_mfma_f32_32x32x16_bf16(kf[3],qc_,C1,0,0,0),   P0[14],P0[15],P1[0],P1[1],   pw1[2]=PKW(P0,12),pw1[3]=PKW(P0,14), pw1); \
    qc_=QF(3); VRD(2); SBAR(); GAPA(C0=__builtin_amdgcn_mfma_f32_32x32x16_bf16(kf[4],qa_,C0,0,0,0),   P1[2],P1[3],P1[4],P1[5],     pw2[0]=PKW(P1,0), pw2[1]=PKW(P1,2), pw2); \
    VRD(6); SBAR(); GAPA(C1=__builtin_amdgcn_mfma_f32_32x32x16_bf16(kf[5],qa_,C1,0,0,0),   P1[6],P1[7],P1[8],P1[9],     pw2[2]=PKW(P1,4), pw2[3]=PKW(P1,6), pw2); \
    VRD(3); SBAR(); GAPA(C0=__builtin_amdgcn_mfma_f32_32x32x16_bf16(kf[6],qc_,C0,0,0,0),   P1[10],P1[11],P1[12],P1[13], pw3[0]=PKW(P1,8), pw3[1]=PKW(P1,10), pw3); \
    VRD(7); SBAR(); GAPA(C1=__builtin_amdgcn_mfma_f32_32x32x16_bf16(kf[7],qc_,C1,0,0,0),   P1[14],P1[15],0.f,0.f,       pw3[2]=PKW(P1,12),pw3[3]=PKW(P1,14), pw3); \
    l_reg+=sacc; \
    if(GK){DMA_K((t)+3,sl_cur);} if(GV){DMA_V((t)+1,sl_next);} \
    CMASK(C0,C1,t); \
    { float a=MX3(C0[0],C0[1],C1[0]),b=MX3(C0[2],C0[3],C1[1]); a=MX3(a,C1[2],C1[3]); \
      _Pragma("unroll") for(int r=4;r<16;r+=4){a=MX3(a,C0[r],C0[r+1]);b=MX3(b,C0[r+2],C0[r+3]);a=MX3(a,C1[r],C1[r+1]);b=MX3(b,C1[r+2],C1[r+3]);} \
      float rm=__builtin_fmaxf(a,b); { auto rr=__builtin_amdgcn_permlane32_swap(__float_as_uint(rm),__float_as_uint(rm),false,false); rm=__builtin_fmaxf(__uint_as_float(rr[0]),__uint_as_float(rr[1])); } \
      resc=false; \
      if(__builtin_expect(__any(rm>(float)THRL),0)){ const float dl=__builtin_fmaxf(rm,0.f); mhat+=dl; \
        _Pragma("unroll") for(int r=0;r<16;++r){C0[r]-=dl;C1[r]-=dl;} \
        SETREF(); \
        const float f=__builtin_amdgcn_exp2f(-dl); l_reg*=f; if(hi==0)wsf[r32]=f; resc=true; } } \
    SBAR(); \
    GAPB(o[0]=__builtin_amdgcn_mfma_f32_32x32x16_bf16(PAF(0),VFR(0),o[0],0,0,0), C0,0); \
    GAPB(o[1]=__builtin_amdgcn_mfma_f32_32x32x16_bf16(PAF(0),VFR(4),o[1],0,0,0), C0,4); \
    KRD(GL,0); GAPB(o[0]=__builtin_amdgcn_mfma_f32_32x32x16_bf16(PAF(1),VFR(1),o[0],0,0,0), C0,8); \
    KRD(GL,1); GAPB(o[1]=__builtin_amdgcn_mfma_f32_32x32x16_bf16(PAF(1),VFR(5),o[1],0,0,0), C0,12); \
    KRD(GL,2); GAPB(o[0]=__builtin_amdgcn_mfma_f32_32x32x16_bf16(PAF(2),VFR(2),o[0],0,0,0), C1,0); \
    KRD(GL,3); GAPB(o[1]=__builtin_amdgcn_mfma_f32_32x32x16_bf16(PAF(2),VFR(6),o[1],0,0,0), C1,4); \
    KBRD(GL,(t)+1); \
    GAPB(o[0]=__builtin_amdgcn_mfma_f32_32x32x16_bf16(PAF(3),VFR(3),o[0],0,0,0), C1,8); \
    GAPB(o[1]=__builtin_amdgcn_mfma_f32_32x32x16_bf16(PAF(3),VFR(7),o[1],0,0,0), C1,12); \
    }while(0)
  int t=1;
  #undef CMASK
  #define CMASK(P0,P1,t) do{}while(0)
  for(;t+5<NT;t+=2){
    STEP(pB0,pB1,pA0,pA1,t,true,true,true);     WAIT_BAR(2); RESC(); ROT();
    STEP(pA0,pA1,pB0,pB1,t+1,true,true,true);   WAIT_BAR(2); RESC(); ROT();
  }
  #undef CMASK
  #define CMASK(P0,P1,t) do{int jb_=(t)-(NT-4); if(jb_>=0)cmask(P0,P1,jb_,qrel,hi);}while(0)
  #define ENDW(tt) do{ if((tt)+3<NT){WAIT_BAR(2);} else if((tt)+2<NT){WAIT_BAR(1);} else {WAIT_BAR(0);} }while(0)
  for(;t+1<NT;t+=2){
    STEP(pB0,pB1,pA0,pA1,t,(t+3<NT),(t+1<NT),(t+1<NT));       ENDW(t);   RESC(); ROT();
    STEP(pA0,pA1,pB0,pB1,t+1,(t+4<NT),(t+2<NT),(t+2<NT));     ENDW(t+1); RESC(); ROT();
  }
  STEP(pB0,pB1,pA0,pA1,NT-1,false,false,false); RESC();
  { float sacc=pB0[0]+pB0[1]; _Pragma("unroll") for(int r=2;r<16;++r)sacc+=pB0[r]; _Pragma("unroll") for(int r=0;r<16;++r)sacc+=pB1[r]; l_reg+=sacc;
    pw0=(u32x4){PKW(pB0,0),PKW(pB0,2),PKW(pB0,4),PKW(pB0,6)};pw1=(u32x4){PKW(pB0,8),PKW(pB0,10),PKW(pB0,12),PKW(pB0,14)};pw2=(u32x4){PKW(pB1,0),PKW(pB1,2),PKW(pB1,4),PKW(pB1,6)};pw3=(u32x4){PKW(pB1,8),PKW(pB1,10),PKW(pB1,12),PKW(pB1,14)};
    SBAR(); pv(o,vb0+sl_cur,PAF(0),PAF(1),PAF(2),PAF(3)); }
  #undef PKW
  #undef PAF
  #undef VFR
  #undef PIN
  #undef MX3
  #undef GAPA
  #undef GAPB
  #undef EX
  #undef VRD
  #undef KRD
  #undef STEP
  #undef ENDW
  {auto rr=__builtin_amdgcn_permlane32_swap(__float_as_uint(l_reg),__float_as_uint(l_reg),false,false);l_reg=__uint_as_float(rr[0])+__uint_as_float(rr[1]);}
  if(hi==0)wsf[32+r32]=l_reg;asm volatile("s_waitcnt lgkmcnt(0)":::"memory");
  float rli[16];
  #pragma unroll
  for(int r=0;r<16;++r)rli[r]=__builtin_amdgcn_rcpf(wsf[32+crow(r,hi)]);
  bf16*Ow=O+(rowbase+q0+wid*QBLK)*PO+h*D; float*sq=ssq+(rowbase+q0+wid*QBLK)*8+h;
  { bf16*stg=(bf16*)(shm+LDS_OST)+wid*2048;
    #pragma unroll
    for(int r=0;r<16;++r){const int orow=crow(r,hi);
      #pragma unroll
      for(int d0=0;d0<2;++d0)stg[orow*64+d0*32+r32]=__float2bfloat16(o[d0][r]*rli[r]);}
    asm volatile("s_waitcnt lgkmcnt(0)":::"memory");
    #pragma unroll
    for(int i=0;i<4;++i){const int row=i*8+(lane>>3),ch=lane&7; const u32x4 v=*(const u32x4*)(stg+row*64+ch*8); ATTN_STORE16(Ow+(long)row*PO+ch*8,v);
      float ss=0.f;
      #pragma unroll
      for(int j=0;j<4;++j){ const float a_=__uint_as_float(v[j]<<16), b_=__uint_as_float(v[j]&0xFFFF0000u); ss+=a_*a_+b_*b_; }
      ss+=__shfl_xor(ss,1); ss+=__shfl_xor(ss,2); ss+=__shfl_xor(ss,4); if(ch==0) sq[(long)row*8]=ss; } }
  asm volatile("s_waitcnt lgkmcnt(0)\n\ts_barrier":::"memory");
  #undef DMA_K
  #undef DMA_V
  #undef CMASK
  #undef START
  #undef RESC
  #undef ROT
  #undef KBF
  #undef QF
  #undef KBRD
  #undef SETREF
}
constexpr int ATTN_LDS_BYTES=LDS_BYTES;
#undef SBAR
#undef WAIT_BAR
}

namespace mk {
__device__ __forceinline__ void pool_tile(Frame& F, int tile) {
    unsigned char* ws = F.ws; constexpr int US = 1040;
    const int t0 = tile * 64, tl0 = t0 % S;
    const bf16* proj = (const bf16*)(ws + WS_PROJ);
    for (int c = F.tid; c < 79 * 64; c += NTHR) { const int rr = c >> 6, ch = c & 63; v4u v = (v4u){0u, 0u, 0u, 0u};
        if (tl0 + rr - 15 >= 0) v = *(const GAS v4u*)(proj + (size_t)(t0 - 15 + rr) * 2048 + ch * 8);
        *(LAS v4u*)(F.lds + rr * US + ch * 16) = v; }
    __syncthreads();
    const int mb = F.wave & 3, nh = F.wave >> 2, r = F.lane & 15, kq = F.lane >> 4, tr = mb * 16 + r, tl = tl0 + tr;
    const bf16* wp = (const bf16*)(ws + WS_WPOOL);
    bf16* ycat = (bf16*)(ws + WS_YCAT); float* ssqp = (float*)(ws + WS_SSQP);
#pragma unroll
    for (int g = 0; g < 4; ++g) {
        constexpr int dummy = 0; (void)dummy;
        const int wg = 2 << g; const int n = (tl + 1 < wg) ? tl + 1 : wg; const float inv = 1.0f / (float)n;
        f32x4 acc[4];
#pragma unroll
        for (int nb = 0; nb < 4; ++nb) acc[nb] = (f32x4){0.f, 0.f, 0.f, 0.f};
#pragma unroll
        for (int ks = 0; ks < 4; ++ks) {
            const int c0 = g * 128 + ks * 32 + kq * 8;
            float sum[8];
#pragma unroll
            for (int j = 0; j < 8; ++j) sum[j] = 0.f;
            v4u cur = (v4u){0u, 0u, 0u, 0u};
#pragma unroll
            for (int i = 0; i < wg; ++i) { const v4u v = *(const LAS v4u*)(F.lds + (tr + 15 - i) * US + c0 * 2); if (i == 0) cur = v;
#pragma unroll
                for (int j = 0; j < 4; ++j) { sum[2 * j] += __uint_as_float(v[j] << 16); sum[2 * j + 1] += __uint_as_float(v[j] & 0xFFFF0000u); } }
            v4u pa;
#pragma unroll
            for (int j = 0; j < 4; ++j) pa[j] = pk2(sum[2 * j] * inv - __uint_as_float(cur[j] << 16), sum[2 * j + 1] * inv - __uint_as_float(cur[j] & 0xFFFF0000u));
            const bf16x8 af = __builtin_bit_cast(bf16x8, pa);
#pragma unroll
            for (int nb = 0; nb < 4; ++nb) { const bf16x8 bfr = *(const bf16x8*)(wp + (size_t)g * 16384 + (size_t)(nh * 64 + nb * 16 + r) * 128 + ks * 32 + kq * 8);
                acc[nb] = __builtin_amdgcn_mfma_f32_16x16x32_bf16(bfr, af, acc[nb], 0, 0, 0); }
        }
        const size_t token = (size_t)t0 + tr; float ss = 0.f;
#pragma unroll
        for (int nb = 0; nb < 4; ++nb) { const f32x4 v = acc[nb]; ss += (v[0] * v[0] + v[1] * v[1]) + (v[2] * v[2] + v[3] * v[3]);
            v2u o; o.x = pk2(v[0], v[1]); o.y = pk2(v[2], v[3]);
            *(GAS v2u*)(ycat + token * D + g * 128 + nh * 64 + nb * 16 + 4 * kq) = o; }
        ss += __shfl_xor(ss, 16); ss += __shfl_xor(ss, 32);
        if (kq == 0) ssqp[token * 8 + g * 2 + nh] = ss;
    }
    __syncthreads();
}

__device__ __forceinline__ void p2(Frame& F) {
    unsigned char* ws = F.ws; char* shm = (char*)(uintptr_t)0;
    (void)shm;
    const attn_body::bf16* proj = (const attn_body::bf16*)(ws + WS_PROJ);
    attn_body::bf16* ycat = (attn_body::bf16*)(ws + WS_YCAT);
    const float* logf = (const float*)(ws + WS_LOGF); float* ssqa = (float*)(ws + WS_SSQA);
    char* lds = (char*)F.lds;
    for (int p = F.vcu; p < 256; p += F.G) {
        const int bh = p >> 2, s = p & 3, b = bh >> 3, h = bh & 7;
        { const float* lf = logf + (size_t)b * S * 8 + h; const int k0 = 4 * F.tid;
          const float l0 = lf[(size_t)(k0 + 0) * 8], l1 = lf[(size_t)(k0 + 1) * 8], l2 = lf[(size_t)(k0 + 2) * 8], l3 = lf[(size_t)(k0 + 3) * 8];
          const float c0 = l0, c1 = c0 + l1, c2 = c1 + l2, c3 = c2 + l3; float x = c3;
#pragma unroll
          for (int o = 1; o < 64; o <<= 1) { const float y = __shfl_up(x, o); if (F.lane >= o) x += y; }
          LAS float* wt = (LAS float*)(F.lds + attn_body::LDS_WS);
          if (F.lane == 63) wt[F.wave] = x;
          __syncthreads();
          float base = x - c3; for (int w = 0; w < F.wave; ++w) base += wt[w];
          LAS float* cum = (LAS float*)(F.lds + attn_body::LDS_CUM);
          *(LAS f32x4*)(cum + k0) = (f32x4){base + c0, base + c1, base + c2, base + c3};
          __syncthreads(); }
#pragma nounroll
        for (int u = 0; u < 2; ++u) attn_body::attn_unit<8>(b, h, u ? 7 - s : s, proj + 512, proj + 1024, proj + 1536, ycat + 512, ssqa, lds);
    }
    __syncthreads();
    for (int tile = F.vcu; tile < T / 64; tile += F.G) pool_tile(F, tile);
}
}
namespace mk {
struct MidScaleHook {
    const LAS float* ratio;
    __device__ __forceinline__ void at(int t, pg8::f32x4 (&acc)[2][2][4][2], int wr, int fr, int) const {
        if (t == 8) {
#pragma unroll
            for (int ai = 0; ai < 2; ++ai)
#pragma unroll
                for (int m = 0; m < 4; ++m) { const float s = ratio[ai * 128 + wr * 64 + m * 16 + fr];
#pragma unroll
                    for (int bj = 0; bj < 2; ++bj)
#pragma unroll
                        for (int n = 0; n < 2; ++n) acc[ai][bj][m][n] *= s; }
        }
    }
};
__device__ __forceinline__ void p3(Frame& F) {
    unsigned char* ws = F.ws;
    LAS float* ratio = (LAS float*)(F.lds + RS_OFF); LAS float* rs = ratio + 256;
    const float* ssqp = (const float*)(ws + WS_SSQP); const float* ssqa = (const float*)(ws + WS_SSQA);
    for (int i = 0; i < 64; ++i) { int pm, pn; if (!static_unit(T / 256, D / 256, F.G, (int)blockIdx.x, i, pm, pn)) break;
        __syncthreads();
        if (F.tid < 256) { const size_t tok = (size_t)pm * 256 + F.tid; float sp = 0.f, sa = 0.f;
#pragma unroll
            for (int j = 0; j < 8; ++j) { sp += ssqp[tok * 8 + j]; sa += ssqa[tok * 8 + j]; }
            const float rp = rsqrtf(sp * (1.f / 512.f) + EPS), ra = rsqrtf(sa * (1.f / 512.f) + EPS);
            ratio[F.tid] = rp / ra; rs[F.tid] = ra; }
        if (F.tid == 0) put_unit(F, 0, ws + WS_YCAT + (size_t)pm * 256 * D * 2, ws + WS_WOUT + (size_t)pn * 256 * D * 2, -1, pm * 256, pn * 256);
        __syncthreads();
        pg8::ListSched Sd{(const LAS pg8::UnitRec*)(F.lds + ULIST_OFF), 1};
        pg8::EpiRowScaleBf16 E{(bf16*)(ws + WS_MIXED), D, rs};
        pg8::gemm_phase<pg8::EpiRowScaleBf16, pg8::ListSched, false, MidScaleHook>(F.lds, D, Sd, E, MidScaleHook{ratio});
    }
}
}
namespace mk {
__device__ __forceinline__ int p4_swz(int row, int chunk) { return row * 2048 + ((chunk ^ (row & 15)) << 4); }
__device__ __forceinline__ void p4(Frame& F) {
    const float* const* in = F.in; unsigned char* ws = F.ws;
    const float* mod = (const float*)(ws + WS_MOD);
    const bf16* mixed = (const bf16*)(ws + WS_MIXED); bf16* h2g = (bf16*)(ws + WS_H2);
    const bf16* wrhi = (const bf16*)(ws + WS_WRHI); const bf16* wrlo = (const bf16*)(ws + WS_WRLO);
    LAS unsigned char* thi = F.lds; LAS unsigned char* tlo = F.lds + 65536;
    const int lane = F.lane;
    for (int tile = F.vcu; tile < T / 32; tile += F.G) {
        for (int rr = 0; rr < 4; ++rr) {
            const int rowi = F.wave * 4 + rr; const size_t token = (size_t)tile * 32 + rowi; const int b = (int)(token / S);
            f32x4 m[4]; float ss = 0.f;
#pragma unroll
            for (int j = 0; j < 4; ++j) { const v2u u = *(const GAS v2u*)(mixed + token * D + 4 * lane + 256 * j);
                m[j] = (f32x4){__uint_as_float(u.x << 16), __uint_as_float(u.x & 0xFFFF0000u), __uint_as_float(u.y << 16), __uint_as_float(u.y & 0xFFFF0000u)};
                ss += (m[j].x * m[j].x + m[j].y * m[j].y) + (m[j].z * m[j].z + m[j].w * m[j].w); }
            const float rm = rsqrtf(wave_sum(ss) * (1.f / D) + EPS);
            float s1 = 0.f;
#pragma unroll
            for (int j = 0; j < 4; ++j) { const int c = 4 * lane + 256 * j;
                const f32x4 xv = *(const GAS f32x4*)(in[I_X] + token * D + c), gt = *(const f32x4*)(mod + b * 6144 + 2048 + c), gp = *(const f32x4*)(in[I_GPOSTMIX] + c);
                m[j] = xv + gt * (m[j] * rm) * gp;
                *(GAS f32x4*)(F.out + token * D + c) = m[j];
                s1 += (m[j].x * m[j].x + m[j].y * m[j].y) + (m[j].z * m[j].z + m[j].w * m[j].w); }
            const float r1 = rsqrtf(wave_sum(s1) * (1.f / D) + EPS);
#pragma unroll
            for (int j = 0; j < 4; ++j) { const int c = 4 * lane + 256 * j;
                const f32x4 gf = *(const f32x4*)(in[I_GPREFFN] + c), sc = *(const f32x4*)(mod + b * 6144 + 4096 + c), sh = *(const f32x4*)(mod + b * 6144 + 3072 + c);
                const f32x4 h = m[j] * r1 * gf * (sc + 1.0f) + sh;
                const unsigned h0 = f2bf(h.x), h1 = f2bf(h.y), h2_ = f2bf(h.z), h3 = f2bf(h.w);
                v2u hv; hv.x = h0 | (h1 << 16); hv.y = h2_ | (h3 << 16);
                v2u lv; lv.x = pk2(h.x - bf2f(h0), h.y - bf2f(h1)); lv.y = pk2(h.z - bf2f(h2_), h.w - bf2f(h3));
                *(GAS v2u*)(h2g + token * D + c) = hv;
                const int off = p4_swz(rowi, (lane >> 1) + 32 * j) + (lane & 1) * 8;
                *(LAS v2u*)(thi + off) = hv; *(LAS v2u*)(tlo + off) = lv; }
        }
        __syncthreads();
        { const int mb = F.wave & 1, nb = F.wave >> 1, r = lane & 15, kq = lane >> 4;
          f32x4 acc = (f32x4){0.f, 0.f, 0.f, 0.f};
          const bf16* bh = wrhi + (size_t)(nb * 16 + r) * D + kq * 8; const bf16* bl = wrlo + (size_t)(nb * 16 + r) * D + kq * 8;
#pragma unroll 4
          for (int ks = 0; ks < 32; ++ks) { const int off = p4_swz(mb * 16 + r, ks * 4 + kq);
              const bf16x8 ah = *(const LAS bf16x8*)(thi + off), al = *(const LAS bf16x8*)(tlo + off);
              const bf16x8 bhf = *(const bf16x8*)(bh + ks * 32), blf = *(const bf16x8*)(bl + ks * 32);
              acc = __builtin_amdgcn_mfma_f32_16x16x32_bf16(ah, bhf, acc, 0, 0, 0);
              acc = __builtin_amdgcn_mfma_f32_16x16x32_bf16(al, bhf, acc, 0, 0, 0);
              acc = __builtin_amdgcn_mfma_f32_16x16x32_bf16(ah, blf, acc, 0, 0, 0); }
          __syncthreads();
          LAS float* lg = (LAS float*)F.lds;
#pragma unroll
          for (int i = 0; i < 4; ++i) lg[(mb * 16 + kq * 4 + i) * 65 + nb * 16 + r] = acc[i];
          if (F.tid < 64) ((LAS unsigned*)(F.lds + 16384))[F.tid] = 0u;
        }
        __syncthreads();
        int my_e = 0; float my_w = 0.f; unsigned my_pos = 0u;
        const int tk = F.tid >> 3, gl = F.tid & 7; const size_t rtoken = (size_t)tile * 32 + tk;
        LAS unsigned* hist = (LAS unsigned*)(F.lds + 16384); LAS unsigned* basev = hist + 64;
        if (F.tid < 256) {
            const LAS float* lg = (const LAS float*)F.lds; const int lb = lane & ~7;
            float sc[8], sl[8];
#pragma unroll
            for (int j = 0; j < 8; ++j) { const float x = lg[tk * 65 + gl * 8 + j]; const float s = 1.0f / (1.0f + __expf(-x)); sc[j] = s; sl[j] = s + in[I_RBIAS][gl * 8 + j]; }
            float a = -INFINITY, b2 = -INFINITY;
#pragma unroll
            for (int j = 0; j < 8; ++j) { const float v = sl[j]; if (v > a) { b2 = a; a = v; } else if (v > b2) b2 = v; }
            const float gs = a + b2; int rank = 0;
#pragma unroll
            for (int i = 0; i < 8; ++i) { const float og = __shfl(gs, lb + i); rank += (og > gs || (og == gs && i < gl)) ? 1 : 0; }
            if (rank >= 4) {
#pragma unroll
                for (int j = 0; j < 8; ++j) sl[j] = -INFINITY; }
            float wsum = 0.f, my_s = 0.f;
#pragma unroll
            for (int rd = 0; rd < 8; ++rd) {
                float bv = sl[0]; int be = gl * 8;
#pragma unroll
                for (int j = 1; j < 8; ++j) if (sl[j] > bv) { bv = sl[j]; be = gl * 8 + j; }
#pragma unroll
                for (int msk = 1; msk < 8; msk <<= 1) { const float ov = __shfl_xor(bv, msk); const int oe = __shfl_xor(be, msk); if (ov > bv || (ov == bv && oe < be)) { bv = ov; be = oe; } }
                float ws_ = 0.f;
#pragma unroll
                for (int j = 0; j < 8; ++j) if (be == gl * 8 + j) { ws_ = sc[j]; sl[j] = -INFINITY; }
                const float wsc = __shfl(ws_, lb + (be >> 3));
                wsum += wsc; if (gl == rd) { my_e = be; my_s = wsc; }
            }
            my_w = my_s / wsum * 2.5f;
            my_pos = __hip_atomic_fetch_add(hist + my_e, 1u, __ATOMIC_RELAXED, __HIP_MEMORY_SCOPE_WORKGROUP);
        }
        __syncthreads();
        const int half = (tile * 32) >= (T / 2) ? 1 : 0;
        if (F.tid < 64) { const unsigned c = hist[F.tid]; basev[F.tid] = c ? __hip_atomic_fetch_add(F.ctl + CW_CNT + 64 * (half * 64 + F.tid), c, __ATOMIC_RELAXED, __HIP_MEMORY_SCOPE_AGENT) : 0u; }
        __syncthreads();
        if (F.tid < 256) { const unsigned slot = basev[my_e] + my_pos; const unsigned v = (unsigned)(half * 64 + my_e);
            ((unsigned*)(ws + WS_LISTS))[(size_t)v * LIST_CAP + slot] = (unsigned)rtoken;
            ((unsigned*)(ws + WS_TOKMAP))[rtoken * 8 + gl] = (v << 16) | slot;
            ((float*)(ws + WS_WTS))[rtoken * 8 + gl] = my_w; }
        __syncthreads();
    }
}
}
namespace mk {
__device__ __forceinline__ void moe_prefix(Frame& F) {
    LAS int* pre = (LAS int*)(F.lds + PRE_OFF);
    __syncthreads();
    if (F.tid < 64) {
        const int c0 = (int)__hip_atomic_load(F.ctl + CW_CNT + 64 * (2 * F.tid), RLX_AGENT), c1 = (int)__hip_atomic_load(F.ctl + CW_CNT + 64 * (2 * F.tid + 1), RLX_AGENT);
        const int t0 = (c0 + 255) >> 8, t1 = (c1 + 255) >> 8; int x = t0 + t1;
#pragma unroll
        for (int o = 1; o < 64; o <<= 1) { const int y = __shfl_up(x, o); if (F.lane >= o) x += y; }
        const int excl = x - (t0 + t1);
        pre[2 * F.tid] = excl; pre[2 * F.tid + 1] = excl + t0; if (F.tid == 63) pre[128] = x;
    }
    __syncthreads();
}
__device__ __forceinline__ int moe_find_list(const LAS int* pre, int tile) {
    int lo = 0, hi = 128;
    while (hi - lo > 1) { const int mid = (lo + hi) >> 1; if (pre[mid] <= tile) lo = mid; else hi = mid; }
    return lo;
}

__device__ __forceinline__ void p5(Frame& F) {
    unsigned char* ws = F.ws;
    moe_prefix(F);
    const LAS int* pre = (const LAS int*)(F.lds + PRE_OFF);
    const int NTr = pre[128], NU = (NTr + T / 256) * 2;
    const unsigned* lists = (const unsigned*)(ws + WS_LISTS);
    int n = 0;
    for (int i = 0; i < MAXU; ++i) { const int L = i * F.G + F.vcu; if (L >= NU) break;
        const int tile = L >> 1, pn = L & 1; const void* Bp; LAS unsigned* tab = (LAS unsigned*)(F.lds + TAB_OFF + i * 1024);
        if (tile < NTr) { const int v = moe_find_list(pre, tile), tl = tile - pre[v], e = v & 63;
            const int cnt = (int)__hip_atomic_load(F.ctl + CW_CNT + 64 * v, RLX_AGENT);
            if (F.tid < 256) { const int r = tl * 256 + F.tid; tab[F.tid] = lists[(size_t)v * LIST_CAP + (r < cnt ? r : 0)]; }
            Bp = ws + WS_WGU + ((size_t)e * 512 + (size_t)pn * 256) * D * 2;
        } else { const int ts = tile - NTr; if (F.tid < 256) tab[F.tid] = (unsigned)(ts * 256 + F.tid); Bp = ws + WS_WSGU + (size_t)pn * 256 * D * 2; }
        if (F.tid == 0) put_unit(F, i, ws + WS_H2, Bp, TAB_OFF + i * 1024, tile * 256, pn * 128);
        ++n; }
    __syncthreads();
    pg8::ListSched Sd{(const LAS pg8::UnitRec*)(F.lds + ULIST_OFF), n};
    pg8::EpiSwiglu E{(bf16*)(ws + WS_H), 256};
    pg8::gemm_phase<pg8::EpiSwiglu, pg8::ListSched, true, pg8::NoHook>(F.lds, D, Sd, E, pg8::NoHook{});
}

__device__ __forceinline__ unsigned char* y_base(Frame& F, int NTr) { return F.ws + WS_H + (size_t)(NTr + T / 256) * 256 * 512; }

__device__ __forceinline__ void p6(Frame& F, int hf) {
    unsigned char* ws = F.ws;
    moe_prefix(F);
    const LAS int* pre = (const LAS int*)(F.lds + PRE_OFF);
    const int NTr = pre[128], t0 = pre[64 * hf], nth = pre[64 * hf + 64] - t0;
    unsigned char* Y = y_base(F, NTr);
    const long cap_tiles = ((long)(ws + WS_END - Y)) / (256 * 2048);
    int ntl = nth + T / 512; if (ntl > cap_tiles) ntl = (int)cap_tiles;
    const int NU = ntl * 4;
    int n = 0;
    for (int i = 0; i < MAXU; ++i) { const int L = i * F.G + F.vcu; if (L >= NU) break;
        const int tl = L >> 2, pn = L & 3; const void* Ap; const void* Bp;
        if (tl < nth) { const int tile = t0 + tl, v = moe_find_list(pre, tile), e = v & 63;
            Ap = ws + WS_H + (size_t)tile * 256 * 512; Bp = ws + WS_WD + ((size_t)e * D + (size_t)pn * 256) * 256 * 2;
        } else { const int tile = NTr + (T / 512) * hf + (tl - nth); Ap = ws + WS_H + (size_t)tile * 256 * 512; Bp = ws + WS_WSD + (size_t)pn * 256 * 256 * 2; }
        if (F.tid == 0) put_unit(F, i, Ap, Bp, -1, tl * 256, pn * 256);
        ++n; }
    __syncthreads();
    pg8::ListSched Sd{(const LAS pg8::UnitRec*)(F.lds + ULIST_OFF), n};
    pg8::EpiBf16 E{(bf16*)Y, D};
    pg8::gemm_phase<pg8::EpiBf16, pg8::ListSched, false, pg8::NoHook>(F.lds, 256, Sd, E, pg8::NoHook{});
}

__device__ __forceinline__ void p7(Frame& F, int hf) {
    const float* const* in = F.in; unsigned char* ws = F.ws;
    moe_prefix(F);
    const LAS int* pre = (const LAS int*)(F.lds + PRE_OFF);
    const int NTr = pre[128], t0 = pre[64 * hf], nth = pre[64 * hf + 64] - t0;
    const bf16* Y = (const bf16*)y_base(F, NTr);
    const float* mod = (const float*)(ws + WS_MOD);
    const unsigned* tokmap = (const unsigned*)(ws + WS_TOKMAP); const float* wts = (const float*)(ws + WS_WTS);
    const int gw = F.vcu * NWAVES + F.wave, NGW = F.G * NWAVES, lane = F.lane;
    for (int tt = gw; tt < T / 2; tt += NGW) {
        const size_t token = (size_t)hf * (T / 2) + tt; const int b = (int)(token / S);
        unsigned tm = 0u; float wv = 0.f;
        if (lane < 8) { tm = tokmap[token * 8 + lane]; wv = wts[token * 8 + lane]; }
        f32x4 ff[4];
        { const bf16* yr = Y + ((size_t)nth * 256 + tt) * D;
#pragma unroll
          for (int j = 0; j < 4; ++j) { const v2u u = *(const GAS v2u*)(yr + 4 * lane + 256 * j);
              ff[j] = (f32x4){__uint_as_float(u.x << 16), __uint_as_float(u.x & 0xFFFF0000u), __uint_as_float(u.y << 16), __uint_as_float(u.y & 0xFFFF0000u)}; } }
#pragma unroll
        for (int k = 0; k < 8; ++k) { const unsigned m = (unsigned)__builtin_amdgcn_readlane((int)tm, k); const float w = __uint_as_float((unsigned)__builtin_amdgcn_readlane((int)__float_as_uint(wv), k));
            const int v = (int)(m >> 16), pos = (int)(m & 0xFFFFu);
            const bf16* yr = Y + ((size_t)(pre[v] - t0) * 256 + pos) * D;
#pragma unroll
            for (int j = 0; j < 4; ++j) { const v2u u = *(const GAS v2u*)(yr + 4 * lane + 256 * j);
                ff[j] += (f32x4){__uint_as_float(u.x << 16), __uint_as_float(u.x & 0xFFFF0000u), __uint_as_float(u.y << 16), __uint_as_float(u.y & 0xFFFF0000u)} * w; } }
        float ss = 0.f;
#pragma unroll
        for (int j = 0; j < 4; ++j) ss += (ff[j].x * ff[j].x + ff[j].y * ff[j].y) + (ff[j].z * ff[j].z + ff[j].w * ff[j].w);
        const float rstd = rsqrtf(wave_sum(ss) * (1.f / D) + EPS);
#pragma unroll
        for (int j = 0; j < 4; ++j) { const int c = 4 * lane + 256 * j;
            const f32x4 x1 = *(const GAS f32x4*)(F.out + token * D + c), gt = *(const f32x4*)(mod + b * 6144 + 5120 + c), gp = *(const f32x4*)(in[I_GPOSTFFN] + c);
            *(GAS f32x4*)(F.out + token * D + c) = x1 + gt * (ff[j] * rstd) * gp; }
    }
}
}
namespace mk {
#ifndef MK_NPHASES_DONE
#define MK_NPHASES_DONE 3
#endif
constexpr int PH_P0A = 0, PH_P0B = 1, PH_P1 = 2, PH_P2 = 3, PH_P3 = 4, PH_P4 = 5, PH_P5 = 6, PH_P6A = 7, PH_P7A = 8, PH_P6B = 9, PH_P7B = 10, N_PHASES = 11;

__global__ void __launch_bounds__(NTHR, 2) mk_fwd(Args a) {
    extern __shared__ __attribute__((aligned(16))) unsigned char lds_[];
    Frame F;
    F.lds = (LAS unsigned char*)lds_; F.ws = a.ws; F.ctl = (unsigned*)(a.ws + WS_CTL); F.in = a.in; F.out = a.out;
    F.tid = threadIdx.x; F.lane = F.tid & 63; F.wave = __builtin_amdgcn_readfirstlane(F.tid >> 6);
    F.G = gridDim.x; { const int bx = blockIdx.x; F.vcu = (F.G % 8 == 0) ? (bx % 8) * (F.G / 8) + bx / 8 : bx; }
    for (int u = F.tid; u < 128; u += NTHR) ((LAS unsigned*)(F.lds + LDSCTL_OFF))[u] = 0u;
    __syncthreads();
    const int lo = a.ph_lo, hi = a.ph_hi;
    const bool multi = (hi - lo) > 1;
    XcdBarrier bar; bar.bar = F.ctl + CW_BAR; bar.x = 0; bar.st = nullptr;
    if (multi) bar = xcd_barrier_post(F.ctl + CW_BAR, (volatile LAS unsigned*)(F.lds + MISC_OFF) + 8);
#define IN(k) (lo <= (k) && (k) < hi)
#define SEAM(k) do { if (IN(k) && IN((k) + 1)) xcd_barrier(bar); } while (0)
    if (IN(PH_P0A)) { p0a(F); } SEAM(PH_P0A);
    if (IN(PH_P0B)) { p0b(F); } SEAM(PH_P0B);
    if (IN(PH_P1)) { p1(F); } SEAM(PH_P1);
#if MK_NPHASES_DONE > 3
    if (IN(PH_P2)) { p2(F); } SEAM(PH_P2);
#endif
#if MK_NPHASES_DONE > 4
    if (IN(PH_P3)) { p3(F); } SEAM(PH_P3);
#endif
#if MK_NPHASES_DONE > 5
    if (IN(PH_P4)) { p4(F); } SEAM(PH_P4);
#endif
#if MK_NPHASES_DONE > 6
    if (IN(PH_P5)) { p5(F); } SEAM(PH_P5);
#endif
#if MK_NPHASES_DONE > 7
    if (IN(PH_P6A)) { p6(F, 0); } SEAM(PH_P6A);
    if (IN(PH_P7A)) { p7(F, 0); } SEAM(PH_P7A);
    if (IN(PH_P6B)) { p6(F, 1); } SEAM(PH_P6B);
    if (IN(PH_P7B)) { p7(F, 1); }
#endif
#undef IN
#undef SEAM
}

static int g_grid = 0;
static bool setup_once() {
    if (g_grid == 0) {
        int dev = 0, cus = 0;
        if (hipGetDevice(&dev) != hipSuccess || hipDeviceGetAttribute(&cus, hipDeviceAttributeMultiprocessorCount, dev) != hipSuccess) { g_grid = -1; return false; }
        if (hipFuncSetAttribute((const void*)mk_fwd, hipFuncAttributeMaxDynamicSharedMemorySize, LDS_BYTES) != hipSuccess) { g_grid = -1; return false; }
        (void)hipGetLastError();
        g_grid = cus;
    }
    return g_grid > 0;
}
static void launch_phases(void* const* d_in, void* d_out, void* d_ws, hipStream_t stream, int lo, int hi) {
    Args a{};
    for (int i = 0; i < N_IN; ++i) a.in[i] = (const float*)d_in[i];
    a.out = (float*)d_out; a.ws = (unsigned char*)d_ws; a.ph_lo = lo; a.ph_hi = hi;
    hipLaunchKernelGGL(mk_fwd, dim3(g_grid), dim3(NTHR), LDS_BYTES, stream, a);
}
}
extern "C" void kernel_launch(void* const* d_in, const int* in_sizes, int n_in, void* d_out, int out_size, void* d_ws, size_t ws_size, hipStream_t stream) {
    if (!mk::setup_once()) return;
    if (ws_size < mk::WS_END) return;
    hipMemsetAsync(d_ws, 0, mk::CTL_ZERO_BYTES, stream);
    mk::launch_phases(d_in, d_out, d_ws, stream, 0, mk::N_PHASES);
}
```

```cpp
#include <hip/hip_runtime.h>
#include <cstdio>
#include <cstdint>
#include <cmath>
#include <hip/hip_bf16.h>
#define MK_NPHASES_DONE 9
namespace pg8 {
#define PG8_LAS __attribute__((address_space(3)))
typedef unsigned short bf16_t;
typedef short bf16x8 __attribute__((ext_vector_type(8)));
typedef float f32x4 __attribute__((ext_vector_type(4)));
typedef unsigned u32x4 __attribute__((ext_vector_type(4)));
typedef unsigned u32x2 __attribute__((ext_vector_type(2)));
constexpr int BM = 256, BK = 64, HALF = 128, HTB = HALF * BK * 2, STAGE_BYTES = 8 * HTB;

__host__ __device__ __forceinline__ int lds_byte(int r, int c) { const int st = (r >> 4) * 2 + (c >> 5), rr = r & 15, cc = c & 31, ob = rr * 64 + cc * 2; return st * 1024 + (ob ^ (((ob >> 9) & 1) << 5)); }
__host__ __device__ __forceinline__ void stage_rc(int b, int& R, int& C) { const int st = b / 1024, sb = b % 1024, swz = sb ^ (((sb >> 9) & 1) << 5); R = (st >> 1) * 16 + swz / 64; C = (st & 1) * 32 + (swz % 64) / 2; }
__host__ __device__ __forceinline__ int perm32(int rho) { const int n = rho >> 4, i = rho & 15; return 8 * (i >> 2) + 4 * n + (i & 3); }

struct Unit { const char* A; const char* B; int tab; int orow; int ocol; int aux; };
struct UnitRec { unsigned long long A, B; int tab, orow, ocol, aux; };
struct ListSched {
    const PG8_LAS UnitRec* list; int n;
    __device__ __forceinline__ bool next(int i, Unit& u) const {
        if (i >= n) return false;
        const PG8_LAS UnitRec* r = list + i;
        const unsigned long long a = r->A, b = r->B;
        const unsigned alo = __builtin_amdgcn_readfirstlane((unsigned)a), ahi = __builtin_amdgcn_readfirstlane((unsigned)(a >> 32));
        const unsigned blo = __builtin_amdgcn_readfirstlane((unsigned)b), bhi = __builtin_amdgcn_readfirstlane((unsigned)(b >> 32));
        u.A = (const char*)(((unsigned long long)ahi << 32) | alo); u.B = (const char*)(((unsigned long long)bhi << 32) | blo);
        u.tab = __builtin_amdgcn_readfirstlane(r->tab); u.orow = __builtin_amdgcn_readfirstlane(r->orow); u.ocol = __builtin_amdgcn_readfirstlane(r->ocol); u.aux = __builtin_amdgcn_readfirstlane(r->aux);
        return true;
    }
};
struct NoHook { __device__ __forceinline__ void at(int, f32x4 (&)[2][2][4][2], int, int, int) const {} };

__device__ __forceinline__ unsigned cvt_pk_bf16(float lo, float hi) { unsigned r; asm volatile("v_cvt_pk_bf16_f32 %0, %1, %2" : "=v"(r) : "v"(lo), "v"(hi)); return r; }

struct EpiBf16 {
    static constexpr bool PERM = true;
    bf16_t* O; int ldc;
    __device__ __forceinline__ void operator()(const f32x4 (&acc)[2][2][4][2], const Unit& u, int wr, int wc, int fr, int fq) const {
        const int row0 = u.orow + wr * 64 + fr, col0 = u.ocol + wc * 32 + 8 * fq;
#pragma unroll
        for (int ai = 0; ai < 2; ++ai)
#pragma unroll
            for (int m = 0; m < 4; ++m) { bf16_t* rowp = O + (size_t)(row0 + ai * HALF + m * 16) * ldc + col0;
#pragma unroll
                for (int bj = 0; bj < 2; ++bj) { const f32x4 v0 = acc[ai][bj][m][0], v1 = acc[ai][bj][m][1];
                    u32x4 w; w.x = cvt_pk_bf16(v0[0], v0[1]); w.y = cvt_pk_bf16(v0[2], v0[3]); w.z = cvt_pk_bf16(v1[0], v1[1]); w.w = cvt_pk_bf16(v1[2], v1[3]);
                    *(u32x4*)(rowp + bj * HALF) = w; } }
    }
};
struct EpiRowScaleBf16 {
    static constexpr bool PERM = true;
    bf16_t* O; int ldc; const PG8_LAS float* rs;
    __device__ __forceinline__ void operator()(const f32x4 (&acc)[2][2][4][2], const Unit& u, int wr, int wc, int fr, int fq) const {
        const int row0 = u.orow + wr * 64 + fr, col0 = u.ocol + wc * 32 + 8 * fq;
#pragma unroll
        for (int ai = 0; ai < 2; ++ai)
#pragma unroll
            for (int m = 0; m < 4; ++m) { bf16_t* rowp = O + (size_t)(row0 + ai * HALF + m * 16) * ldc + col0; const float s = rs[ai * HALF + wr * 64 + m * 16 + fr];
#pragma unroll
                for (int bj = 0; bj < 2; ++bj) { const f32x4 v0 = acc[ai][bj][m][0] * s, v1 = acc[ai][bj][m][1] * s;
                    u32x4 w; w.x = cvt_pk_bf16(v0[0], v0[1]); w.y = cvt_pk_bf16(v0[2], v0[3]); w.z = cvt_pk_bf16(v1[0], v1[1]); w.w = cvt_pk_bf16(v1[2], v1[3]);
                    *(u32x4*)(rowp + bj * HALF) = w; } }
    }
};
struct EpiFp8 {
    static constexpr bool PERM = true;
    unsigned char* O; int ldc;
    __device__ __forceinline__ void operator()(const f32x4 (&acc)[2][2][4][2], const Unit& u, int wr, int wc, int fr, int fq) const {
        const int row0 = u.orow + wr * 64 + fr, col0 = u.ocol + wc * 32 + 8 * fq;
#pragma unroll
        for (int ai = 0; ai < 2; ++ai)
#pragma unroll
            for (int m = 0; m < 4; ++m) { unsigned char* rowp = O + (size_t)(row0 + ai * HALF + m * 16) * ldc + col0;
#pragma unroll
                for (int bj = 0; bj < 2; ++bj) { f32x4 v0 = acc[ai][bj][m][0] * 16.0f, v1 = acc[ai][bj][m][1] * 16.0f;
#pragma unroll
                    for (int j = 0; j < 4; ++j) { v0[j] = __builtin_amdgcn_fmed3f(v0[j], -448.f, 448.f); v1[j] = __builtin_amdgcn_fmed3f(v1[j], -448.f, 448.f); }
                    int p0 = __builtin_amdgcn_cvt_pk_fp8_f32(v0[0], v0[1], 0, false); p0 = __builtin_amdgcn_cvt_pk_fp8_f32(v0[2], v0[3], p0, true);
                    int p1 = __builtin_amdgcn_cvt_pk_fp8_f32(v1[0], v1[1], 0, false); p1 = __builtin_amdgcn_cvt_pk_fp8_f32(v1[2], v1[3], p1, true);
                    u32x2 w; w.x = (unsigned)p0; w.y = (unsigned)p1; *(u32x2*)(rowp + bj * HALF) = w; } }
    }
};
__device__ __forceinline__ float silu_mul(float g, float u) { return g * u * __builtin_amdgcn_rcpf(1.0f + __builtin_amdgcn_exp2f(-1.4426950408889634f * g)); }
struct EpiSwiglu {
    static constexpr bool PERM = true;
    bf16_t* O; int ldc;
    __device__ __forceinline__ void operator()(const f32x4 (&acc)[2][2][4][2], const Unit& u, int wr, int wc, int fr, int fq) const {
        const int row0 = u.orow + wr * 64 + fr, col0 = u.ocol + wc * 32 + 8 * fq;
#pragma unroll
        for (int ai = 0; ai < 2; ++ai)
#pragma unroll
            for (int m = 0; m < 4; ++m) { bf16_t* rowp = O + (size_t)(row0 + ai * HALF + m * 16) * ldc + col0;
                const f32x4 g0 = acc[ai][0][m][0], g1 = acc[ai][0][m][1], u0 = acc[ai][1][m][0], u1 = acc[ai][1][m][1];
                u32x4 w; w.x = cvt_pk_bf16(silu_mul(g0[0], u0[0]), silu_mul(g0[1], u0[1])); w.y = cvt_pk_bf16(silu_mul(g0[2], u0[2]), silu_mul(g0[3], u0[3]));
                w.z = cvt_pk_bf16(silu_mul(g1[0], u1[0]), silu_mul(g1[1], u1[1])); w.w = cvt_pk_bf16(silu_mul(g1[2], u1[2]), silu_mul(g1[3], u1[3]));
                *(u32x4*)rowp = w; }
    }
};

template <class Epi, class Sched, bool GATHER, class Hook>
__device__ __forceinline__ void gemm_phase(PG8_LAS unsigned char* lds, const int K, const Sched& S, const Epi& E, const Hook& H, const int wid  ) {
    int lane; asm volatile("v_mbcnt_lo_u32_b32 %0, -1, 0\n\tv_mbcnt_hi_u32_b32 %0, -1, %0" : "=v"(lane));
    const int tid = wid * 64 + lane, wr = wid >> 2, wc = wid & 3, fr = lane & 15, fq = lane >> 4;
    const int nt = K / BK;
    unsigned voffB[2];
#pragma unroll
    for (int i = 0; i < 2; ++i) { int R, C; stage_rc(tid * 16 + i * 8192, R, C); const int Rb = Epi::PERM ? ((R & ~31) + perm32(R & 31)) : R; voffB[i] = (unsigned)(Rb * K + C) * 2u; }
    const size_t kstep = (size_t)(BK * 2);
    const size_t hstep = (size_t)HALF * K * 2;
    const unsigned ldsw = (unsigned)wid * 1024u;
    const int aoff = lds_byte(wr * 64 + fr, fq * 8), boff = lds_byte(wc * 32 + fr, fq * 8);
    unsigned offC[2][2];
#define PG8_LOADOFF(dst, u) do { _Pragma("unroll") for (int _i = 0; _i < 2; ++_i) { int _R, _C; stage_rc(tid * 16 + _i * 8192, _R, _C); _Pragma("unroll") for (int _h = 0; _h < 2; ++_h) { \
        if constexpr (GATHER) { const unsigned _row = *(const PG8_LAS unsigned*)(lds + (u).tab + 4 * (_h * HALF + _R)); dst[_h][_i] = _row * (unsigned)(K * 2) + (unsigned)(_C * 2); } \
        else dst[_h][_i] = (unsigned)((_h * HALF + _R) * K + _C) * 2u; } } } while (0)
#define PG8_SA(b, h) (((b) * 2 + (h)) * HTB)
#define PG8_SB(b, h) ((4 + (b) * 2 + (h)) * HTB)
#define PG8_STAGE(bufoff, gbase, voff) do { _Pragma("unroll") for (int _i = 0; _i < 2; ++_i) \
        __builtin_amdgcn_global_load_lds((const unsigned*)((const char*)(gbase) + (voff)[_i]), (PG8_LAS unsigned*)(lds + (bufoff) + ldsw + _i * 8192), 16, 0, 0); } while (0)
#define PG8_LDA(dst, b, h) do { _Pragma("unroll") for (int m = 0; m < 4; ++m) _Pragma("unroll") for (int k = 0; k < 2; ++k) dst[m][k] = *(const PG8_LAS bf16x8*)(lds + PG8_SA(b, h) + aoff + m * 2048 + k * 1024); } while (0)
#define PG8_LDB(dst, b, h) do { _Pragma("unroll") for (int n = 0; n < 2; ++n) _Pragma("unroll") for (int k = 0; k < 2; ++k) dst[n][k] = *(const PG8_LAS bf16x8*)(lds + PG8_SB(b, h) + boff + n * 2048 + k * 1024); } while (0)
#define PG8_MMA(ai, bj, At, Bt) do { __builtin_amdgcn_s_setprio(1); _Pragma("unroll") for (int m = 0; m < 4; ++m) _Pragma("unroll") for (int n = 0; n < 2; ++n) _Pragma("unroll") for (int k = 0; k < 2; ++k) \
        acc[ai][bj][m][n] = __builtin_amdgcn_mfma_f32_16x16x32_bf16(Bt[n][k], At[m][k], acc[ai][bj][m][n], 0, 0, 0); __builtin_amdgcn_s_setprio(0); } while (0)
#define PG8_WAIT_V(n) asm volatile("s_waitcnt vmcnt(" #n ")" ::: "memory")
#define PG8_WAIT_L(n) asm volatile("s_waitcnt lgkmcnt(" #n ")" ::: "memory")
#define PG8_BAR __builtin_amdgcn_s_barrier()
#define PG8_SCHED __builtin_amdgcn_sched_barrier(0)
    Unit cur, nxt; int ui = 0;
    if (!S.next(0, cur)) return;
    f32x4 acc[2][2][4][2];
#pragma unroll
    for (int a = 0; a < 2; ++a)
#pragma unroll
        for (int b = 0; b < 2; ++b)
#pragma unroll
            for (int m = 0; m < 4; ++m)
#pragma unroll
                for (int n = 0; n < 2; ++n) acc[a][b][m][n] = (f32x4){0.f, 0.f, 0.f, 0.f};
    bf16x8 At[4][2], B0[2][2], B1[2][2];
    const char* cA = cur.A; const char* cB = cur.B;
    PG8_LOADOFF(offC, cur);
    PG8_STAGE(PG8_SB(0, 0), cB, voffB); PG8_STAGE(PG8_SB(0, 1), cB + hstep, voffB); PG8_STAGE(PG8_SA(0, 0), cA, offC[0]); PG8_STAGE(PG8_SA(0, 1), cA, offC[1]);
    if (wr == 1) PG8_BAR;
    PG8_WAIT_V(2); PG8_BAR;
    PG8_STAGE(PG8_SB(1, 0), cB + kstep, voffB); PG8_STAGE(PG8_SA(1, 0), cA + kstep, offC[0]); PG8_STAGE(PG8_SB(1, 1), cB + hstep + kstep, voffB);
    PG8_WAIT_V(6); PG8_BAR;
    for (;;) {
        const bool has_next = S.next(ui + 1, nxt);
        const char* nA = has_next ? nxt.A : cA; const char* nB = has_next ? nxt.B : cB;
        for (int t = 0; t < nt; t += 2) {
            const bool last = (t == nt - 2);
            H.at(t, acc, wr, fr, lane);
            const char* a1 = cA + (size_t)(t + 1) * kstep;
            const char* a2 = last ? nA : cA + (size_t)(t + 2) * kstep; const char* b2 = last ? nB : cB + (size_t)(t + 2) * kstep;
            const char* a3 = a2 + kstep; const char* b3 = b2 + kstep;
            PG8_LDB(B0, 0, 0); PG8_LDB(B1, 0, 1); PG8_SCHED; PG8_LDA(At, 0, 0); PG8_STAGE(PG8_SA(1, 1), a1, offC[1]);
            if constexpr (GATHER) { if (last && has_next) { PG8_LOADOFF(offC, nxt); } }
            PG8_WAIT_V(8); PG8_WAIT_L(0); PG8_BAR; PG8_MMA(0, 0, At, B0); PG8_MMA(0, 1, At, B1); PG8_BAR; PG8_SCHED;
            PG8_LDA(At, 0, 1); PG8_STAGE(PG8_SB(0, 0), b2, voffB); PG8_STAGE(PG8_SB(0, 1), b2 + hstep, voffB); PG8_STAGE(PG8_SA(0, 0), a2, offC[0]);
            PG8_WAIT_V(8); PG8_WAIT_L(0); PG8_BAR; PG8_MMA(1, 0, At, B0); PG8_MMA(1, 1, At, B1); PG8_BAR; PG8_SCHED;
            PG8_LDB(B0, 1, 0); PG8_LDB(B1, 1, 1); PG8_SCHED; PG8_LDA(At, 1, 0); PG8_STAGE(PG8_SA(0, 1), a2, offC[1]);
            PG8_WAIT_V(8); PG8_WAIT_L(0); PG8_BAR; PG8_MMA(0, 0, At, B0); PG8_MMA(0, 1, At, B1); PG8_BAR; PG8_SCHED;
            PG8_LDA(At, 1, 1); PG8_STAGE(PG8_SB(1, 0), b3, voffB); PG8_STAGE(PG8_SB(1, 1), b3 + hstep, voffB); PG8_STAGE(PG8_SA(1, 0), a3, offC[0]);
            PG8_WAIT_V(8); PG8_WAIT_L(0); PG8_BAR; PG8_MMA(1, 0, At, B0); PG8_MMA(1, 1, At, B1); PG8_BAR; PG8_SCHED;
        }
        if (wr == 0) PG8_BAR;
        { int l2; asm volatile("v_mbcnt_lo_u32_b32 %0, -1, 0\n\tv_mbcnt_hi_u32_b32 %0, -1, %0" : "=v"(l2)); E(acc, cur, wr, wc, l2 & 15, l2 >> 4); }
        if (!has_next) break;
#pragma unroll
        for (int a = 0; a < 2; ++a)
#pragma unroll
            for (int b = 0; b < 2; ++b)
#pragma unroll
                for (int m = 0; m < 4; ++m)
#pragma unroll
                    for (int n = 0; n < 2; ++n) acc[a][b][m][n] = (f32x4){0.f, 0.f, 0.f, 0.f};
        cur = nxt; cA = nA; cB = nB; ++ui;
        if (wr == 1) PG8_BAR;
    }
    PG8_WAIT_V(0);
    PG8_BAR;
#undef PG8_LOADOFF
#undef PG8_SA
#undef PG8_SB
#undef PG8_STAGE
#undef PG8_LDA
#undef PG8_LDB
#undef PG8_MMA
#undef PG8_WAIT_V
#undef PG8_WAIT_L
#undef PG8_BAR
#undef PG8_SCHED
}
}
namespace mk {
#define GAS __attribute__((address_space(1)))
#define LAS __attribute__((address_space(3)))
typedef unsigned short bf16;
typedef unsigned v4u __attribute__((ext_vector_type(4)));
typedef unsigned v2u __attribute__((ext_vector_type(2)));
typedef float f32x4 __attribute__((ext_vector_type(4)));
typedef short bf16x8 __attribute__((ext_vector_type(8)));

constexpr int T = 16384, D = 1024, S = 2048, NB = 8, NH = 8, HD = 64, NE = 64, DIN = 2056;
constexpr int NTHR = 512, NWAVES = 8;
constexpr float EPS = 1e-6f;
constexpr float LOG2E = 1.4426950408889634f;
constexpr float QSCALE = 0.125f * LOG2E;
constexpr int NLIST = 64, LIST_CAP = 16384;

constexpr size_t MiB = 1u << 20;
constexpr size_t WS_CTL = 0, CTL_ZERO_BYTES = 1 * MiB;
constexpr size_t WS_SMALL = 1 * MiB;
constexpr size_t WS_MOD = WS_SMALL, WS_WF = WS_SMALL + 256 * 1024, WS_LOGF = WS_SMALL + 512 * 1024, WS_SSQP = WS_SMALL + 1 * MiB, WS_SSQA = WS_SSQP + 512 * 1024,
                 WS_TOKMAP = WS_SSQA + 512 * 1024, WS_WTS = WS_TOKMAP + 512 * 1024, WS_LISTS = WS_WTS + 512 * 1024;
constexpr size_t WS_WD = 8 * MiB, WS_WSD = 40 * MiB;
constexpr size_t WS_H = 40 * MiB + 512 * 1024;
constexpr size_t WS_HB = 41 * MiB, WS_PROJ = 73 * MiB, WS_YCAT = 41 * MiB, WS_MIXED = 73 * MiB;
constexpr size_t WS_WIN = 190 * MiB, WS_WOUT = 194 * MiB, WS_WSGU = 196 * MiB, WS_WPOOL = 197 * MiB, WS_WRHI = WS_WPOOL + 128 * 1024, WS_WRLO = WS_WRHI + 128 * 1024;
constexpr size_t WS_H2 = 199 * MiB, WS_WGU = 231 * MiB, WS_END = 295 * MiB;
static_assert(WS_LISTS + (size_t)NLIST * LIST_CAP * 4 <= WS_WD && WS_WRLO + 128 * 1024 <= WS_H2, "ws map");
constexpr int CW_TMO = 0, CW_BAR = 4096, CW_CNT = 8192;

constexpr int RING_BYTES = 131072, LDSCTL_OFF = RING_BYTES, MISC_OFF = LDSCTL_OFF, ULIST_OFF = LDSCTL_OFF + 512, PRE_OFF = ULIST_OFF + 512, TAB_OFF = PRE_OFF + 528,
              RS_OFF = TAB_OFF + 8192, LDS_BYTES = 147456;
constexpr int MAXU = 8;
static_assert(RS_OFF + 2048 <= LDS_BYTES && (TAB_OFF % 16) == 0, "LDS map");

#define RLX_AGENT __ATOMIC_RELAXED, __HIP_MEMORY_SCOPE_AGENT
#define LDS_WAIT() asm volatile("s_waitcnt lgkmcnt(0)" ::: "memory")
#define VM_WAIT() asm volatile("s_waitcnt vmcnt(0)" ::: "memory")
__device__ __forceinline__ unsigned f2bf(float f) { unsigned u = __builtin_bit_cast(unsigned, f); return (u + 0x7fffu + ((u >> 16) & 1u)) >> 16; }
__device__ __forceinline__ unsigned pk2(float lo, float hi) { return f2bf(lo) | (f2bf(hi) << 16); }
__device__ __forceinline__ float bf2f(unsigned h) { return __builtin_bit_cast(float, h << 16); }
__device__ __forceinline__ float wave_sum(float v) {
#pragma unroll
    for (int o = 1; o < 64; o <<= 1) v += __shfl_xor(v, o);
    return v;
}

#define XB_TMO      128
#define XB_XCNT(j)  (256  + 64 * (j))
#define XB_XSUB(j)  (1280 + 64 * (j))
#define XB_XGEN(j)  (2304 + 64 * (j))
#define XB_TOP      3328
#define XB_TOPGEN   3392
#define XCD_BAR_WORDS 3456
#define XB_SPIN_CAP (1u << 18)
__device__ __forceinline__ unsigned xb_ld(unsigned* p)              { return __hip_atomic_load(p, __ATOMIC_RELAXED, __HIP_MEMORY_SCOPE_AGENT); }
__device__ __forceinline__ unsigned xb_add(unsigned* p, unsigned v) { return __hip_atomic_fetch_add(p, v, __ATOMIC_RELAXED, __HIP_MEMORY_SCOPE_AGENT); }
__device__ __forceinline__ unsigned xb_xcc_id() { return (unsigned)__builtin_amdgcn_s_getreg((3 << 11) | 20) & 0xFu; }
#define XB_SPIN(cond, bar) do { unsigned _sp = 0; while (cond) { __builtin_amdgcn_s_sleep(1); \
    if ((++_sp & 255u) == 0u) { if (xb_ld(&(bar)[XB_TMO])) break; if (_sp > XB_SPIN_CAP) { atomicAdd(&(bar)[XB_TMO], 1u); break; } } } } while (0)
struct XcdBarrier { unsigned* bar; unsigned x; volatile LAS unsigned* st; };
__device__ __forceinline__ XcdBarrier xcd_barrier_post(unsigned* bar, volatile LAS unsigned* st) {
    XcdBarrier b; b.bar = bar; b.x = xb_xcc_id(); b.st = st;
    if (threadIdx.x == 0) (void)xb_add(&bar[XB_XCNT(b.x)], 1u);
    return b;
}
__device__ __forceinline__ void xcd_barrier_complete(unsigned* bar, unsigned x, unsigned& nloc, unsigned& nx) {
    const unsigned G = gridDim.x * gridDim.y * gridDim.z;
    unsigned sum, cnt, mine, sp = 0u;
    for (;;) {
        sum = 0u; cnt = 0u; mine = 0u;
#pragma unroll
        for (unsigned j = 0; j < 16; ++j) { const unsigned c = xb_ld(&bar[XB_XCNT(j)]); sum += c; cnt += (c > 0u) ? 1u : 0u; mine = (j == x) ? c : mine; }
        if (sum == G) break;
        __builtin_amdgcn_s_sleep(1);
        if ((++sp & 255u) == 0u) { if (xb_ld(&bar[XB_TMO])) break; if (sp > XB_SPIN_CAP) { atomicAdd(&bar[XB_TMO], 1u); break; } }
    }
    nloc = mine > 0u ? mine : 1u; nx = cnt > 0u ? cnt : 1u;
}
__device__ __forceinline__ void xcd_barrier(const XcdBarrier& b) {
    asm volatile("s_waitcnt vmcnt(0)" ::: "memory");
    __syncthreads();
    if (threadIdx.x == 0) {
        unsigned* bar = b.bar;
        __builtin_amdgcn_s_waitcnt(0);
        unsigned nloc = b.st[0], nx = b.st[1];
        if (nloc == 0u) { xcd_barrier_complete(bar, b.x, nloc, nx); b.st[0] = nloc; b.st[1] = nx; }
        const unsigned old = xb_add(&bar[XB_XSUB(b.x)], 1u);
        const unsigned gen = old / nloc;
        if (old + 1u == (gen + 1u) * nloc) {
            __builtin_amdgcn_fence(__ATOMIC_RELEASE, "agent");
            asm volatile("s_waitcnt vmcnt(0)" ::: "memory");
            const unsigned og = xb_add(&bar[XB_TOP], 1u);
            const unsigned tg = og / nx;
            if (og + 1u == (tg + 1u) * nx) xb_add(&bar[XB_TOPGEN], 1u);
            else XB_SPIN(xb_ld(&bar[XB_TOPGEN]) == tg, bar);
            __builtin_amdgcn_fence(__ATOMIC_ACQUIRE, "agent");
            xb_add(&bar[XB_XGEN(b.x)], 1u);
            asm volatile("s_waitcnt vmcnt(0)" ::: "memory");
        } else {
            XB_SPIN(xb_ld(&bar[XB_XGEN(b.x)]) == gen, bar);
            __builtin_amdgcn_fence(__ATOMIC_ACQUIRE, "agent");
            asm volatile("s_waitcnt vmcnt(0)" ::: "memory");
        }
    }
    __syncthreads();
}

enum { I_X = 0, I_C, I_WADA, I_BADA, I_GPREMIX, I_GPOSTMIX, I_GPREFFN, I_GPOSTFFN, I_WIN, I_BFORGET, I_WPOOL, I_POOLSCALE, I_GPOOLOUT, I_GATTNOUT, I_WOUT,
       I_WROUTER, I_RBIAS, I_WGATE, I_WUP, I_WDOWN, I_WSGATE, I_WSUP, I_WSDOWN, N_IN };

struct Args { const float* in[N_IN]; float* out; unsigned char* ws; int ph_lo, ph_hi; };

struct Frame {
    LAS unsigned char* lds; unsigned* ctl; unsigned char* ws; const float* const* in; float* out;
    int tid, lane, wave, vcu, G;
};
}
namespace mk {
template <int MODE>
__device__ __forceinline__ void tr_item(const float* W, int ldn, int k0, int n0, bf16* WT, bf16* WT2, int Kd, int rowbase, const float* sc, float cmul, LAS float* scr, int lane) {
#pragma unroll 8
    for (int i = 0; i < 32; ++i) { const int kk = 2 * i + (lane >> 5); scr[kk * 33 + (lane & 31)] = W[(size_t)(k0 + kk) * ldn + n0 + (lane & 31)]; }
    LDS_WAIT(); asm volatile("" ::: "memory");
    const int c = lane & 7;
#pragma unroll
    for (int j = 0; j < 4; ++j) { const int n = (lane >> 3) + 8 * j; const LAS float* s = scr + (8 * c) * 33 + n;
        float v[8];
#pragma unroll
        for (int i = 0; i < 8; ++i) { v[i] = s[i * 33] * cmul; if (MODE == 1) v[i] *= sc[k0 + 8 * c + i]; if (MODE == 2) v[i] *= sc[n0 + n]; }
        v4u o; o.x = pk2(v[0], v[1]); o.y = pk2(v[2], v[3]); o.z = pk2(v[4], v[5]); o.w = pk2(v[6], v[7]);
        *(GAS v4u*)(WT + (size_t)(rowbase + n) * Kd + k0 + 8 * c) = o;
        if (MODE == 3) {
#pragma unroll
            for (int i = 0; i < 8; ++i) v[i] = v[i] - bf2f(f2bf(v[i]));
            v4u p; p.x = pk2(v[0], v[1]); p.y = pk2(v[2], v[3]); p.z = pk2(v[4], v[5]); p.w = pk2(v[6], v[7]);
            *(GAS v4u*)(WT2 + (size_t)(rowbase + n) * Kd + k0 + 8 * c) = p; } }
    LDS_WAIT(); asm volatile("" ::: "memory");
}

__device__ __forceinline__ void p0a(Frame& F) {
    const float* const* in = F.in; unsigned char* ws = F.ws;
    if (F.vcu < 192) {
        LAS float* red = (LAS float*)F.lds;
        const int col0 = 32 * F.vcu, kk = F.tid >> 3, c4 = F.tid & 7;
        const float* wa = in[I_WADA]; const float* cc = in[I_C];
        f32x4 acc[8];
#pragma unroll
        for (int b = 0; b < 8; ++b) acc[b] = (f32x4){0.f, 0.f, 0.f, 0.f};
#pragma unroll 4
        for (int i = 0; i < 16; ++i) { const int k = kk + 64 * i; const f32x4 w = *(const f32x4*)(wa + (size_t)k * 6144 + col0 + 4 * c4);
#pragma unroll
            for (int b = 0; b < 8; ++b) acc[b] += w * cc[b * D + k]; }
#pragma unroll
        for (int b = 0; b < 8; ++b) *(LAS f32x4*)(red + kk * 256 + b * 32 + 4 * c4) = acc[b];
        __syncthreads();
        if (F.tid < 256) { float s = 0.f;
#pragma unroll 8
            for (int k2 = 0; k2 < 64; ++k2) s += red[k2 * 256 + F.tid];
            const int b = F.tid >> 5, c = F.tid & 31; ((float*)(ws + WS_MOD))[b * 6144 + col0 + c] = s + in[I_BADA][col0 + c]; }
        __syncthreads();
    }
    if (F.vcu == 255) { float* wf = (float*)(ws + WS_WF); for (int i = F.tid; i < 8192; i += NTHR) { const int j = i >> 10, k = i & 1023; wf[i] = in[I_WIN][(size_t)k * DIN + 2048 + j]; } }
    LAS float* scr = (LAS float*)(F.lds + F.wave * 16384);
    const int gw = F.vcu * NWAVES + F.wave, NGW = F.G * NWAVES, lane = F.lane;
    constexpr int I_E = 8192, I_IN = 1024, I_OUT = 512, I_S = 128, I_P = 32, I_R = 32;
    constexpr int NITEMS = 3 * I_E + I_IN + I_OUT + 3 * I_S + I_P + I_R;
    bf16* Wgu = (bf16*)(ws + WS_WGU); bf16* Wd = (bf16*)(ws + WS_WD);
    for (int it = gw; it < NITEMS; it += NGW) {
        int r = it;
        if (r < 2 * I_E) { const int up = r >= I_E; if (up) r -= I_E; const int e = r >> 7, rem = r & 127, k0 = 64 * (rem >> 3), n0 = 32 * (rem & 7);
            tr_item<0>(in[up ? I_WUP : I_WGATE] + (size_t)e * D * 256, 256, k0, n0, Wgu + (size_t)e * 512 * D, nullptr, D, (n0 >> 7) * 256 + (n0 & 127) + (up ? 128 : 0), nullptr, 1.f, scr, lane); continue; }
        r -= 2 * I_E;
        if (r < I_E) { const int e = r >> 7, rem = r & 127, k0 = 64 * (rem >> 5), n0 = 32 * (rem & 31);
            tr_item<0>(in[I_WDOWN] + (size_t)e * 256 * D, D, k0, n0, Wd + (size_t)e * D * 256, nullptr, 256, n0, nullptr, 1.f, scr, lane); continue; }
        r -= I_E;
        if (r < I_IN) { const int k0 = 64 * (r >> 6), n0 = 32 * (r & 63);
            tr_item<0>(in[I_WIN], DIN, k0, n0, (bf16*)(ws + WS_WIN), nullptr, D, n0, nullptr, (n0 >= 512 && n0 < 1024) ? QSCALE : 1.f, scr, lane); continue; }
        r -= I_IN;
        if (r < I_OUT) { const int k0 = 64 * (r >> 5), n0 = 32 * (r & 31);
            tr_item<1>(in[I_WOUT], D, k0, n0, (bf16*)(ws + WS_WOUT), nullptr, D, n0, k0 < 512 ? in[I_GPOOLOUT] : in[I_GATTNOUT] - 512, 1.f, scr, lane); continue; }
        r -= I_OUT;
        if (r < 2 * I_S) { const int up = r >= I_S; if (up) r -= I_S; const int k0 = 64 * (r >> 3), n0 = 32 * (r & 7);
            tr_item<0>(in[up ? I_WSUP : I_WSGATE], 256, k0, n0, (bf16*)(ws + WS_WSGU), nullptr, D, (n0 >> 7) * 256 + (n0 & 127) + (up ? 128 : 0), nullptr, 1.f, scr, lane); continue; }
        r -= 2 * I_S;
        if (r < I_S) { const int k0 = 64 * (r >> 5), n0 = 32 * (r & 31);
            tr_item<0>(in[I_WSDOWN], D, k0, n0, (bf16*)(ws + WS_WSD), nullptr, 256, n0, nullptr, 1.f, scr, lane); continue; }
        r -= I_S;
        if (r < I_P) { const int g = r >> 3, rem = r & 7, k0 = 64 * (rem >> 2), n0 = 32 * (rem & 3);
            tr_item<2>(in[I_WPOOL] + (size_t)g * 16384, 128, k0, n0, (bf16*)(ws + WS_WPOOL) + (size_t)g * 16384, nullptr, 128, n0, in[I_POOLSCALE] + g * 128, 1.f, scr, lane); continue; }
        r -= I_P;
        { const int k0 = 64 * (r >> 1), n0 = 32 * (r & 1);
            tr_item<3>(in[I_WROUTER], 64, k0, n0, (bf16*)(ws + WS_WRHI), (bf16*)(ws + WS_WRLO), D, n0, nullptr, 1.f, scr, lane); }
    }
}

__device__ __forceinline__ void p0b(Frame& F) {
    const float* const* in = F.in; unsigned char* ws = F.ws;
    LAS float* wfl = (LAS float*)F.lds;
    { const float* wf = (const float*)(ws + WS_WF); for (int i = F.tid; i < 2048; i += NTHR) *(LAS f32x4*)(wfl + 4 * i) = *(const f32x4*)(wf + 4 * i); }
    __syncthreads();
    const int gw = F.vcu * NWAVES + F.wave, lane = F.lane, NGW = F.G * NWAVES;
    const float* mod = (const float*)(ws + WS_MOD);
    for (int r0 = 8 * gw; r0 < T; r0 += 8 * NGW) {
        const int b = r0 / S;
        f32x4 gs[4], sh[4];
#pragma unroll
        for (int j = 0; j < 4; ++j) { const int c = 4 * lane + 256 * j; const f32x4 g = *(const f32x4*)(in[I_GPREMIX] + c), sc = *(const f32x4*)(mod + b * 6144 + 1024 + c);
            gs[j] = g * (sc + 1.0f); sh[j] = *(const f32x4*)(mod + b * 6144 + c); }
        const float bfg = in[I_BFORGET][lane & 7];
        for (int rr = 0; rr < 8; ++rr) {
            const int row = r0 + rr; const GAS f32x4* xr = (const GAS f32x4*)(in[I_X] + (size_t)row * D) + lane;
            f32x4 v[4]; float ss = 0.f;
#pragma unroll
            for (int j = 0; j < 4; ++j) { v[j] = xr[64 * j]; ss += (v[j].x * v[j].x + v[j].y * v[j].y) + (v[j].z * v[j].z + v[j].w * v[j].w); }
            const float rstd = rsqrtf(wave_sum(ss) * (1.f / D) + EPS);
            GAS unsigned long long* o8 = (GAS unsigned long long*)((bf16*)(ws + WS_HB) + (size_t)row * D) + lane;
#pragma unroll
            for (int j = 0; j < 4; ++j) { v[j] = v[j] * rstd * gs[j] + sh[j]; o8[64 * j] = (unsigned long long)pk2(v[j].x, v[j].y) | ((unsigned long long)pk2(v[j].z, v[j].w) << 32); }
            float z = 0.f;
#pragma unroll
            for (int h = 0; h < 8; ++h) { float p = 0.f;
#pragma unroll
                for (int j = 0; j < 4; ++j) { const f32x4 w = *(const LAS f32x4*)(wfl + h * 1024 + 4 * lane + 256 * j); p += (v[j].x * w.x + v[j].y * w.y) + (v[j].z * w.z + v[j].w * w.w); }
                p = wave_sum(p); z = (lane == h) ? p : z; }
            if (lane < 8) { const float u = z + bfg; ((float*)(ws + WS_LOGF))[(size_t)row * 8 + lane] = fminf(u, 0.f) - log1pf(__expf(-fabsf(u))); }
        }
    }
}

__device__ __forceinline__ bool static_unit(int nM, int nN, int G, int c, int i, int& pm, int& pn) {
    const int nwg = nM * nN; const long L = (long)i * G + c; if (L >= nwg) return false;
    int wgid = (int)L; { const int q = nwg / 8, r = nwg % 8, xcd = wgid % 8, off = wgid / 8; wgid = (xcd < r ? xcd * (q + 1) : r * (q + 1) + (xcd - r) * q) + off; }
    const int nig = 8 * nN, gid = wgid / nig, fm = gid * 8, gsz = (nM - fm) < 8 ? (nM - fm) : 8;
    pm = fm + ((wgid % nig) % gsz); pn = (wgid % nig) / gsz; return true;
}
__device__ __forceinline__ void put_unit(Frame& F, int i, const void* A, const void* B, int tab, int orow, int ocol) {
    LAS pg8::UnitRec* r = (LAS pg8::UnitRec*)(F.lds + ULIST_OFF) + i;
    r->A = (unsigned long long)(uintptr_t)A; r->B = (unsigned long long)(uintptr_t)B; r->tab = tab; r->orow = orow; r->ocol = ocol; r->aux = 0;
}
__device__ __forceinline__ void p1(Frame& F) {
    unsigned char* ws = F.ws; int n = 0;
    for (int i = 0; i < MAXU; ++i) { int pm, pn; if (!static_unit(T / 256, 2048 / 256, F.G, (int)blockIdx.x, i, pm, pn)) break;
        if (F.tid == 0) put_unit(F, i, ws + WS_HB + (size_t)pm * 256 * D * 2, ws + WS_WIN + (size_t)pn * 256 * D * 2, -1, pm * 256, pn * 256);
        ++n; }
    __syncthreads();
    pg8::ListSched Sd{(const LAS pg8::UnitRec*)(F.lds + ULIST_OFF), n};
    pg8::EpiBf16 E{(bf16*)(ws + WS_PROJ), 2048};
    pg8::gemm_phase<pg8::EpiBf16, pg8::ListSched, false, pg8::NoHook>(F.lds, D, Sd, E, pg8::NoHook{}, F.wave);
}
}
namespace attn_body {
using bf16=__hip_bfloat16;
using bf16x8=__attribute__((ext_vector_type(8)))short;
using s16x4=__attribute__((ext_vector_type(4)))short;
using f32x16=__attribute__((ext_vector_type(16)))float;
using u32x4=__attribute__((ext_vector_type(4)))unsigned;
constexpr int BATCH=8,NHEAD=8,SEQ=2048,D=64,DM=2048,PO=1024;
constexpr int NW=8,QBLK=32,QB=QBLK*NW,KVBLK=64,NQB=SEQ/QB;
__device__ __forceinline__ int crow(int r,int hi){return (r&3)+8*(r>>2)+4*hi;}
#define SBAR() __builtin_amdgcn_sched_barrier(0)
__device__ __forceinline__ void cmask(f32x16&p0,f32x16&p1,int jb,int qrel,int hi){
  const float NEG=-INFINITY; int kb=64*jb+4*hi;
  #pragma unroll
  for(int r=0;r<16;++r){int kv=kb+(r&3)+8*(r>>2); if(kv>qrel)p0[r]=NEG; if(kv+32>qrel)p1[r]=NEG;}
}

constexpr int NSLOT=3, SLOTB=8192;
constexpr int LDS_K=0, LDS_V=NSLOT*SLOTB, LDS_WS=2*NSLOT*SLOTB, LDS_OST=LDS_WS+NW*64*4, LDS_CUM=LDS_OST+NW*4096, LDS_KB=LDS_CUM+SEQ*4, LDS_BYTES=LDS_KB+SEQ*4;
__device__ __forceinline__ void glds16(const void*gsrc,unsigned lds_dst){unsigned keep;
  asm volatile("s_mov_b32 %0, m0\n\ts_mov_b32 m0, %2\n\ts_nop 0\n\tglobal_load_lds_dwordx4 %1, off\n\ts_mov_b32 m0, %0":"=&s"(keep):"v"(gsrc),"s"(lds_dst):"memory");}
__device__ __forceinline__ float max3f(float a,float b,float c){float r;asm("v_max3_f32 %0, %1, %2, %3":"=v"(r):"v"(a),"v"(b),"v"(c));return r;}
__device__ __forceinline__ float max2f(float a,float b){float r;asm("v_max_f32_e32 %0, %1, %2":"=v"(r):"v"(a),"v"(b));return r;}
__device__ __forceinline__ float fadd_s(float a,float b){float r;asm("v_add_f32_e32 %0, %1, %2":"=v"(r):"v"(a),"v"(b));return r;}
__device__ __forceinline__ float fsub_s(float a,float b){float r;asm("v_sub_f32_e32 %0, %1, %2":"=v"(r):"v"(a),"v"(b));return r;}
typedef float f32x2_t __attribute__((ext_vector_type(2))); typedef __bf16 bf16x2_t __attribute__((ext_vector_type(2)));
__device__ __forceinline__ unsigned cvtpk_s(float lo,float hi){f32x2_t v={lo,hi};bf16x2_t b=__builtin_convertvector(v,bf16x2_t);return __builtin_bit_cast(unsigned,b);}
#define WAIT_BAR(N) asm volatile("s_waitcnt vmcnt(" #N ") lgkmcnt(0)\n\ts_barrier":::"memory")

__device__ __forceinline__ void qkt(f32x16&p0,f32x16&p1,const char*Kslot,const bf16x8*qr,bf16x8 kb0,bf16x8 kb1,bf16x8 qb,int r32,int hi){
  const char*kb=Kslot+hi*1024+r32*16;
  p0=__builtin_amdgcn_mfma_f32_32x32x16_bf16(kb0,qb,f32x16{},0,0,0);p1=__builtin_amdgcn_mfma_f32_32x32x16_bf16(kb1,qb,f32x16{},0,0,0);
  #pragma unroll
  for(int d0=0;d0<4;++d0){
    const bf16x8 b0=*reinterpret_cast<const bf16x8*>(kb+d0*2048);
    const bf16x8 b1=*reinterpret_cast<const bf16x8*>(kb+d0*2048+512);
    p0=__builtin_amdgcn_mfma_f32_32x32x16_bf16(b0,qr[d0],p0,0,0,0);p1=__builtin_amdgcn_mfma_f32_32x32x16_bf16(b1,qr[d0],p1,0,0,0);}
}
typedef __attribute__((address_space(3))) const char* lds_cptr;
typedef short v4i16_t __attribute__((ext_vector_type(4)));
__device__ __forceinline__ void kload8(bf16x8*kf,lds_cptr kp){
  kf[0]=*(const __attribute__((address_space(3))) bf16x8*)(kp);      kf[1]=*(const __attribute__((address_space(3))) bf16x8*)(kp+512);
  kf[2]=*(const __attribute__((address_space(3))) bf16x8*)(kp+2048); kf[3]=*(const __attribute__((address_space(3))) bf16x8*)(kp+2560);
  kf[4]=*(const __attribute__((address_space(3))) bf16x8*)(kp+4096); kf[5]=*(const __attribute__((address_space(3))) bf16x8*)(kp+4608);
  kf[6]=*(const __attribute__((address_space(3))) bf16x8*)(kp+6144); kf[7]=*(const __attribute__((address_space(3))) bf16x8*)(kp+6656);
}
__device__ __forceinline__ void kload2(bf16x8*kf,lds_cptr kp,int j){ kf[2*j]=*(const __attribute__((address_space(3))) bf16x8*)(kp+j*2048); kf[2*j+1]=*(const __attribute__((address_space(3))) bf16x8*)(kp+j*2048+512); }
__device__ __forceinline__ s16x4 vtr(lds_cptr p){ return __builtin_bit_cast(s16x4,__builtin_amdgcn_ds_read_tr16_b64_v4i16((__attribute__((address_space(3))) v4i16_t*)p)); }
__device__ __forceinline__ float rowmax(const f32x16&p0,const f32x16&p1){
  float a=max3f(p0[0],p0[1],p1[0]),b=max3f(p0[2],p0[3],p1[1]);a=max3f(a,p1[2],p1[3]);
  #pragma unroll
  for(int r=4;r<16;r+=4){a=max3f(a,p0[r],p0[r+1]);b=max3f(b,p0[r+2],p0[r+3]);a=max3f(a,p1[r],p1[r+1]);b=max3f(b,p1[r+2],p1[r+3]);}
  const float m=max2f(a,b);
  auto rr=__builtin_amdgcn_permlane32_swap(__float_as_uint(m),__float_as_uint(m),false,false);
  return max2f(__uint_as_float(rr[0]),__uint_as_float(rr[1]));
}
__device__ __forceinline__ void pv(f32x16*o,int vb,bf16x8 pa0,bf16x8 pa1,bf16x8 pa2,bf16x8 pa3){
  #pragma unroll
  for(int d0=0;d0<2;++d0){s16x4 lo[4],hi[4];
    #pragma unroll
    for(int ks=0;ks<4;++ks){
      asm volatile("ds_read_b64_tr_b16 %0,%1 offset:%c2":"=&v"(lo[ks]):"v"(vb),"i"(d0*4096+ks*1024):"memory");
      asm volatile("ds_read_b64_tr_b16 %0,%1 offset:%c2":"=&v"(hi[ks]):"v"(vb),"i"(d0*4096+ks*1024+512):"memory");}
    asm volatile("s_waitcnt lgkmcnt(0)":::"memory");SBAR();
    #define PK(k) (bf16x8){lo[k][0],lo[k][1],lo[k][2],lo[k][3],hi[k][0],hi[k][1],hi[k][2],hi[k][3]}
    o[d0]=__builtin_amdgcn_mfma_f32_32x32x16_bf16(pa0,PK(0),o[d0],0,0,0);
    o[d0]=__builtin_amdgcn_mfma_f32_32x32x16_bf16(pa1,PK(1),o[d0],0,0,0);
    o[d0]=__builtin_amdgcn_mfma_f32_32x32x16_bf16(pa2,PK(2),o[d0],0,0,0);
    o[d0]=__builtin_amdgcn_mfma_f32_32x32x16_bf16(pa3,PK(3),o[d0],0,0,0);
    #undef PK
  }
}

#ifndef ATTN_STORE16
#define ATTN_STORE16(p,v) (*(u32x4*)(p)=(v))
#endif
template<int THRL> __device__ __forceinline__ void attn_unit(int b,int h,int qb,const bf16*Q,const bf16*__restrict__ K,const bf16*__restrict__ V,bf16*O,float*ssq,char*shm,const int wid){
  int lane; asm volatile("v_mbcnt_lo_u32_b32 %0, -1, 0\n\tv_mbcnt_hi_u32_b32 %0, -1, %0" : "=v"(lane));
  const int tid=wid*64+lane, r32=lane&31,hi=lane>>5;
  const long rowbase=(long)b*SEQ; const int q0=qb*QB;
  const bf16*Qw=Q+(rowbase+q0+wid*QBLK)*DM+h*D;
  const bf16*Kh=K+rowbase*DM+h*D,*Vh=V+rowbase*DM+h*D;
  const unsigned lds0=(unsigned)(uintptr_t)shm;
  float*wsf=(float*)(shm+LDS_WS)+wid*64;
  const bf16*ksrc=Kh+(long)lane*DM+wid*8;
  const bf16*vsrc=Vh+(long)(16*(wid&3)+(lane>>2))*DM+(wid>>2)*32+(lane&3)*8;
  const unsigned kdst=lds0+LDS_K+wid*1024, vdst=lds0+LDS_V+wid*1024;
  #define DMA_K(t,slot) glds16(ksrc+(long)(t)*KVBLK*DM,(unsigned)__builtin_amdgcn_readfirstlane(kdst+(slot)))
  #define DMA_V(t,slot) glds16(vsrc+(long)(t)*KVBLK*DM,(unsigned)__builtin_amdgcn_readfirstlane(vdst+(slot)))
  const int vb0=(int)(lds0+LDS_V)+((lane>>4)&1)*32+(lane&3)*8+(4*hi+((lane&15)>>2))*64;
  const char*Kbase=shm+LDS_K; bf16x8 kf[8];
  const lds_cptr shm3=(lds_cptr)shm; const lds_cptr kp0=shm3+LDS_K+hi*1024+r32*16; const lds_cptr vp0=shm3+LDS_V+((lane>>4)&1)*32+(lane&3)*8+(4*hi+((lane&15)>>2))*64;
  const int NT=(q0+QB)/KVBLK;
  { const float*cum=(const float*)(shm+LDS_CUM); unsigned*kbt_=(unsigned*)(shm+LDS_KB); const float ref=cum[q0+QB-1];
    for(int k=tid;k<NT*KVBLK;k+=NW*64){ const float v=(ref-cum[k])*1.4426950408889634f; const unsigned hb=mk::f2bf(v); kbt_[k]=hb|(mk::f2bf(v-mk::bf2f(hb))<<16); }
    __syncthreads(); }
  const __attribute__((address_space(3))) unsigned* kbt=(const __attribute__((address_space(3))) unsigned*)((lds_cptr)shm+LDS_KB);
  const unsigned kone1=hi?0u:0x3F803F80u;
  #define KBF(pk) __builtin_bit_cast(bf16x8,(u32x4){(pk),kone1,kone1,0u})
  unsigned kbr0,kbr1;
  #define KBRD(G,tt) do{ if(G){ const unsigned a_=kbt[(tt)*KVBLK+r32], b_=kbt[(tt)*KVBLK+32+r32]; kbr0=a_; kbr1=b_; } }while(0)
  bf16x8 qb_=__builtin_bit_cast(bf16x8,(u32x4){kone1,0u,0u,0u});
  #define SETREF() do{ const float nm_=-mhat; const unsigned h0_=__float_as_uint(nm_)&0xFFFF0000u; const float r1_=nm_-__uint_as_float(h0_); const unsigned h1_=__float_as_uint(r1_)&0xFFFF0000u; \
      const float r2_=r1_-__uint_as_float(h1_); const unsigned h2_=__float_as_uint(r2_)&0xFFFF0000u; \
      qb_=__builtin_bit_cast(bf16x8,(u32x4){kone1, hi?0u:((h0_>>16)|h1_), hi?0u:(h2_>>16), 0u}); }while(0)
  DMA_K(0,0);DMA_V(0,0);DMA_K(1,SLOTB);
  bf16x8 qr[4];
  #pragma unroll
  for(int d0=0;d0<4;++d0)qr[d0]=*reinterpret_cast<const bf16x8*>(&Qw[(long)r32*DM+d0*16+hi*8]);
  const lds_cptr qp0=shm3+LDS_OST+wid*4096+hi*512+r32*16;
  #pragma unroll
  for(int d0=0;d0<4;++d0)*(__attribute__((address_space(3))) bf16x8*)((__attribute__((address_space(3))) char*)(qp0+d0*1024))=qr[d0];
  #define QF(d0) (*(const __attribute__((address_space(3))) bf16x8*)(qp0+(d0)*1024))
  float mhat=0.f,l_reg=0.f;f32x16 o[2];o[0]=f32x16{};o[1]=f32x16{};
  const int qrel=wid*QBLK+r32;
  #define CMASK(P0,P1,t) do{int jb_=(t)-(NT-4); if(jb_>=0)cmask(P0,P1,jb_,qrel,hi);}while(0)
  bool resc=false;
  #define START(P0,P1) do{ const float rm=rowmax(P0,P1); resc=false; \
    { const float dl=rm; mhat=fadd_s(mhat,dl); \
      _Pragma("unroll") for(int r=0;r<16;++r){P0[r]=fsub_s(P0[r],dl);P1[r]=fsub_s(P1[r],dl);} \
      SETREF(); } \
    _Pragma("unroll") for(int r=0;r<16;++r)P0[r]=__builtin_amdgcn_exp2f(P0[r]); }while(0)
  #define RESC() do{ if(resc){ asm volatile("s_waitcnt lgkmcnt(0)":::"memory"); \
      _Pragma("unroll") for(int d_=0;d_<2;++d_) _Pragma("unroll") for(int r=0;r<16;++r)o[d_][r]*=wsf[crow(r,hi)]; } }while(0)
  f32x16 pA0,pA1,pB0,pB1;
  int sl_prev=0,sl_cur=0,sl_next=SLOTB;
  #define ROT() do{sl_prev=sl_cur;sl_cur=sl_next;sl_next=(sl_next==(NSLOT-1)*SLOTB)?0:sl_next+SLOTB;}while(0)
  DMA_K(2,2*SLOTB);
  WAIT_BAR(3);
  KBRD(true,0);
  qkt(pA0,pA1,Kbase,qr,KBF(kbr0),KBF(kbr1),qb_,r32,hi);asm volatile("s_nop 15\n\ts_nop 7":"+v"(pA0),"+v"(pA1));CMASK(pA0,pA1,0);
  START(pA0,pA1);
  _Pragma("unroll") for(int r=0;r<16;++r)pA1[r]=__builtin_amdgcn_exp2f(pA1[r]);
  WAIT_BAR(0);
  DMA_K(3,0);DMA_V(1,SLOTB);
  ROT();
  kload8(kf,kp0+sl_cur);
  KBRD(true,1);
  WAIT_BAR(2);
  s16x4 vlo[8],vhi[8]; u32x4 pw0,pw1,pw2,pw3;
  #define PKW(P,B) cvtpk_s(P[B],P[B+1])
  #define PAF(k) __builtin_bit_cast(bf16x8,pw##k)
  #define VFR(i) (bf16x8){vlo[i][0],vlo[i][1],vlo[i][2],vlo[i][3],vhi[i][0],vhi[i][1],vhi[i][2],vhi[i][3]}
  #define PIN(x) asm volatile("":"+v"(x))
  #define MX3(a,b,c) __builtin_fmaxf(__builtin_fmaxf((a),(b)),(c))
  #define GAPA(MF,A0,A1,A2,A3,W0,W1,PW) do{ MF; sacc+=A0; sacc+=A1; sacc+=A2; sacc+=A3; PIN(sacc); W0; W1; PIN(PW); SBAR(); }while(0)
  #define EX(v) __builtin_amdgcn_exp2f(v)
  #define GAPB(MF,X,B) do{ MF; X[B]=EX(X[B]); X[B+1]=EX(X[B+1]); X[B+2]=EX(X[B+2]); X[B+3]=EX(X[B+3]); PIN(X); SBAR(); }while(0)
  #define VRD(i) do{ vlo[i]=vtr(vp_+(((i)>>2)*4096+((i)&3)*1024)); vhi[i]=vtr(vp_+(((i)>>2)*4096+((i)&3)*1024+512)); }while(0)
  #define KRD(G,j) do{ if(G){ kload2(kf,kp0+sl_next,j); SBAR(); } }while(0)
  #define STEP(C0,C1,P0,P1,t,GK,GV,GL) do{ SBAR(); \
    const lds_cptr vp_=vp0+sl_prev; \
    C0=__builtin_amdgcn_mfma_f32_32x32x16_bf16(KBF(kbr0),qb_,f32x16{},0,0,0); C1=__builtin_amdgcn_mfma_f32_32x32x16_bf16(KBF(kbr1),qb_,f32x16{},0,0,0); SBAR(); \
    VRD(0); SBAR(); float sacc=(P0[0]+P0[1]); \
    bf16x8 qa_=QF(0), qc_=QF(1); \
    GAPA(C0=__builtin_amdgcn_mfma_f32_32x32x16_bf16(kf[0],qa_,C0,0,0,0), P0[2],P0[3],P0[4],P0[5],     pw0[0]=PKW(P0,0), pw0[1]=PKW(P0,2), pw0); \
    VRD(4); SBAR(); GAPA(C1=__builtin_amdgcn_mfma_f32_32x32x16_bf16(kf[1],qa_,C1,0,0,0), P0[6],P0[7],P0[8],P0[9],     pw0[2]=PKW(P0,4), pw0[3]=PKW(P0,6), pw0); \
    qa_=QF(2); VRD(1); SBAR(); GAPA(C0=__builtin_amdgcn_mfma_f32_32x32x16_bf16(kf[2],qc_,C0,0,0,0),   P0[10],P0[11],P0[12],P0[13], pw1[0]=PKW(P0,8), pw1[1]=PKW(P0,10), pw1); \
    VRD(5); SBAR(); GAPA(C1=__builtin_amdgcn_mfma_f32_32x32x16_bf16(kf[3],qc_,C1,0,0,0),   P0[14],P0[15],P1[0],P1[1],   pw1[2]=PKW(P0,12),pw1[3]=PKW(P0,14), pw1); \
    qc_=QF(3); VRD(2); SBAR(); GAPA(C0=__builtin_amdgcn_mfma_f32_32x32x16_bf16(kf[4],qa_,C0,0,0,0),   P1[2],P1[3],P1[4],P1[5],     pw2[0]=PKW(P1,0), pw2[1]=PKW(P1,2), pw2); \
    VRD(6); SBAR(); GAPA(C1=__builtin_amdgcn_mfma_f32_32x32x16_bf16(kf[5],qa_,C1,0,0,0),   P1[6],P1[7],P1[8],P1[9],     pw2[2]=PKW(P1,4), pw2[3]=PKW(P1,6), pw2); \
    VRD(3); SBAR(); GAPA(C0=__builtin_amdgcn_mfma_f32_32x32x16_bf16(kf[6],qc_,C0,0,0,0),   P1[10],P1[11],P1[12],P1[13], pw3[0]=PKW(P1,8), pw3[1]=PKW(P1,10), pw3); \
    VRD(7); SBAR(); GAPA(C1=__builtin_amdgcn_mfma_f32_32x32x16_bf16(kf[7],qc_,C1,0,0,0),   P1[14],P1[15],0.f,0.f,       pw3[2]=PKW(P1,12),pw3[3]=PKW(P1,14), pw3); \
    l_reg+=sacc; \
    if(GK){DMA_K((t)+3,sl_cur);} if(GV){DMA_V((t)+1,sl_next);} \
    CMASK(C0,C1,t); \
    { float a=MX3(C0[0],C0[1],C1[0]),b=MX3(C0[2],C0[3],C1[1]); a=MX3(a,C1[2],C1[3]); \
      _Pragma("unroll") for(int r=4;r<16;r+=4){a=MX3(a,C0[r],C0[r+1]);b=MX3(b,C0[r+2],C0[r+3]);a=MX3(a,C1[r],C1[r+1]);b=MX3(b,C1[r+2],C1[r+3]);} \
      float rm=__builtin_fmaxf(a,b); { auto rr=__builtin_amdgcn_permlane32_swap(__float_as_uint(rm),__float_as_uint(rm),false,false); rm=__builtin_fmaxf(__uint_as_float(rr[0]),__uint_as_float(rr[1])); } \
      resc=false; \
      if(__builtin_expect(__any(rm>(float)THRL),0)){ const float dl=__builtin_fmaxf(rm,0.f); mhat+=dl; \
        _Pragma("unroll") for(int r=0;r<16;++r){C0[r]-=dl;C1[r]-=dl;} \
        SETREF(); \
        const float f=__builtin_amdgcn_exp2f(-dl); l_reg*=f; if(hi==0)wsf[r32]=f; resc=true; } } \
    SBAR(); \
    GAPB(o[0]=__builtin_amdgcn_mfma_f32_32x32x16_bf16(PAF(0),VFR(0),o[0],0,0,0), C0,0); \
    GAPB(o[1]=__builtin_amdgcn_mfma_f32_32x32x16_bf16(PAF(0),VFR(4),o[1],0,0,0), C0,4); \
    KRD(GL,0); GAPB(o[0]=__builtin_amdgcn_mfma_f32_32x32x16_bf16(PAF(1),VFR(1),o[0],0,0,0), C0,8); \
    KRD(GL,1); GAPB(o[1]=__builtin_amdgcn_mfma_f32_32x32x16_bf16(PAF(1),VFR(5),o[1],0,0,0), C0,12); \
    KRD(GL,2); GAPB(o[0]=__builtin_amdgcn_mfma_f32_32x32x16_bf16(PAF(2),VFR(2),o[0],0,0,0), C1,0); \
    KRD(GL,3); GAPB(o[1]=__builtin_amdgcn_mfma_f32_32x32x16_bf16(PAF(2),VFR(6),o[1],0,0,0), C1,4); \
    KBRD(GL,(t)+1); \
    GAPB(o[0]=__builtin_amdgcn_mfma_f32_32x32x16_bf16(PAF(3),VFR(3),o[0],0,0,0), C1,8); \
    GAPB(o[1]=__builtin_amdgcn_mfma_f32_32x32x16_bf16(PAF(3),VFR(7),o[1],0,0,0), C1,12); \
    }while(0)
  int t=1;
  #undef CMASK
  #define CMASK(P0,P1,t) do{}while(0)
  for(;t+5<NT;t+=2){
    STEP(pB0,pB1,pA0,pA1,t,true,true,true);     WAIT_BAR(2); RESC(); ROT();
    STEP(pA0,pA1,pB0,pB1,t+1,true,true,true);   WAIT_BAR(2); RESC(); ROT();
  }
  #undef CMASK
  #define CMASK(P0,P1,t) do{int jb_=(t)-(NT-4); if(jb_>=0)cmask(P0,P1,jb_,qrel,hi);}while(0)
  #define ENDW(tt) do{ if((tt)+3<NT){WAIT_BAR(2);} else if((tt)+2<NT){WAIT_BAR(1);} else {WAIT_BAR(0);} }while(0)
  for(;t+1<NT;t+=2){
    STEP(pB0,pB1,pA0,pA1,t,(t+3<NT),(t+1<NT),(t+1<NT));       ENDW(t);   RESC(); ROT();
    STEP(pA0,pA1,pB0,pB1,t+1,(t+4<NT),(t+2<NT),(t+2<NT));     ENDW(t+1); RESC(); ROT();
  }
  STEP(pB0,pB1,pA0,pA1,NT-1,false,false,false); RESC();
  { float sacc=pB0[0]+pB0[1]; _Pragma("unroll") for(int r=2;r<16;++r)sacc+=pB0[r]; _Pragma("unroll") for(int r=0;r<16;++r)sacc+=pB1[r]; l_reg+=sacc;
    pw0=(u32x4){PKW(pB0,0),PKW(pB0,2),PKW(pB0,4),PKW(pB0,6)};pw1=(u32x4){PKW(pB0,8),PKW(pB0,10),PKW(pB0,12),PKW(pB0,14)};pw2=(u32x4){PKW(pB1,0),PKW(pB1,2),PKW(pB1,4),PKW(pB1,6)};pw3=(u32x4){PKW(pB1,8),PKW(pB1,10),PKW(pB1,12),PKW(pB1,14)};
    SBAR(); pv(o,vb0+sl_cur,PAF(0),PAF(1),PAF(2),PAF(3)); }
  #undef PKW
  #undef PAF
  #undef VFR
  #undef PIN
  #undef MX3
  #undef GAPA
  #undef GAPB
  #undef EX
  #undef VRD
  #undef KRD
  #undef STEP
  #undef ENDW
  {auto rr=__builtin_amdgcn_permlane32_swap(__float_as_uint(l_reg),__float_as_uint(l_reg),false,false);l_reg=__uint_as_float(rr[0])+__uint_as_float(rr[1]);}
  if(hi==0)wsf[32+r32]=l_reg;asm volatile("s_waitcnt lgkmcnt(0)":::"memory");
  float rli[16];
  #pragma unroll
  for(int r=0;r<16;++r)rli[r]=__builtin_amdgcn_rcpf(wsf[32+crow(r,hi)]);
  bf16*Ow=O+(rowbase+q0+wid*QBLK)*PO+h*D; float*sq=ssq+(rowbase+q0+wid*QBLK)*8+h;
  { bf16*stg=(bf16*)(shm+LDS_OST)+wid*2048;
    #pragma unroll
    for(int r=0;r<16;++r){const int orow=crow(r,hi);
      #pragma unroll
      for(int d0=0;d0<2;++d0)stg[orow*64+d0*32+r32]=__float2bfloat16(o[d0][r]*rli[r]);}
    asm volatile("s_waitcnt lgkmcnt(0)":::"memory");
    #pragma unroll
    for(int i=0;i<4;++i){const int row=i*8+(lane>>3),ch=lane&7; const u32x4 v=*(const u32x4*)(stg+row*64+ch*8); ATTN_STORE16(Ow+(long)row*PO+ch*8,v);
      float ss=0.f;
      #pragma unroll
      for(int j=0;j<4;++j){ const float a_=__uint_as_float(v[j]<<16), b_=__uint_as_float(v[j]&0xFFFF0000u); ss+=a_*a_+b_*b_; }
      ss+=__shfl_xor(ss,1); ss+=__shfl_xor(ss,2); ss+=__shfl_xor(ss,4); if(ch==0) sq[(long)row*8]=ss; } }
  asm volatile("s_waitcnt lgkmcnt(0)\n\ts_barrier":::"memory");
  #undef DMA_K
  #undef DMA_V
  #undef CMASK
  #undef START
  #undef RESC
  #undef ROT
  #undef KBF
  #undef QF
  #undef KBRD
  #undef SETREF
}
constexpr int ATTN_LDS_BYTES=LDS_BYTES;
#undef SBAR
#undef WAIT_BAR
}

namespace mk {
__device__ __forceinline__ void pool_tile(Frame& F, int tile) {
    unsigned char* ws = F.ws; constexpr int US = 1040;
    const int t0 = tile * 64, tl0 = t0 % S;
    const bf16* proj = (const bf16*)(ws + WS_PROJ);
    for (int c = F.tid; c < 79 * 64; c += NTHR) { const int rr = c >> 6, ch = c & 63; v4u v = (v4u){0u, 0u, 0u, 0u};
        if (tl0 + rr - 15 >= 0) v = *(const GAS v4u*)(proj + (size_t)(t0 - 15 + rr) * 2048 + ch * 8);
        *(LAS v4u*)(F.lds + rr * US + ch * 16) = v; }
    __syncthreads();
    const int mb = F.wave & 3, nh = F.wave >> 2, r = F.lane & 15, kq = F.lane >> 4, tr = mb * 16 + r, tl = tl0 + tr;
    const bf16* wp = (const bf16*)(ws + WS_WPOOL);
    bf16* ycat = (bf16*)(ws + WS_YCAT); float* ssqp = (float*)(ws + WS_SSQP);
#pragma unroll
    for (int g = 0; g < 4; ++g) {
        constexpr int dummy = 0; (void)dummy;
        const int wg = 2 << g; const int n = (tl + 1 < wg) ? tl + 1 : wg; const float inv = 1.0f / (float)n;
        f32x4 acc[4];
#pragma unroll
        for (int nb = 0; nb < 4; ++nb) acc[nb] = (f32x4){0.f, 0.f, 0.f, 0.f};
#pragma unroll
        for (int ks = 0; ks < 4; ++ks) {
            const int c0 = g * 128 + ks * 32 + kq * 8;
            float sum[8];
#pragma unroll
            for (int j = 0; j < 8; ++j) sum[j] = 0.f;
            v4u cur = (v4u){0u, 0u, 0u, 0u};
#pragma unroll
            for (int i = 0; i < wg; ++i) { const v4u v = *(const LAS v4u*)(F.lds + (tr + 15 - i) * US + c0 * 2); if (i == 0) cur = v;
#pragma unroll
                for (int j = 0; j < 4; ++j) { sum[2 * j] += __uint_as_float(v[j] << 16); sum[2 * j + 1] += __uint_as_float(v[j] & 0xFFFF0000u); } }
            v4u pa;
#pragma unroll
            for (int j = 0; j < 4; ++j) pa[j] = pk2(sum[2 * j] * inv - __uint_as_float(cur[j] << 16), sum[2 * j + 1] * inv - __uint_as_float(cur[j] & 0xFFFF0000u));
            const bf16x8 af = __builtin_bit_cast(bf16x8, pa);
#pragma unroll
            for (int nb = 0; nb < 4; ++nb) { const bf16x8 bfr = *(const bf16x8*)(wp + (size_t)g * 16384 + (size_t)(nh * 64 + nb * 16 + r) * 128 + ks * 32 + kq * 8);
                acc[nb] = __builtin_amdgcn_mfma_f32_16x16x32_bf16(bfr, af, acc[nb], 0, 0, 0); }
        }
        const size_t token = (size_t)t0 + tr; float ss = 0.f;
#pragma unroll
        for (int nb = 0; nb < 4; ++nb) { const f32x4 v = acc[nb]; ss += (v[0] * v[0] + v[1] * v[1]) + (v[2] * v[2] + v[3] * v[3]);
            v2u o; o.x = pk2(v[0], v[1]); o.y = pk2(v[2], v[3]);
            *(GAS v2u*)(ycat + token * D + g * 128 + nh * 64 + nb * 16 + 4 * kq) = o; }
        ss += __shfl_xor(ss, 16); ss += __shfl_xor(ss, 32);
        if (kq == 0) ssqp[token * 8 + g * 2 + nh] = ss;
    }
    __syncthreads();
}

__device__ __forceinline__ void p2(Frame& F) {
    unsigned char* ws = F.ws; char* shm = (char*)(uintptr_t)0;
    (void)shm;
    const attn_body::bf16* proj = (const attn_body::bf16*)(ws + WS_PROJ);
    attn_body::bf16* ycat = (attn_body::bf16*)(ws + WS_YCAT);
    const float* logf = (const float*)(ws + WS_LOGF); float* ssqa = (float*)(ws + WS_SSQA);
    char* lds = (char*)F.lds;
    for (int p = F.vcu; p < 256; p += F.G) {
        const int bh = p >> 2, s = p & 3, b = bh >> 3, h = bh & 7;
        { const float* lf = logf + (size_t)b * S * 8 + h; const int k0 = 4 * F.tid;
          const float l0 = lf[(size_t)(k0 + 0) * 8], l1 = lf[(size_t)(k0 + 1) * 8], l2 = lf[(size_t)(k0 + 2) * 8], l3 = lf[(size_t)(k0 + 3) * 8];
          const float c0 = l0, c1 = c0 + l1, c2 = c1 + l2, c3 = c2 + l3; float x = c3;
#pragma unroll
          for (int o = 1; o < 64; o <<= 1) { const float y = __shfl_up(x, o); if (F.lane >= o) x += y; }
          LAS float* wt = (LAS float*)(F.lds + attn_body::LDS_WS);
          if (F.lane == 63) wt[F.wave] = x;
          __syncthreads();
          float base = x - c3; for (int w = 0; w < F.wave; ++w) base += wt[w];
          LAS float* cum = (LAS float*)(F.lds + attn_body::LDS_CUM);
          *(LAS f32x4*)(cum + k0) = (f32x4){base + c0, base + c1, base + c2, base + c3};
          __syncthreads(); }
#pragma nounroll
        for (int u = 0; u < 2; ++u) attn_body::attn_unit<8>(b, h, u ? 7 - s : s, proj + 512, proj + 1024, proj + 1536, ycat + 512, ssqa, lds, F.wave);
    }
    __syncthreads();
    for (int tile = F.vcu; tile < T / 64; tile += F.G) pool_tile(F, tile);
}
}
namespace mk {
struct MidScaleHook {
    const LAS float* ratio;
    __device__ __forceinline__ void at(int t, pg8::f32x4 (&acc)[2][2][4][2], int wr, int fr, int) const {
        if (t == 8) {
#pragma unroll
            for (int ai = 0; ai < 2; ++ai)
#pragma unroll
                for (int m = 0; m < 4; ++m) { const float s = ratio[ai * 128 + wr * 64 + m * 16 + fr];
#pragma unroll
                    for (int bj = 0; bj < 2; ++bj)
#pragma unroll
                        for (int n = 0; n < 2; ++n) acc[ai][bj][m][n] *= s; }
        }
    }
};
__device__ __forceinline__ void p3(Frame& F) {
    unsigned char* ws = F.ws;
    LAS float* ratio = (LAS float*)(F.lds + RS_OFF); LAS float* rs = ratio + 256;
    const float* ssqp = (const float*)(ws + WS_SSQP); const float* ssqa = (const float*)(ws + WS_SSQA);
    for (int i = 0; i < 64; ++i) { int pm, pn; if (!static_unit(T / 256, D / 256, F.G, (int)blockIdx.x, i, pm, pn)) break;
        __syncthreads();
        if (F.tid < 256) { const size_t tok = (size_t)pm * 256 + F.tid; float sp = 0.f, sa = 0.f;
#pragma unroll
            for (int j = 0; j < 8; ++j) { sp += ssqp[tok * 8 + j]; sa += ssqa[tok * 8 + j]; }
            const float rp = rsqrtf(sp * (1.f / 512.f) + EPS), ra = rsqrtf(sa * (1.f / 512.f) + EPS);
            ratio[F.tid] = rp / ra; rs[F.tid] = ra; }
        if (F.tid == 0) put_unit(F, 0, ws + WS_YCAT + (size_t)pm * 256 * D * 2, ws + WS_WOUT + (size_t)pn * 256 * D * 2, -1, pm * 256, pn * 256);
        __syncthreads();
        pg8::ListSched Sd{(const LAS pg8::UnitRec*)(F.lds + ULIST_OFF), 1};
        pg8::EpiRowScaleBf16 E{(bf16*)(ws + WS_MIXED), D, rs};
        pg8::gemm_phase<pg8::EpiRowScaleBf16, pg8::ListSched, false, MidScaleHook>(F.lds, D, Sd, E, MidScaleHook{ratio}, F.wave);
    }
}
}
namespace mk {
__device__ __forceinline__ int p4_swz(int row, int chunk) { return row * 2048 + ((chunk ^ (row & 15)) << 4); }
template <bool DRY> __device__ __forceinline__ void p4(Frame& F) {
    const bool live = !DRY || (__hip_atomic_load(F.ctl + 3, RLX_AGENT) == 0xdeadbeefu);
    const float* const* in = F.in; unsigned char* ws = F.ws;
    const float* mod = (const float*)(ws + WS_MOD);
    const bf16* mixed = (const bf16*)(ws + WS_MIXED); bf16* h2g = (bf16*)(ws + WS_H2);
    const bf16* wrhi = (const bf16*)(ws + WS_WRHI); const bf16* wrlo = (const bf16*)(ws + WS_WRLO);
    LAS unsigned char* thi = F.lds; LAS unsigned char* tlo = F.lds + 65536;
    const int lane = F.lane;
    for (int tile = F.vcu; tile < T / 32; tile += F.G) {
        for (int rr = 0; rr < 4; ++rr) {
            const int rowi = F.wave * 4 + rr; const size_t token = (size_t)tile * 32 + rowi; const int b = (int)(token / S);
            f32x4 m[4]; float ss = 0.f;
#pragma unroll
            for (int j = 0; j < 4; ++j) { const v2u u = *(const GAS v2u*)(mixed + token * D + 4 * lane + 256 * j);
                m[j] = (f32x4){__uint_as_float(u.x << 16), __uint_as_float(u.x & 0xFFFF0000u), __uint_as_float(u.y << 16), __uint_as_float(u.y & 0xFFFF0000u)};
                ss += (m[j].x * m[j].x + m[j].y * m[j].y) + (m[j].z * m[j].z + m[j].w * m[j].w); }
            const float rm = rsqrtf(wave_sum(ss) * (1.f / D) + EPS);
            float s1 = 0.f;
#pragma unroll
            for (int j = 0; j < 4; ++j) { const int c = 4 * lane + 256 * j;
                const f32x4 xv = *(const GAS f32x4*)(in[I_X] + token * D + c), gt = *(const f32x4*)(mod + b * 6144 + 2048 + c), gp = *(const f32x4*)(in[I_GPOSTMIX] + c);
                m[j] = xv + gt * (m[j] * rm) * gp;
                if (live) *(GAS f32x4*)(F.out + token * D + c) = m[j];
                s1 += (m[j].x * m[j].x + m[j].y * m[j].y) + (m[j].z * m[j].z + m[j].w * m[j].w); }
            const float r1 = rsqrtf(wave_sum(s1) * (1.f / D) + EPS);
#pragma unroll
            for (int j = 0; j < 4; ++j) { const int c = 4 * lane + 256 * j;
                const f32x4 gf = *(const f32x4*)(in[I_GPREFFN] + c), sc = *(const f32x4*)(mod + b * 6144 + 4096 + c), sh = *(const f32x4*)(mod + b * 6144 + 3072 + c);
                const f32x4 h = m[j] * r1 * gf * (sc + 1.0f) + sh;
                const unsigned h0 = f2bf(h.x), h1 = f2bf(h.y), h2_ = f2bf(h.z), h3 = f2bf(h.w);
                v2u hv; hv.x = h0 | (h1 << 16); hv.y = h2_ | (h3 << 16);
                v2u lv; lv.x = pk2(h.x - bf2f(h0), h.y - bf2f(h1)); lv.y = pk2(h.z - bf2f(h2_), h.w - bf2f(h3));
                if (live) *(GAS v2u*)(h2g + token * D + c) = hv;
                const int off = p4_swz(rowi, (lane >> 1) + 32 * j) + (lane & 1) * 8;
                *(LAS v2u*)(thi + off) = hv; *(LAS v2u*)(tlo + off) = lv; }
        }
        __syncthreads();
        { const int mb = F.wave & 1, nb = F.wave >> 1, r = lane & 15, kq = lane >> 4;
          f32x4 acc = (f32x4){0.f, 0.f, 0.f, 0.f};
          const bf16* bh = wrhi + (size_t)(nb * 16 + r) * D + kq * 8; const bf16* bl = wrlo + (size_t)(nb * 16 + r) * D + kq * 8;
#pragma unroll 4
          for (int ks = 0; ks < 32; ++ks) { const int off = p4_swz(mb * 16 + r, ks * 4 + kq);
              const bf16x8 ah = *(const LAS bf16x8*)(thi + off), al = *(const LAS bf16x8*)(tlo + off);
              const bf16x8 bhf = *(const bf16x8*)(bh + ks * 32), blf = *(const bf16x8*)(bl + ks * 32);
              acc = __builtin_amdgcn_mfma_f32_16x16x32_bf16(ah, bhf, acc, 0, 0, 0);
              acc = __builtin_amdgcn_mfma_f32_16x16x32_bf16(al, bhf, acc, 0, 0, 0);
              acc = __builtin_amdgcn_mfma_f32_16x16x32_bf16(ah, blf, acc, 0, 0, 0); }
          __syncthreads();
          LAS float* lg = (LAS float*)F.lds;
#pragma unroll
          for (int i = 0; i < 4; ++i) lg[(mb * 16 + kq * 4 + i) * 65 + nb * 16 + r] = acc[i];
          if (F.tid < 64) ((LAS unsigned*)(F.lds + 16384))[F.tid] = 0u;
        }
        __syncthreads();
        int my_e = 0; float my_w = 0.f; unsigned my_pos = 0u;
        const int tk = F.tid >> 3, gl = F.tid & 7; const size_t rtoken = (size_t)tile * 32 + tk;
        LAS unsigned* hist = (LAS unsigned*)(F.lds + 16384); LAS unsigned* basev = hist + 64;
        if (F.tid < 256) {
            const LAS float* lg = (const LAS float*)F.lds; const int lb = lane & ~7;
            float sc[8], sl[8];
#pragma unroll
            for (int j = 0; j < 8; ++j) { const float x = lg[tk * 65 + gl * 8 + j]; const float s = 1.0f / (1.0f + __expf(-x)); sc[j] = s; sl[j] = s + in[I_RBIAS][gl * 8 + j]; }
            float a = -INFINITY, b2 = -INFINITY;
#pragma unroll
            for (int j = 0; j < 8; ++j) { const float v = sl[j]; if (v > a) { b2 = a; a = v; } else if (v > b2) b2 = v; }
            const float gs = a + b2; int rank = 0;
#pragma unroll
            for (int i = 0; i < 8; ++i) { const float og = __shfl(gs, lb + i); rank += (og > gs || (og == gs && i < gl)) ? 1 : 0; }
            if (rank >= 4) {
#pragma unroll
                for (int j = 0; j < 8; ++j) sl[j] = -INFINITY; }
            float wsum = 0.f, my_s = 0.f;
#pragma unroll
            for (int rd = 0; rd < 8; ++rd) {
                float bv = sl[0]; int be = gl * 8;
#pragma unroll
                for (int j = 1; j < 8; ++j) if (sl[j] > bv) { bv = sl[j]; be = gl * 8 + j; }
#pragma unroll
                for (int msk = 1; msk < 8; msk <<= 1) { const float ov = __shfl_xor(bv, msk); const int oe = __shfl_xor(be, msk); if (ov > bv || (ov == bv && oe < be)) { bv = ov; be = oe; } }
                float ws_ = 0.f;
#pragma unroll
                for (int j = 0; j < 8; ++j) if (be == gl * 8 + j) { ws_ = sc[j]; sl[j] = -INFINITY; }
                const float wsc = __shfl(ws_, lb + (be >> 3));
                wsum += wsc; if (gl == rd) { my_e = be; my_s = wsc; }
            }
            my_w = my_s / wsum * 2.5f;
            my_pos = __hip_atomic_fetch_add(hist + my_e, 1u, __ATOMIC_RELAXED, __HIP_MEMORY_SCOPE_WORKGROUP);
        }
        __syncthreads();
        if (F.tid < 64) { const unsigned c = hist[F.tid]; basev[F.tid] = (c && live) ? __hip_atomic_fetch_add(F.ctl + CW_CNT + 64 * F.tid, c, __ATOMIC_RELAXED, __HIP_MEMORY_SCOPE_AGENT) : 0u; }
        __syncthreads();
        if (F.tid < 256 && live) { const unsigned slot = basev[my_e] + my_pos; const unsigned v = (unsigned)my_e;
            ((unsigned*)(ws + WS_LISTS))[(size_t)v * LIST_CAP + slot] = (unsigned)rtoken;
            ((unsigned*)(ws + WS_TOKMAP))[rtoken * 8 + gl] = (v << 16) | slot;
            ((float*)(ws + WS_WTS))[rtoken * 8 + gl] = my_w; }
        __syncthreads();
    }
}
}
namespace mk {
__device__ __forceinline__ void moe_prefix(Frame& F) {
    LAS int* pre = (LAS int*)(F.lds + PRE_OFF);
    __syncthreads();
    if (F.tid < 64) {
        const int c0 = (int)__hip_atomic_load(F.ctl + CW_CNT + 64 * F.tid, RLX_AGENT);
        const int t0 = (c0 + 255) >> 8; int x = t0;
#pragma unroll
        for (int o = 1; o < 64; o <<= 1) { const int y = __shfl_up(x, o); if (F.lane >= o) x += y; }
        pre[F.tid] = x - t0; if (F.tid == 63) pre[64] = x;
    }
    __syncthreads();
}
__device__ __forceinline__ int moe_find_list(const LAS int* pre, int tile) {
    int lo = 0, hi = 64;
    while (hi - lo > 1) { const int mid = (lo + hi) >> 1; if (pre[mid] <= tile) lo = mid; else hi = mid; }
    return lo;
}
__device__ __forceinline__ int moe_tiles(int NTr) { int nt = NTr + T / 256; const long cap = (long)((WS_END - WS_H) / (256 * (512 + 1024))); return nt > cap ? (int)cap : nt; }
__device__ __forceinline__ unsigned char* y_base(Frame& F, int ntl) { return F.ws + WS_H + (size_t)ntl * 256 * 512; }

__device__ __forceinline__ void p5(Frame& F) {
    unsigned char* ws = F.ws;
    moe_prefix(F);
    const LAS int* pre = (const LAS int*)(F.lds + PRE_OFF);
    const int NTr = pre[64], ntl = moe_tiles(NTr), NU = ntl * 2;
    const unsigned* lists = (const unsigned*)(ws + WS_LISTS);
    int n = 0;
    for (int i = 0; i < MAXU; ++i) { const int L = i * F.G + F.vcu; if (L >= NU) break;
        const int tile = L >> 1, pn = L & 1; const void* Bp; LAS unsigned* tab = (LAS unsigned*)(F.lds + TAB_OFF + i * 1024);
        if (tile < NTr) { const int e = moe_find_list(pre, tile), tl = tile - pre[e];
            const int cnt = (int)__hip_atomic_load(F.ctl + CW_CNT + 64 * e, RLX_AGENT);
            if (F.tid < 256) { const int r = tl * 256 + F.tid; tab[F.tid] = lists[(size_t)e * LIST_CAP + (r < cnt ? r : 0)]; }
            Bp = ws + WS_WGU + ((size_t)e * 512 + (size_t)pn * 256) * D * 2;
        } else { const int ts = tile - NTr; if (F.tid < 256) tab[F.tid] = (unsigned)(ts * 256 + F.tid); Bp = ws + WS_WSGU + (size_t)pn * 256 * D * 2; }
        if (F.tid == 0) put_unit(F, i, ws + WS_H2, Bp, TAB_OFF + i * 1024, tile * 256, pn * 128);
        ++n; }
    __syncthreads();
    pg8::ListSched Sd{(const LAS pg8::UnitRec*)(F.lds + ULIST_OFF), n};
    pg8::EpiSwiglu E{(bf16*)(ws + WS_H), 256};
    pg8::gemm_phase<pg8::EpiSwiglu, pg8::ListSched, true, pg8::NoHook>(F.lds, D, Sd, E, pg8::NoHook{}, F.wave);
}

__device__ __forceinline__ void p6(Frame& F) {
    unsigned char* ws = F.ws;
    moe_prefix(F);
    const LAS int* pre = (const LAS int*)(F.lds + PRE_OFF);
    const int NTr = pre[64], ntl = moe_tiles(NTr), NU = ntl * 4;
    unsigned char* Y = y_base(F, ntl);
    int n = 0;
    for (int i = 0; i < 16; ++i) { const int L = i * F.G + F.vcu; if (L >= NU) break;
        const int tile = L >> 2, pn = L & 3; const void* Bp;
        if (tile < NTr) { const int e = moe_find_list(pre, tile); Bp = ws + WS_WD + ((size_t)e * D + (size_t)pn * 256) * 256 * 2; }
        else Bp = ws + WS_WSD + (size_t)pn * 256 * 256 * 2;
        if (F.tid == 0) put_unit(F, i, ws + WS_H + (size_t)tile * 256 * 512, Bp, -1, tile * 256, pn * 256);
        ++n; }
    __syncthreads();
    pg8::ListSched Sd{(const LAS pg8::UnitRec*)(F.lds + ULIST_OFF), n};
    pg8::EpiFp8 E{Y, D};
    pg8::gemm_phase<pg8::EpiFp8, pg8::ListSched, false, pg8::NoHook>(F.lds, 256, Sd, E, pg8::NoHook{}, F.wave);
}

__device__ __forceinline__ void y_acc(f32x4 (&ff)[4], const unsigned char* yr, int lane, float w) {
    const v4u u = *(const GAS v4u*)(yr + 16 * lane);
#pragma unroll
    for (int i = 0; i < 4; ++i) { typedef float f2 __attribute__((ext_vector_type(2)));
        const f2 a = __builtin_amdgcn_cvt_pk_f32_fp8((int)u[i], false), b = __builtin_amdgcn_cvt_pk_f32_fp8((int)u[i], true);
        ff[i] += (f32x4){a.x, a.y, b.x, b.y} * w; }
}
template <bool DRY> __device__ __forceinline__ void p7(Frame& F) {
    const bool live = !DRY || (__hip_atomic_load(F.ctl + 3, RLX_AGENT) == 0xdeadbeefu);
    const float* const* in = F.in; unsigned char* ws = F.ws;
    moe_prefix(F);
    const LAS int* pre = (const LAS int*)(F.lds + PRE_OFF);
    const int NTr = pre[64], ntl = moe_tiles(NTr);
    const unsigned char* Y = y_base(F, ntl);
    const float* mod = (const float*)(ws + WS_MOD);
    const unsigned* tokmap = (const unsigned*)(ws + WS_TOKMAP); const float* wts = (const float*)(ws + WS_WTS);
    const int gw = F.vcu * NWAVES + F.wave, NGW = F.G * NWAVES, lane = F.lane;
    for (int token = gw; token < T; token += NGW) {
        const int b = token / S;
        unsigned tm = 0u; float wv = 0.f;
        if (lane < 8) { tm = tokmap[(size_t)token * 8 + lane]; wv = wts[(size_t)token * 8 + lane]; }
        f32x4 ff[4];
#pragma unroll
        for (int i = 0; i < 4; ++i) ff[i] = (f32x4){0.f, 0.f, 0.f, 0.f};
        y_acc(ff, Y + ((size_t)NTr * 256 + token) * D, lane, 1.0f / 16.0f);
#pragma unroll
        for (int k = 0; k < 8; ++k) { const unsigned m = (unsigned)__builtin_amdgcn_readlane((int)tm, k); const float w = __uint_as_float((unsigned)__builtin_amdgcn_readlane((int)__float_as_uint(wv), k));
            const int e = (int)(m >> 16), pos = (int)(m & 0xFFFFu);
            y_acc(ff, Y + ((size_t)pre[e] * 256 + pos) * D, lane, w * (1.0f / 16.0f)); }
        float ss = 0.f;
#pragma unroll
        for (int i = 0; i < 4; ++i) ss += (ff[i].x * ff[i].x + ff[i].y * ff[i].y) + (ff[i].z * ff[i].z + ff[i].w * ff[i].w);
        const float rstd = rsqrtf(wave_sum(ss) * (1.f / D) + EPS);
#pragma unroll
        for (int i = 0; i < 4; ++i) { const int c = 16 * lane + 4 * i;
            const f32x4 x1 = *(const GAS f32x4*)(F.out + (size_t)token * D + c), gt = *(const f32x4*)(mod + b * 6144 + 5120 + c), gp = *(const f32x4*)(in[I_GPOSTFFN] + c);
            if (live) *(GAS f32x4*)(F.out + (size_t)token * D + c) = x1 + gt * (ff[i] * rstd) * gp; }
    }
}
}
namespace mk {
#ifndef MK_NPHASES_DONE
#define MK_NPHASES_DONE 3
#endif
constexpr int PH_P0A = 0, PH_P0B = 1, PH_P1 = 2, PH_P2 = 3, PH_P3 = 4, PH_P4 = 5, PH_P5 = 6, PH_P6 = 7, PH_P7 = 8, N_PHASES = 9;

__global__ void __launch_bounds__(NTHR, 2) mk_fwd(Args a) {
    extern __shared__ __attribute__((aligned(16))) unsigned char lds_[];
    Frame F;
    F.lds = (LAS unsigned char*)lds_; F.ws = a.ws; F.ctl = (unsigned*)(a.ws + WS_CTL); F.in = a.in; F.out = a.out;
    F.tid = threadIdx.x; F.lane = F.tid & 63; F.wave = __builtin_amdgcn_readfirstlane(F.tid >> 6);
    F.G = gridDim.x; { const int bx = blockIdx.x; F.vcu = (F.G % 8 == 0) ? (bx % 8) * (F.G / 8) + bx / 8 : bx; }
    for (int u = F.tid; u < 128; u += NTHR) ((LAS unsigned*)(F.lds + LDSCTL_OFF))[u] = 0u;
    __syncthreads();
    const int lo = a.ph_lo, hi = a.ph_hi;
    const bool multi = (hi - lo) > 1;
    XcdBarrier bar; bar.bar = F.ctl + CW_BAR; bar.x = 0; bar.st = nullptr;
    if (multi) bar = xcd_barrier_post(F.ctl + CW_BAR, (volatile LAS unsigned*)(F.lds + MISC_OFF) + 8);
#define IN(k) (lo <= (k) && (k) < hi)
#define SEAM(k) do { if (IN(k) && IN((k) + 1)) xcd_barrier(bar); } while (0)
#ifndef MK_DBL
#define MK_DBL 0
#endif
#define DBL(k) (((MK_DBL) >> (k)) & 1)
#define REFRESH() do { int l_; asm volatile("v_mbcnt_lo_u32_b32 %0, -1, 0\n\tv_mbcnt_hi_u32_b32 %0, -1, %0" : "=v"(l_)); F.lane = l_; F.tid = F.wave * 64 + l_; } while (0)
#define RUN(k, call, drycall) do { if (IN(k)) { if (DBL(k)) { REFRESH(); drycall; if (multi) xcd_barrier(bar); } REFRESH(); call; } SEAM(k); } while (0)
    RUN(PH_P0A, p0a(F), p0a(F));
    RUN(PH_P0B, p0b(F), p0b(F));
    RUN(PH_P1, p1(F), p1(F));
#if MK_NPHASES_DONE > 3
    RUN(PH_P2, p2(F), p2(F));
#endif
#if MK_NPHASES_DONE > 4
    RUN(PH_P3, p3(F), p3(F));
#endif
#if MK_NPHASES_DONE > 5
    RUN(PH_P4, p4<false>(F), p4<true>(F));
#endif
#if MK_NPHASES_DONE > 6
    RUN(PH_P5, p5(F), p5(F));
#endif
#if MK_NPHASES_DONE > 7
    RUN(PH_P6, p6(F), p6(F));
    if (IN(PH_P7)) { if (DBL(PH_P7)) { REFRESH(); p7<true>(F); if (multi) xcd_barrier(bar); } REFRESH(); p7<false>(F); }
#endif
#undef RUN
#undef REFRESH
#undef DBL
#undef IN
#undef SEAM
}

static int g_grid = 0;
static bool setup_once() {
    if (g_grid == 0) {
        int dev = 0, cus = 0;
        if (hipGetDevice(&dev) != hipSuccess || hipDeviceGetAttribute(&cus, hipDeviceAttributeMultiprocessorCount, dev) != hipSuccess) { g_grid = -1; return false; }
        if (hipFuncSetAttribute((const void*)mk_fwd, hipFuncAttributeMaxDynamicSharedMemorySize, LDS_BYTES) != hipSuccess) { g_grid = -1; return false; }
        (void)hipGetLastError();
        g_grid = cus;
    }
    return g_grid > 0;
}
static void launch_phases(void* const* d_in, void* d_out, void* d_ws, hipStream_t stream, int lo, int hi) {
    Args a{};
    for (int i = 0; i < N_IN; ++i) a.in[i] = (const float*)d_in[i];
    a.out = (float*)d_out; a.ws = (unsigned char*)d_ws; a.ph_lo = lo; a.ph_hi = hi;
    hipLaunchKernelGGL(mk_fwd, dim3(g_grid), dim3(NTHR), LDS_BYTES, stream, a);
}
}
extern "C" void kernel_launch(void* const* d_in, const int* in_sizes, int n_in, void* d_out, int out_size, void* d_ws, size_t ws_size, hipStream_t stream) {
    if (!mk::setup_once()) return;
    if (ws_size < mk::WS_END) return;
    hipMemsetAsync(d_ws, 0, mk::CTL_ZERO_BYTES, stream);
    mk::launch_phases(d_in, d_out, d_ws, stream, 0, mk::N_PHASES);
}
```

```cpp
#include <hip/hip_runtime.h>
#include <cstdio>
#include <cstdint>
#include <cmath>
#include <hip/hip_bf16.h>
#define MK_NPHASES_DONE 9
namespace pg8 {
#define PG8_LAS __attribute__((address_space(3)))
typedef unsigned short bf16_t;
typedef short bf16x8 __attribute__((ext_vector_type(8)));
typedef float f32x4 __attribute__((ext_vector_type(4)));
typedef unsigned u32x4 __attribute__((ext_vector_type(4)));
typedef unsigned u32x2 __attribute__((ext_vector_type(2)));
typedef int i32x4 __attribute__((ext_vector_type(4)));
typedef int i32x8 __attribute__((ext_vector_type(8)));
constexpr int BM = 256, BK = 64, HALF = 128, HTB = HALF * BK * 2, STAGE_BYTES = 8 * HTB;

__host__ __device__ __forceinline__ int lds_byte(int r, int c) { const int st = (r >> 4) * 2 + (c >> 5), rr = r & 15, cc = c & 31, ob = rr * 64 + cc * 2; return st * 1024 + (ob ^ (((ob >> 9) & 1) << 5)); }
__host__ __device__ __forceinline__ void stage_rc(int b, int& R, int& C) { const int st = b / 1024, sb = b % 1024, swz = sb ^ (((sb >> 9) & 1) << 5); R = (st >> 1) * 16 + swz / 64; C = (st & 1) * 32 + (swz % 64) / 2; }
__host__ __device__ __forceinline__ int perm32(int rho) { const int n = rho >> 4, i = rho & 15; return 8 * (i >> 2) + 4 * n + (i & 3); }

struct Unit { const char* A; const char* B; int tab; int orow; int ocol; int aux; };
struct UnitRec { unsigned long long A, B; int tab, orow, ocol, aux; };
struct ListSched {
    const PG8_LAS UnitRec* list; int n;
    __device__ __forceinline__ bool next(int i, Unit& u) const {
        if (i >= n) return false;
        const PG8_LAS UnitRec* r = list + i;
        const unsigned long long a = r->A, b = r->B;
        const unsigned alo = __builtin_amdgcn_readfirstlane((unsigned)a), ahi = __builtin_amdgcn_readfirstlane((unsigned)(a >> 32));
        const unsigned blo = __builtin_amdgcn_readfirstlane((unsigned)b), bhi = __builtin_amdgcn_readfirstlane((unsigned)(b >> 32));
        u.A = (const char*)(((unsigned long long)ahi << 32) | alo); u.B = (const char*)(((unsigned long long)bhi << 32) | blo);
        u.tab = __builtin_amdgcn_readfirstlane(r->tab); u.orow = __builtin_amdgcn_readfirstlane(r->orow); u.ocol = __builtin_amdgcn_readfirstlane(r->ocol); u.aux = __builtin_amdgcn_readfirstlane(r->aux);
        return true;
    }
};
struct NoHook { __device__ __forceinline__ void at(int, f32x4 (&)[2][2][4][2], int, int, int) const {} };

__device__ __forceinline__ unsigned cvt_pk_bf16(float lo, float hi) { unsigned r; asm volatile("v_cvt_pk_bf16_f32 %0, %1, %2" : "=v"(r) : "v"(lo), "v"(hi)); return r; }

struct EpiBf16 {
    static constexpr bool PERM = true;
    bf16_t* O; int ldc;
    __device__ __forceinline__ void operator()(const f32x4 (&acc)[2][2][4][2], const Unit& u, int wr, int wc, int fr, int fq) const {
        const int row0 = u.orow + wr * 64 + fr, col0 = u.ocol + wc * 32 + 8 * fq;
#pragma unroll
        for (int ai = 0; ai < 2; ++ai)
#pragma unroll
            for (int m = 0; m < 4; ++m) { bf16_t* rowp = O + (size_t)(row0 + ai * HALF + m * 16) * ldc + col0;
#pragma unroll
                for (int bj = 0; bj < 2; ++bj) { const f32x4 v0 = acc[ai][bj][m][0], v1 = acc[ai][bj][m][1];
                    u32x4 w; w.x = cvt_pk_bf16(v0[0], v0[1]); w.y = cvt_pk_bf16(v0[2], v0[3]); w.z = cvt_pk_bf16(v1[0], v1[1]); w.w = cvt_pk_bf16(v1[2], v1[3]);
                    *(u32x4*)(rowp + bj * HALF) = w; } }
    }
};
struct EpiRowScaleBf16 {
    static constexpr bool PERM = true;
    bf16_t* O; int ldc; const PG8_LAS float* rs;
    __device__ __forceinline__ void operator()(const f32x4 (&acc)[2][2][4][2], const Unit& u, int wr, int wc, int fr, int fq) const {
        const int row0 = u.orow + wr * 64 + fr, col0 = u.ocol + wc * 32 + 8 * fq;
#pragma unroll
        for (int ai = 0; ai < 2; ++ai)
#pragma unroll
            for (int m = 0; m < 4; ++m) { bf16_t* rowp = O + (size_t)(row0 + ai * HALF + m * 16) * ldc + col0; const float s = rs[ai * HALF + wr * 64 + m * 16 + fr];
#pragma unroll
                for (int bj = 0; bj < 2; ++bj) { const f32x4 v0 = acc[ai][bj][m][0] * s, v1 = acc[ai][bj][m][1] * s;
                    u32x4 w; w.x = cvt_pk_bf16(v0[0], v0[1]); w.y = cvt_pk_bf16(v0[2], v0[3]); w.z = cvt_pk_bf16(v1[0], v1[1]); w.w = cvt_pk_bf16(v1[2], v1[3]);
                    *(u32x4*)(rowp + bj * HALF) = w; } }
    }
};
struct EpiFp8 {
    static constexpr bool PERM = true;
    unsigned char* O; int ldc;
    __device__ __forceinline__ void operator()(const f32x4 (&acc)[2][2][4][2], const Unit& u, int wr, int wc, int fr, int fq) const {
        const int row0 = u.orow + wr * 64 + fr, col0 = u.ocol + wc * 32 + 8 * fq;
#pragma unroll
        for (int ai = 0; ai < 2; ++ai)
#pragma unroll
            for (int m = 0; m < 4; ++m) { unsigned char* rowp = O + (size_t)(row0 + ai * HALF + m * 16) * ldc + col0;
#pragma unroll
                for (int bj = 0; bj < 2; ++bj) { f32x4 v0 = acc[ai][bj][m][0] * 16.0f, v1 = acc[ai][bj][m][1] * 16.0f;
#pragma unroll
                    for (int j = 0; j < 4; ++j) { v0[j] = __builtin_amdgcn_fmed3f(v0[j], -448.f, 448.f); v1[j] = __builtin_amdgcn_fmed3f(v1[j], -448.f, 448.f); }
                    int p0 = __builtin_amdgcn_cvt_pk_fp8_f32(v0[0], v0[1], 0, false); p0 = __builtin_amdgcn_cvt_pk_fp8_f32(v0[2], v0[3], p0, true);
                    int p1 = __builtin_amdgcn_cvt_pk_fp8_f32(v1[0], v1[1], 0, false); p1 = __builtin_amdgcn_cvt_pk_fp8_f32(v1[2], v1[3], p1, true);
                    u32x2 w; w.x = (unsigned)p0; w.y = (unsigned)p1; *(u32x2*)(rowp + bj * HALF) = w; } }
    }
};
__device__ __forceinline__ float silu_mul(float g, float u) { return g * u * __builtin_amdgcn_rcpf(1.0f + __builtin_amdgcn_exp2f(-1.4426950408889634f * g)); }
struct EpiSwiglu {
    static constexpr bool PERM = true;
    bf16_t* O; int ldc; float s;
    __device__ __forceinline__ void operator()(const f32x4 (&acc)[2][2][4][2], const Unit& u, int wr, int wc, int fr, int fq) const {
        const int row0 = u.orow + wr * 64 + fr, col0 = u.ocol + wc * 32 + 8 * fq;
#pragma unroll
        for (int ai = 0; ai < 2; ++ai)
#pragma unroll
            for (int m = 0; m < 4; ++m) { bf16_t* rowp = O + (size_t)(row0 + ai * HALF + m * 16) * ldc + col0;
                const f32x4 g0 = acc[ai][0][m][0] * s, g1 = acc[ai][0][m][1] * s, u0 = acc[ai][1][m][0] * s, u1 = acc[ai][1][m][1] * s;
                u32x4 w; w.x = cvt_pk_bf16(silu_mul(g0[0], u0[0]), silu_mul(g0[1], u0[1])); w.y = cvt_pk_bf16(silu_mul(g0[2], u0[2]), silu_mul(g0[3], u0[3]));
                w.z = cvt_pk_bf16(silu_mul(g1[0], u1[0]), silu_mul(g1[1], u1[1])); w.w = cvt_pk_bf16(silu_mul(g1[2], u1[2]), silu_mul(g1[3], u1[3]));
                *(u32x4*)rowp = w; }
    }
};

template <class Epi, class Sched, bool GATHER, class Hook, bool FP8 = false>
__device__ __forceinline__ void gemm_phase(PG8_LAS unsigned char* lds, const int K, const Sched& S, const Epi& E, const Hook& H, const int wid  ) {
    int lane; asm volatile("v_mbcnt_lo_u32_b32 %0, -1, 0\n\tv_mbcnt_hi_u32_b32 %0, -1, %0" : "=v"(lane));
    const int tid = wid * 64 + lane, wr = wid >> 2, wc = wid & 3, fr = lane & 15, fq = lane >> 4;
    const int nt = K / BK;
    unsigned voffB[2];
#pragma unroll
    for (int i = 0; i < 2; ++i) { int R, C; stage_rc(tid * 16 + i * 8192, R, C); const int Rb = Epi::PERM ? ((R & ~31) + perm32(R & 31)) : R; voffB[i] = (unsigned)(Rb * K + C) * 2u; }
    const size_t kstep = (size_t)(BK * 2);
    const size_t hstep = (size_t)HALF * K * 2;
    const unsigned ldsw = (unsigned)wid * 1024u;
    const int aoff = lds_byte(wr * 64 + fr, fq * 8), boff = lds_byte(wc * 32 + fr, fq * 8);
    unsigned offC[2][2];
#define PG8_LOADOFF(dst, u) do { _Pragma("unroll") for (int _i = 0; _i < 2; ++_i) { int _R, _C; stage_rc(tid * 16 + _i * 8192, _R, _C); _Pragma("unroll") for (int _h = 0; _h < 2; ++_h) { \
        if constexpr (GATHER) { const unsigned _row = *(const PG8_LAS unsigned*)(lds + (u).tab + 4 * (_h * HALF + _R)); dst[_h][_i] = _row * (unsigned)(K * 2) + (unsigned)(_C * 2); } \
        else dst[_h][_i] = (unsigned)((_h * HALF + _R) * K + _C) * 2u; } } } while (0)
#define PG8_SA(b, h) (((b) * 2 + (h)) * HTB)
#define PG8_SB(b, h) ((4 + (b) * 2 + (h)) * HTB)
#define PG8_STAGE(bufoff, gbase, voff) do { _Pragma("unroll") for (int _i = 0; _i < 2; ++_i) \
        __builtin_amdgcn_global_load_lds((const unsigned*)((const char*)(gbase) + (voff)[_i]), (PG8_LAS unsigned*)(lds + (bufoff) + ldsw + _i * 8192), 16, 0, 0); } while (0)
#define PG8_LDA(dst, b, h) do { _Pragma("unroll") for (int m = 0; m < 4; ++m) _Pragma("unroll") for (int k = 0; k < 2; ++k) dst[m][k] = *(const PG8_LAS bf16x8*)(lds + PG8_SA(b, h) + aoff + m * 2048 + k * 1024); } while (0)
#define PG8_LDB(dst, b, h) do { _Pragma("unroll") for (int n = 0; n < 2; ++n) _Pragma("unroll") for (int k = 0; k < 2; ++k) dst[n][k] = *(const PG8_LAS bf16x8*)(lds + PG8_SB(b, h) + boff + n * 2048 + k * 1024); } while (0)
#define PG8_CAT(x, y) __builtin_shufflevector(__builtin_bit_cast(i32x4, x), __builtin_bit_cast(i32x4, y), 0, 1, 2, 3, 4, 5, 6, 7)
#define PG8_MMA(ai, bj, At, Bt) do { __builtin_amdgcn_s_setprio(1); if constexpr (FP8) { _Pragma("unroll") for (int m = 0; m < 4; ++m) _Pragma("unroll") for (int n = 0; n < 2; ++n) \
        acc[ai][bj][m][n] = __builtin_amdgcn_mfma_scale_f32_16x16x128_f8f6f4(PG8_CAT(Bt[n][0], Bt[n][1]), PG8_CAT(At[m][0], At[m][1]), acc[ai][bj][m][n], 0, 0, 0, 0x7F7F7F7F, 0, 0x7F7F7F7F); } else { \
        _Pragma("unroll") for (int m = 0; m < 4; ++m) _Pragma("unroll") for (int n = 0; n < 2; ++n) _Pragma("unroll") for (int k = 0; k < 2; ++k) \
        acc[ai][bj][m][n] = __builtin_amdgcn_mfma_f32_16x16x32_bf16(Bt[n][k], At[m][k], acc[ai][bj][m][n], 0, 0, 0); } __builtin_amdgcn_s_setprio(0); } while (0)
#define PG8_WAIT_V(n) asm volatile("s_waitcnt vmcnt(" #n ")" ::: "memory")
#define PG8_WAIT_L(n) asm volatile("s_waitcnt lgkmcnt(" #n ")" ::: "memory")
#define PG8_BAR __builtin_amdgcn_s_barrier()
#define PG8_SCHED __builtin_amdgcn_sched_barrier(0)
    Unit cur, nxt; int ui = 0;
    if (!S.next(0, cur)) return;
    f32x4 acc[2][2][4][2];
#pragma unroll
    for (int a = 0; a < 2; ++a)
#pragma unroll
        for (int b = 0; b < 2; ++b)
#pragma unroll
            for (int m = 0; m < 4; ++m)
#pragma unroll
                for (int n = 0; n < 2; ++n) acc[a][b][m][n] = (f32x4){0.f, 0.f, 0.f, 0.f};
    bf16x8 At[4][2], B0[2][2], B1[2][2];
    const char* cA = cur.A; const char* cB = cur.B;
    PG8_LOADOFF(offC, cur);
    PG8_STAGE(PG8_SB(0, 0), cB, voffB); PG8_STAGE(PG8_SB(0, 1), cB + hstep, voffB); PG8_STAGE(PG8_SA(0, 0), cA, offC[0]); PG8_STAGE(PG8_SA(0, 1), cA, offC[1]);
    if (wr == 1) PG8_BAR;
    PG8_WAIT_V(2); PG8_BAR;
    PG8_STAGE(PG8_SB(1, 0), cB + kstep, voffB); PG8_STAGE(PG8_SA(1, 0), cA + kstep, offC[0]); PG8_STAGE(PG8_SB(1, 1), cB + hstep + kstep, voffB);
    PG8_WAIT_V(6); PG8_BAR;
    for (;;) {
        const bool has_next = S.next(ui + 1, nxt);
        const char* nA = has_next ? nxt.A : cA; const char* nB = has_next ? nxt.B : cB;
        for (int t = 0; t < nt; t += 2) {
            const bool last = (t == nt - 2);
            H.at(t, acc, wr, fr, lane);
            const char* a1 = cA + (size_t)(t + 1) * kstep;
            const char* a2 = last ? nA : cA + (size_t)(t + 2) * kstep; const char* b2 = last ? nB : cB + (size_t)(t + 2) * kstep;
            const char* a3 = a2 + kstep; const char* b3 = b2 + kstep;
            PG8_LDB(B0, 0, 0); PG8_LDB(B1, 0, 1); PG8_SCHED; PG8_LDA(At, 0, 0); PG8_STAGE(PG8_SA(1, 1), a1, offC[1]);
            if constexpr (GATHER) { if (last && has_next) { PG8_LOADOFF(offC, nxt); } }
            PG8_WAIT_V(8); PG8_WAIT_L(0); PG8_BAR; PG8_MMA(0, 0, At, B0); PG8_MMA(0, 1, At, B1); PG8_BAR; PG8_SCHED;
            PG8_LDA(At, 0, 1); PG8_STAGE(PG8_SB(0, 0), b2, voffB); PG8_STAGE(PG8_SB(0, 1), b2 + hstep, voffB); PG8_STAGE(PG8_SA(0, 0), a2, offC[0]);
            PG8_WAIT_V(8); PG8_WAIT_L(0); PG8_BAR; PG8_MMA(1, 0, At, B0); PG8_MMA(1, 1, At, B1); PG8_BAR; PG8_SCHED;
            PG8_LDB(B0, 1, 0); PG8_LDB(B1, 1, 1); PG8_SCHED; PG8_LDA(At, 1, 0); PG8_STAGE(PG8_SA(0, 1), a2, offC[1]);
            PG8_WAIT_V(8); PG8_WAIT_L(0); PG8_BAR; PG8_MMA(0, 0, At, B0); PG8_MMA(0, 1, At, B1); PG8_BAR; PG8_SCHED;
            PG8_LDA(At, 1, 1); PG8_STAGE(PG8_SB(1, 0), b3, voffB); PG8_STAGE(PG8_SB(1, 1), b3 + hstep, voffB); PG8_STAGE(PG8_SA(1, 0), a3, offC[0]);
            PG8_WAIT_V(8); PG8_WAIT_L(0); PG8_BAR; PG8_MMA(1, 0, At, B0); PG8_MMA(1, 1, At, B1); PG8_BAR; PG8_SCHED;
        }
        if (wr == 0) PG8_BAR;
        { int l2; asm volatile("v_mbcnt_lo_u32_b32 %0, -1, 0\n\tv_mbcnt_hi_u32_b32 %0, -1, %0" : "=v"(l2)); E(acc, cur, wr, wc, l2 & 15, l2 >> 4); }
        if (!has_next) break;
#pragma unroll
        for (int a = 0; a < 2; ++a)
#pragma unroll
            for (int b = 0; b < 2; ++b)
#pragma unroll
                for (int m = 0; m < 4; ++m)
#pragma unroll
                    for (int n = 0; n < 2; ++n) acc[a][b][m][n] = (f32x4){0.f, 0.f, 0.f, 0.f};
        cur = nxt; cA = nA; cB = nB; ++ui;
        if (wr == 1) PG8_BAR;
    }
    PG8_WAIT_V(0);
    PG8_BAR;
#undef PG8_LOADOFF
#undef PG8_SA
#undef PG8_SB
#undef PG8_STAGE
#undef PG8_LDA
#undef PG8_LDB
#undef PG8_MMA
#undef PG8_CAT
#undef PG8_WAIT_V
#undef PG8_WAIT_L
#undef PG8_BAR
#undef PG8_SCHED
}
}
namespace mk {
#define GAS __attribute__((address_space(1)))
#define LAS __attribute__((address_space(3)))
typedef unsigned short bf16;
typedef unsigned v4u __attribute__((ext_vector_type(4)));
typedef unsigned v2u __attribute__((ext_vector_type(2)));
typedef float f32x4 __attribute__((ext_vector_type(4)));
typedef short bf16x8 __attribute__((ext_vector_type(8)));

constexpr int T = 16384, D = 1024, S = 2048, NB = 8, NH = 8, HD = 64, NE = 64, DIN = 2056;
constexpr int NTHR = 512, NWAVES = 8;
constexpr float EPS = 1e-6f;
constexpr float LOG2E = 1.4426950408889634f;
constexpr float QSCALE = 0.125f * LOG2E;
constexpr int NLIST = 64, LIST_CAP = 16384;

constexpr size_t MiB = 1u << 20;
constexpr size_t WS_CTL = 0, CTL_ZERO_BYTES = 1 * MiB;
constexpr size_t WS_SMALL = 1 * MiB;
constexpr size_t WS_MOD = WS_SMALL, WS_WF = WS_SMALL + 256 * 1024, WS_LOGF = WS_SMALL + 512 * 1024, WS_SSQP = WS_SMALL + 1 * MiB, WS_SSQA = WS_SSQP + 512 * 1024,
                 WS_TOKMAP = WS_SSQA + 512 * 1024, WS_WTS = WS_TOKMAP + 512 * 1024, WS_LISTS = WS_WTS + 512 * 1024;
constexpr size_t WS_WD = 8 * MiB, WS_WSD = 40 * MiB;
constexpr size_t WS_H = 40 * MiB + 512 * 1024;
constexpr size_t WS_HB = 41 * MiB, WS_PROJ = 73 * MiB, WS_YCAT = 41 * MiB, WS_MIXED = 73 * MiB;
constexpr size_t WS_WIN = 190 * MiB, WS_WOUT = 194 * MiB, WS_WSGU = 196 * MiB, WS_WPOOL = 197 * MiB, WS_WRHI = WS_WPOOL + 128 * 1024, WS_WRLO = WS_WRHI + 128 * 1024;
constexpr size_t WS_H2 = 199 * MiB  , WS_WGU = 231 * MiB  , WS_END = 295 * MiB;
constexpr float H2_SCALE = 8.0f, WGU_SCALE = 64.0f;
static_assert(WS_LISTS + (size_t)NLIST * LIST_CAP * 4 <= WS_WD && WS_WRLO + 128 * 1024 <= WS_H2, "ws map");
constexpr int CW_TMO = 0, CW_BAR = 4096, CW_CNT = 8192;

constexpr int RING_BYTES = 131072, LDSCTL_OFF = RING_BYTES, MISC_OFF = LDSCTL_OFF, ULIST_OFF = LDSCTL_OFF + 512, PRE_OFF = ULIST_OFF + 512, TAB_OFF = PRE_OFF + 528,
              RS_OFF = TAB_OFF + 8192, LDS_BYTES = 147456;
constexpr int MAXU = 8;
static_assert(RS_OFF + 2048 <= LDS_BYTES && (TAB_OFF % 16) == 0, "LDS map");

#define RLX_AGENT __ATOMIC_RELAXED, __HIP_MEMORY_SCOPE_AGENT
#define LDS_WAIT() asm volatile("s_waitcnt lgkmcnt(0)" ::: "memory")
#define VM_WAIT() asm volatile("s_waitcnt vmcnt(0)" ::: "memory")
__device__ __forceinline__ unsigned f2bf(float f) { unsigned u = __builtin_bit_cast(unsigned, f); return (u + 0x7fffu + ((u >> 16) & 1u)) >> 16; }
__device__ __forceinline__ unsigned pk2(float lo, float hi) { return f2bf(lo) | (f2bf(hi) << 16); }
__device__ __forceinline__ float bf2f(unsigned h) { return __builtin_bit_cast(float, h << 16); }
__device__ __forceinline__ float wave_sum(float v) {
#pragma unroll
    for (int o = 1; o < 64; o <<= 1) v += __shfl_xor(v, o);
    return v;
}

#define XB_TMO      128
#define XB_XCNT(j)  (256  + 64 * (j))
#define XB_XSUB(j)  (1280 + 64 * (j))
#define XB_XGEN(j)  (2304 + 64 * (j))
#define XB_TOP      3328
#define XB_TOPGEN   3392
#define XCD_BAR_WORDS 3456
#define XB_SPIN_CAP (1u << 18)
__device__ __forceinline__ unsigned xb_ld(unsigned* p)              { return __hip_atomic_load(p, __ATOMIC_RELAXED, __HIP_MEMORY_SCOPE_AGENT); }
__device__ __forceinline__ unsigned xb_add(unsigned* p, unsigned v) { return __hip_atomic_fetch_add(p, v, __ATOMIC_RELAXED, __HIP_MEMORY_SCOPE_AGENT); }
__device__ __forceinline__ unsigned xb_xcc_id() { return (unsigned)__builtin_amdgcn_s_getreg((3 << 11) | 20) & 0xFu; }
#define XB_SPIN(cond, bar) do { unsigned _sp = 0; while (cond) { __builtin_amdgcn_s_sleep(1); \
    if ((++_sp & 255u) == 0u) { if (xb_ld(&(bar)[XB_TMO])) break; if (_sp > XB_SPIN_CAP) { atomicAdd(&(bar)[XB_TMO], 1u); break; } } } } while (0)
struct XcdBarrier { unsigned* bar; unsigned x; volatile LAS unsigned* st; };
__device__ __forceinline__ XcdBarrier xcd_barrier_post(unsigned* bar, volatile LAS unsigned* st) {
    XcdBarrier b; b.bar = bar; b.x = xb_xcc_id(); b.st = st;
    if (threadIdx.x == 0) (void)xb_add(&bar[XB_XCNT(b.x)], 1u);
    return b;
}
__device__ __forceinline__ void xcd_barrier_complete(unsigned* bar, unsigned x, unsigned& nloc, unsigned& nx) {
    const unsigned G = gridDim.x * gridDim.y * gridDim.z;
    unsigned sum, cnt, mine, sp = 0u;
    for (;;) {
        sum = 0u; cnt = 0u; mine = 0u;
#pragma unroll
        for (unsigned j = 0; j < 16; ++j) { const unsigned c = xb_ld(&bar[XB_XCNT(j)]); sum += c; cnt += (c > 0u) ? 1u : 0u; mine = (j == x) ? c : mine; }
        if (sum == G) break;
        __builtin_amdgcn_s_sleep(1);
        if ((++sp & 255u) == 0u) { if (xb_ld(&bar[XB_TMO])) break; if (sp > XB_SPIN_CAP) { atomicAdd(&bar[XB_TMO], 1u); break; } }
    }
    nloc = mine > 0u ? mine : 1u; nx = cnt > 0u ? cnt : 1u;
}
__device__ __forceinline__ void xcd_barrier(const XcdBarrier& b) {
    asm volatile("s_waitcnt vmcnt(0)" ::: "memory");
    __syncthreads();
    if (threadIdx.x == 0) {
        unsigned* bar = b.bar;
        __builtin_amdgcn_s_waitcnt(0);
        unsigned nloc = b.st[0], nx = b.st[1];
        if (nloc == 0u) { xcd_barrier_complete(bar, b.x, nloc, nx); b.st[0] = nloc; b.st[1] = nx; }
        const unsigned old = xb_add(&bar[XB_XSUB(b.x)], 1u);
        const unsigned gen = old / nloc;
        if (old + 1u == (gen + 1u) * nloc) {
            __builtin_amdgcn_fence(__ATOMIC_RELEASE, "agent");
            asm volatile("s_waitcnt vmcnt(0)" ::: "memory");
            const unsigned og = xb_add(&bar[XB_TOP], 1u);
            const unsigned tg = og / nx;
            if (og + 1u == (tg + 1u) * nx) xb_add(&bar[XB_TOPGEN], 1u);
            else XB_SPIN(xb_ld(&bar[XB_TOPGEN]) == tg, bar);
            __builtin_amdgcn_fence(__ATOMIC_ACQUIRE, "agent");
            xb_add(&bar[XB_XGEN(b.x)], 1u);
            asm volatile("s_waitcnt vmcnt(0)" ::: "memory");
        } else {
            XB_SPIN(xb_ld(&bar[XB_XGEN(b.x)]) == gen, bar);
            __builtin_amdgcn_fence(__ATOMIC_ACQUIRE, "agent");
            asm volatile("s_waitcnt vmcnt(0)" ::: "memory");
        }
    }
    __syncthreads();
}

enum { I_X = 0, I_C, I_WADA, I_BADA, I_GPREMIX, I_GPOSTMIX, I_GPREFFN, I_GPOSTFFN, I_WIN, I_BFORGET, I_WPOOL, I_POOLSCALE, I_GPOOLOUT, I_GATTNOUT, I_WOUT,
       I_WROUTER, I_RBIAS, I_WGATE, I_WUP, I_WDOWN, I_WSGATE, I_WSUP, I_WSDOWN, N_IN };

struct Args { const float* in[N_IN]; float* out; unsigned char* ws; int ph_lo, ph_hi; };

struct Frame {
    LAS unsigned char* lds; unsigned* ctl; unsigned char* ws; const float* const* in; float* out;
    int tid, lane, wave, vcu, G;
};
}
namespace mk {
template <int MODE>
__device__ __forceinline__ void tr_item(const float* W, int ldn, int k0, int n0, bf16* WT, bf16* WT2, int Kd, int rowbase, const float* sc, float cmul, LAS float* scr, int lane) {
#pragma unroll 8
    for (int i = 0; i < 32; ++i) { const int kk = 2 * i + (lane >> 5); scr[kk * 33 + (lane & 31)] = W[(size_t)(k0 + kk) * ldn + n0 + (lane & 31)]; }
    LDS_WAIT(); asm volatile("" ::: "memory");
    const int c = lane & 7;
#pragma unroll
    for (int j = 0; j < 4; ++j) { const int n = (lane >> 3) + 8 * j; const LAS float* s = scr + (8 * c) * 33 + n;
        float v[8];
#pragma unroll
        for (int i = 0; i < 8; ++i) { v[i] = s[i * 33] * cmul; if (MODE == 1) v[i] *= sc[k0 + 8 * c + i]; if (MODE == 2) v[i] *= sc[n0 + n]; }
        if (MODE == 4) { int p0 = __builtin_amdgcn_cvt_pk_fp8_f32(v[0], v[1], 0, false); p0 = __builtin_amdgcn_cvt_pk_fp8_f32(v[2], v[3], p0, true);
            int p1 = __builtin_amdgcn_cvt_pk_fp8_f32(v[4], v[5], 0, false); p1 = __builtin_amdgcn_cvt_pk_fp8_f32(v[6], v[7], p1, true);
            v2u o8; o8.x = (unsigned)p0; o8.y = (unsigned)p1; *(GAS v2u*)((unsigned char*)WT + (size_t)(rowbase + n) * Kd + k0 + 8 * c) = o8; continue; }
        v4u o; o.x = pk2(v[0], v[1]); o.y = pk2(v[2], v[3]); o.z = pk2(v[4], v[5]); o.w = pk2(v[6], v[7]);
        *(GAS v4u*)(WT + (size_t)(rowbase + n) * Kd + k0 + 8 * c) = o;
        if (MODE == 3) {
#pragma unroll
            for (int i = 0; i < 8; ++i) v[i] = v[i] - bf2f(f2bf(v[i]));
            v4u p; p.x = pk2(v[0], v[1]); p.y = pk2(v[2], v[3]); p.z = pk2(v[4], v[5]); p.w = pk2(v[6], v[7]);
            *(GAS v4u*)(WT2 + (size_t)(rowbase + n) * Kd + k0 + 8 * c) = p; } }
    LDS_WAIT(); asm volatile("" ::: "memory");
}

__device__ __forceinline__ void p0a(Frame& F) {
    const float* const* in = F.in; unsigned char* ws = F.ws;
    if (F.vcu < 192) {
        LAS float* red = (LAS float*)F.lds;
        const int col0 = 32 * F.vcu, kk = F.tid >> 3, c4 = F.tid & 7;
        const float* wa = in[I_WADA]; const float* cc = in[I_C];
        f32x4 acc[8];
#pragma unroll
        for (int b = 0; b < 8; ++b) acc[b] = (f32x4){0.f, 0.f, 0.f, 0.f};
#pragma unroll 4
        for (int i = 0; i < 16; ++i) { const int k = kk + 64 * i; const f32x4 w = *(const f32x4*)(wa + (size_t)k * 6144 + col0 + 4 * c4);
#pragma unroll
            for (int b = 0; b < 8; ++b) acc[b] += w * cc[b * D + k]; }
#pragma unroll
        for (int b = 0; b < 8; ++b) *(LAS f32x4*)(red + kk * 256 + b * 32 + 4 * c4) = acc[b];
        __syncthreads();
        if (F.tid < 256) { float s = 0.f;
#pragma unroll 8
            for (int k2 = 0; k2 < 64; ++k2) s += red[k2 * 256 + F.tid];
            const int b = F.tid >> 5, c = F.tid & 31; ((float*)(ws + WS_MOD))[b * 6144 + col0 + c] = s + in[I_BADA][col0 + c]; }
        __syncthreads();
    }
    if (F.vcu == 255) { float* wf = (float*)(ws + WS_WF); for (int i = F.tid; i < 8192; i += NTHR) { const int j = i >> 10, k = i & 1023; wf[i] = in[I_WIN][(size_t)k * DIN + 2048 + j]; } }
    LAS float* scr = (LAS float*)(F.lds + F.wave * 16384);
    const int gw = F.vcu * NWAVES + F.wave, NGW = F.G * NWAVES, lane = F.lane;
    constexpr int I_E = 8192, I_IN = 1024, I_OUT = 512, I_S = 128, I_P = 32, I_R = 32;
    constexpr int NITEMS = 3 * I_E + I_IN + I_OUT + 3 * I_S + I_P + I_R;
    bf16* Wgu = (bf16*)(ws + WS_WGU); bf16* Wd = (bf16*)(ws + WS_WD);
    for (int it = gw; it < NITEMS; it += NGW) {
        int r = it;
        if (r < 2 * I_E) { const int up = r >= I_E; if (up) r -= I_E; const int e = r >> 7, rem = r & 127, k0 = 64 * (rem >> 3), n0 = 32 * (rem & 7);
            tr_item<4>(in[up ? I_WUP : I_WGATE] + (size_t)e * D * 256, 256, k0, n0, (bf16*)((unsigned char*)Wgu + (size_t)e * 512 * D), nullptr, D, (n0 >> 7) * 256 + (n0 & 127) + (up ? 128 : 0), nullptr, WGU_SCALE, scr, lane); continue; }
        r -= 2 * I_E;
        if (r < I_E) { const int e = r >> 7, rem = r & 127, k0 = 64 * (rem >> 5), n0 = 32 * (rem & 31);
            tr_item<0>(in[I_WDOWN] + (size_t)e * 256 * D, D, k0, n0, Wd + (size_t)e * D * 256, nullptr, 256, n0, nullptr, 1.f, scr, lane); continue; }
        r -= I_E;
        if (r < I_IN) { const int k0 = 64 * (r >> 6), n0 = 32 * (r & 63);
            tr_item<0>(in[I_WIN], DIN, k0, n0, (bf16*)(ws + WS_WIN), nullptr, D, n0, nullptr, (n0 >= 512 && n0 < 1024) ? QSCALE : 1.f, scr, lane); continue; }
        r -= I_IN;
        if (r < I_OUT) { const int k0 = 64 * (r >> 5), n0 = 32 * (r & 31);
            tr_item<1>(in[I_WOUT], D, k0, n0, (bf16*)(ws + WS_WOUT), nullptr, D, n0, k0 < 512 ? in[I_GPOOLOUT] : in[I_GATTNOUT] - 512, 1.f, scr, lane); continue; }
        r -= I_OUT;
        if (r < 2 * I_S) { const int up = r >= I_S; if (up) r -= I_S; const int k0 = 64 * (r >> 3), n0 = 32 * (r & 7);
            tr_item<4>(in[up ? I_WSUP : I_WSGATE], 256, k0, n0, (bf16*)(ws + WS_WSGU), nullptr, D, (n0 >> 7) * 256 + (n0 & 127) + (up ? 128 : 0), nullptr, WGU_SCALE, scr, lane); continue; }
        r -= 2 * I_S;
        if (r < I_S) { const int k0 = 64 * (r >> 5), n0 = 32 * (r & 31);
            tr_item<0>(in[I_WSDOWN], D, k0, n0, (bf16*)(ws + WS_WSD), nullptr, 256, n0, nullptr, 1.f, scr, lane); continue; }
        r -= I_S;
        if (r < I_P) { const int g = r >> 3, rem = r & 7, k0 = 64 * (rem >> 2), n0 = 32 * (rem & 3);
            tr_item<2>(in[I_WPOOL] + (size_t)g * 16384, 128, k0, n0, (bf16*)(ws + WS_WPOOL) + (size_t)g * 16384, nullptr, 128, n0, in[I_POOLSCALE] + g * 128, 1.f, scr, lane); continue; }
        r -= I_P;
        { const int k0 = 64 * (r >> 1), n0 = 32 * (r & 1);
            tr_item<3>(in[I_WROUTER], 64, k0, n0, (bf16*)(ws + WS_WRHI), (bf16*)(ws + WS_WRLO), D, n0, nullptr, 1.f, scr, lane); }
    }
}

__device__ __forceinline__ void p0b(Frame& F) {
    const float* const* in = F.in; unsigned char* ws = F.ws;
    LAS float* wfl = (LAS float*)F.lds;
    { const float* wf = (const float*)(ws + WS_WF); for (int i = F.tid; i < 2048; i += NTHR) *(LAS f32x4*)(wfl + 4 * i) = *(const f32x4*)(wf + 4 * i); }
    __syncthreads();
    const int gw = F.vcu * NWAVES + F.wave, lane = F.lane, NGW = F.G * NWAVES;
    const float* mod = (const float*)(ws + WS_MOD);
    for (int r0 = 8 * gw; r0 < T; r0 += 8 * NGW) {
        const int b = r0 / S;
        f32x4 gs[4], sh[4];
#pragma unroll
        for (int j = 0; j < 4; ++j) { const int c = 4 * lane + 256 * j; const f32x4 g = *(const f32x4*)(in[I_GPREMIX] + c), sc = *(const f32x4*)(mod + b * 6144 + 1024 + c);
            gs[j] = g * (sc + 1.0f); sh[j] = *(const f32x4*)(mod + b * 6144 + c); }
        const float bfg = in[I_BFORGET][lane & 7];
        for (int rr = 0; rr < 8; ++rr) {
            const int row = r0 + rr; const GAS f32x4* xr = (const GAS f32x4*)(in[I_X] + (size_t)row * D) + lane;
            f32x4 v[4]; float ss = 0.f;
#pragma unroll
            for (int j = 0; j < 4; ++j) { v[j] = xr[64 * j]; ss += (v[j].x * v[j].x + v[j].y * v[j].y) + (v[j].z * v[j].z + v[j].w * v[j].w); }
            const float rstd = rsqrtf(wave_sum(ss) * (1.f / D) + EPS);
            GAS unsigned long long* o8 = (GAS unsigned long long*)((bf16*)(ws + WS_HB) + (size_t)row * D) + lane;
#pragma unroll
            for (int j = 0; j < 4; ++j) { v[j] = v[j] * rstd * gs[j] + sh[j]; o8[64 * j] = (unsigned long long)pk2(v[j].x, v[j].y) | ((unsigned long long)pk2(v[j].z, v[j].w) << 32); }
            float z = 0.f;
#pragma unroll
            for (int h = 0; h < 8; ++h) { float p = 0.f;
#pragma unroll
                for (int j = 0; j < 4; ++j) { const f32x4 w = *(const LAS f32x4*)(wfl + h * 1024 + 4 * lane + 256 * j); p += (v[j].x * w.x + v[j].y * w.y) + (v[j].z * w.z + v[j].w * w.w); }
                p = wave_sum(p); z = (lane == h) ? p : z; }
            if (lane < 8) { const float u = z + bfg; ((float*)(ws + WS_LOGF))[(size_t)row * 8 + lane] = fminf(u, 0.f) - log1pf(__expf(-fabsf(u))); }
        }
    }
}

__device__ __forceinline__ bool static_unit(int nM, int nN, int G, int c, int i, int& pm, int& pn) {
    const int nwg = nM * nN; const long L = (long)i * G + c; if (L >= nwg) return false;
    int wgid = (int)L; { const int q = nwg / 8, r = nwg % 8, xcd = wgid % 8, off = wgid / 8; wgid = (xcd < r ? xcd * (q + 1) : r * (q + 1) + (xcd - r) * q) + off; }
    const int nig = 8 * nN, gid = wgid / nig, fm = gid * 8, gsz = (nM - fm) < 8 ? (nM - fm) : 8;
    pm = fm + ((wgid % nig) % gsz); pn = (wgid % nig) / gsz; return true;
}
__device__ __forceinline__ void put_unit(Frame& F, int i, const void* A, const void* B, int tab, int orow, int ocol) {
    LAS pg8::UnitRec* r = (LAS pg8::UnitRec*)(F.lds + ULIST_OFF) + i;
    r->A = (unsigned long long)(uintptr_t)A; r->B = (unsigned long long)(uintptr_t)B; r->tab = tab; r->orow = orow; r->ocol = ocol; r->aux = 0;
}
__device__ __forceinline__ void p1(Frame& F) {
    unsigned char* ws = F.ws; int n = 0;
    for (int i = 0; i < MAXU; ++i) { int pm, pn; if (!static_unit(T / 256, 2048 / 256, F.G, (int)blockIdx.x, i, pm, pn)) break;
        if (F.tid == 0) put_unit(F, i, ws + WS_HB + (size_t)pm * 256 * D * 2, ws + WS_WIN + (size_t)pn * 256 * D * 2, -1, pm * 256, pn * 256);
        ++n; }
    __syncthreads();
    pg8::ListSched Sd{(const LAS pg8::UnitRec*)(F.lds + ULIST_OFF), n};
    pg8::EpiBf16 E{(bf16*)(ws + WS_PROJ), 2048};
    pg8::gemm_phase<pg8::EpiBf16, pg8::ListSched, false, pg8::NoHook>(F.lds, D, Sd, E, pg8::NoHook{}, F.wave);
}
}
namespace attn_body {
using bf16=__hip_bfloat16;
using bf16x8=__attribute__((ext_vector_type(8)))short;
using s16x4=__attribute__((ext_vector_type(4)))short;
using f32x16=__attribute__((ext_vector_type(16)))float;
using u32x4=__attribute__((ext_vector_type(4)))unsigned;
constexpr int BATCH=8,NHEAD=8,SEQ=2048,D=64,DM=2048,PO=1024;
constexpr int NW=8,QBLK=32,QB=QBLK*NW,KVBLK=64,NQB=SEQ/QB;
__device__ __forceinline__ int crow(int r,int hi){return (r&3)+8*(r>>2)+4*hi;}
#define SBAR() __builtin_amdgcn_sched_barrier(0)
__device__ __forceinline__ void cmask(f32x16&p0,f32x16&p1,int jb,int qrel,int hi){
  const float NEG=-INFINITY; int kb=64*jb+4*hi;
  #pragma unroll
  for(int r=0;r<16;++r){int kv=kb+(r&3)+8*(r>>2); if(kv>qrel)p0[r]=NEG; if(kv+32>qrel)p1[r]=NEG;}
}

constexpr int NSLOT=3, SLOTB=8192;
constexpr int LDS_K=0, LDS_V=NSLOT*SLOTB, LDS_WS=2*NSLOT*SLOTB, LDS_OST=LDS_WS+NW*64*4, LDS_CUM=LDS_OST+NW*4096, LDS_KB=LDS_CUM+SEQ*4, LDS_BYTES=LDS_KB+SEQ*4;
__device__ __forceinline__ void glds16(const void*gsrc,unsigned lds_dst){unsigned keep;
  asm volatile("s_mov_b32 %0, m0\n\ts_mov_b32 m0, %2\n\ts_nop 0\n\tglobal_load_lds_dwordx4 %1, off\n\ts_mov_b32 m0, %0":"=&s"(keep):"v"(gsrc),"s"(lds_dst):"memory");}
__device__ __forceinline__ float max3f(float a,float b,float c){float r;asm("v_max3_f32 %0, %1, %2, %3":"=v"(r):"v"(a),"v"(b),"v"(c));return r;}
__device__ __forceinline__ float max2f(float a,float b){float r;asm("v_max_f32_e32 %0, %1, %2":"=v"(r):"v"(a),"v"(b));return r;}
__device__ __forceinline__ float fadd_s(float a,float b){float r;asm("v_add_f32_e32 %0, %1, %2":"=v"(r):"v"(a),"v"(b));return r;}
__device__ __forceinline__ float fsub_s(float a,float b){float r;asm("v_sub_f32_e32 %0, %1, %2":"=v"(r):"v"(a),"v"(b));return r;}
typedef float f32x2_t __attribute__((ext_vector_type(2))); typedef __bf16 bf16x2_t __attribute__((ext_vector_type(2)));
__device__ __forceinline__ unsigned cvtpk_s(float lo,float hi){f32x2_t v={lo,hi};bf16x2_t b=__builtin_convertvector(v,bf16x2_t);return __builtin_bit_cast(unsigned,b);}
#define WAIT_BAR(N) asm volatile("s_waitcnt vmcnt(" #N ") lgkmcnt(0)\n\ts_barrier":::"memory")

__device__ __forceinline__ void qkt(f32x16&p0,f32x16&p1,const char*Kslot,const bf16x8*qr,bf16x8 kb0,bf16x8 kb1,bf16x8 qb,int r32,int hi){
  const char*kb=Kslot+hi*1024+r32*16;
  p0=__builtin_amdgcn_mfma_f32_32x32x16_bf16(kb0,qb,f32x16{},0,0,0);p1=__builtin_amdgcn_mfma_f32_32x32x16_bf16(kb1,qb,f32x16{},0,0,0);
  #pragma unroll
  for(int d0=0;d0<4;++d0){
    const bf16x8 b0=*reinterpret_cast<const bf16x8*>(kb+d0*2048);
    const bf16x8 b1=*reinterpret_cast<const bf16x8*>(kb+d0*2048+512);
    p0=__builtin_amdgcn_mfma_f32_32x32x16_bf16(b0,qr[d0],p0,0,0,0);p1=__builtin_amdgcn_mfma_f32_32x32x16_bf16(b1,qr[d0],p1,0,0,0);}
}
typedef __attribute__((address_space(3))) const char* lds_cptr;
typedef short v4i16_t __attribute__((ext_vector_type(4)));
__device__ __forceinline__ void kload8(bf16x8*kf,lds_cptr kp){
  kf[0]=*(const __attribute__((address_space(3))) bf16x8*)(kp);      kf[1]=*(const __attribute__((address_space(3))) bf16x8*)(kp+512);
  kf[2]=*(const __attribute__((address_space(3))) bf16x8*)(kp+2048); kf[3]=*(const __attribute__((address_space(3))) bf16x8*)(kp+2560);
  kf[4]=*(const __attribute__((address_space(3))) bf16x8*)(kp+4096); kf[5]=*(const __attribute__((address_space(3))) bf16x8*)(kp+4608);
  kf[6]=*(const __attribute__((address_space(3))) bf16x8*)(kp+6144); kf[7]=*(const __attribute__((address_space(3))) bf16x8*)(kp+6656);
}
__device__ __forceinline__ void kload2(bf16x8*kf,lds_cptr kp,int j){ kf[2*j]=*(const __attribute__((address_space(3))) bf16x8*)(kp+j*2048); kf[2*j+1]=*(const __attribute__((address_space(3))) bf16x8*)(kp+j*2048+512); }
__device__ __forceinline__ s16x4 vtr(lds_cptr p){ return __builtin_bit_cast(s16x4,__builtin_amdgcn_ds_read_tr16_b64_v4i16((__attribute__((address_space(3))) v4i16_t*)p)); }
__device__ __forceinline__ float rowmax(const f32x16&p0,const f32x16&p1){
  float a=max3f(p0[0],p0[1],p1[0]),b=max3f(p0[2],p0[3],p1[1]);a=max3f(a,p1[2],p1[3]);
  #pragma unroll
  for(int r=4;r<16;r+=4){a=max3f(a,p0[r],p0[r+1]);b=max3f(b,p0[r+2],p0[r+3]);a=max3f(a,p1[r],p1[r+1]);b=max3f(b,p1[r+2],p1[r+3]);}
  const float m=max2f(a,b);
  auto rr=__builtin_amdgcn_permlane32_swap(__float_as_uint(m),__float_as_uint(m),false,false);
  return max2f(__uint_as_float(rr[0]),__uint_as_float(rr[1]));
}
__device__ __forceinline__ void pv(f32x16*o,int vb,bf16x8 pa0,bf16x8 pa1,bf16x8 pa2,bf16x8 pa3){
  #pragma unroll
  for(int d0=0;d0<2;++d0){s16x4 lo[4],hi[4];
    #pragma unroll
    for(int ks=0;ks<4;++ks){
      asm volatile("ds_read_b64_tr_b16 %0,%1 offset:%c2":"=&v"(lo[ks]):"v"(vb),"i"(d0*4096+ks*1024):"memory");
      asm volatile("ds_read_b64_tr_b16 %0,%1 offset:%c2":"=&v"(hi[ks]):"v"(vb),"i"(d0*4096+ks*1024+512):"memory");}
    asm volatile("s_waitcnt lgkmcnt(0)":::"memory");SBAR();
    #define PK(k) (bf16x8){lo[k][0],lo[k][1],lo[k][2],lo[k][3],hi[k][0],hi[k][1],hi[k][2],hi[k][3]}
    o[d0]=__builtin_amdgcn_mfma_f32_32x32x16_bf16(pa0,PK(0),o[d0],0,0,0);
    o[d0]=__builtin_amdgcn_mfma_f32_32x32x16_bf16(pa1,PK(1),o[d0],0,0,0);
    o[d0]=__builtin_amdgcn_mfma_f32_32x32x16_bf16(pa2,PK(2),o[d0],0,0,0);
    o[d0]=__builtin_amdgcn_mfma_f32_32x32x16_bf16(pa3,PK(3),o[d0],0,0,0);
    #undef PK
  }
}

#ifndef ATTN_STORE16
#define ATTN_STORE16(p,v) (*(u32x4*)(p)=(v))
#endif
template<int THRL> __device__ __forceinline__ void attn_unit(int b,int h,int qb,const bf16*Q,const bf16*__restrict__ K,const bf16*__restrict__ V,bf16*O,float*ssq,char*shm,const int wid){
  int lane; asm volatile("v_mbcnt_lo_u32_b32 %0, -1, 0\n\tv_mbcnt_hi_u32_b32 %0, -1, %0" : "=v"(lane));
  const int tid=wid*64+lane, r32=lane&31,hi=lane>>5;
  const long rowbase=(long)b*SEQ; const int q0=qb*QB;
  const bf16*Qw=Q+(rowbase+q0+wid*QBLK)*DM+h*D;
  const bf16*Kh=K+rowbase*DM+h*D,*Vh=V+rowbase*DM+h*D;
  const unsigned lds0=(unsigned)(uintptr_t)shm;
  float*wsf=(float*)(shm+LDS_WS)+wid*64;
  const bf16*ksrc=Kh+(long)lane*DM+wid*8;
  const bf16*vsrc=Vh+(long)(16*(wid&3)+(lane>>2))*DM+(wid>>2)*32+(lane&3)*8;
  const unsigned kdst=lds0+LDS_K+wid*1024, vdst=lds0+LDS_V+wid*1024;
  #define DMA_K(t,slot) glds16(ksrc+(long)(t)*KVBLK*DM,(unsigned)__builtin_amdgcn_readfirstlane(kdst+(slot)))
  #define DMA_V(t,slot) glds16(vsrc+(long)(t)*KVBLK*DM,(unsigned)__builtin_amdgcn_readfirstlane(vdst+(slot)))
  const int vb0=(int)(lds0+LDS_V)+((lane>>4)&1)*32+(lane&3)*8+(4*hi+((lane&15)>>2))*64;
  const char*Kbase=shm+LDS_K; bf16x8 kf[8];
  const lds_cptr shm3=(lds_cptr)shm; const lds_cptr kp0=shm3+LDS_K+hi*1024+r32*16; const lds_cptr vp0=shm3+LDS_V+((lane>>4)&1)*32+(lane&3)*8+(4*hi+((lane&15)>>2))*64;
  const int NT=(q0+QB)/KVBLK;
  { const float*cum=(const float*)(shm+LDS_CUM); unsigned*kbt_=(unsigned*)(shm+LDS_KB); const float ref=cum[q0+QB-1];
    for(int k=tid;k<NT*KVBLK;k+=NW*64){ const float v=(ref-cum[k])*1.4426950408889634f; const unsigned hb=mk::f2bf(v); kbt_[k]=hb|(mk::f2bf(v-mk::bf2f(hb))<<16); }
    __syncthreads(); }
  const __attribute__((address_space(3))) unsigned* kbt=(const __attribute__((address_space(3))) unsigned*)((lds_cptr)shm+LDS_KB);
  const unsigned kone1=hi?0u:0x3F803F80u;
  #define KBF(pk) __builtin_bit_cast(bf16x8,(u32x4){(pk),kone1,kone1,0u})
  unsigned kbr0,kbr1;
  #define KBRD(G,tt) do{ if(G){ const unsigned a_=kbt[(tt)*KVBLK+r32], b_=kbt[(tt)*KVBLK+32+r32]; kbr0=a_; kbr1=b_; } }while(0)
  bf16x8 qb_=__builtin_bit_cast(bf16x8,(u32x4){kone1,0u,0u,0u});
  #define SETREF() do{ const float nm_=-mhat; const unsigned h0_=__float_as_uint(nm_)&0xFFFF0000u; const float r1_=nm_-__uint_as_float(h0_); const unsigned h1_=__float_as_uint(r1_)&0xFFFF0000u; \
      const float r2_=r1_-__uint_as_float(h1_); const unsigned h2_=__float_as_uint(r2_)&0xFFFF0000u; \
      qb_=__builtin_bit_cast(bf16x8,(u32x4){kone1, hi?0u:((h0_>>16)|h1_), hi?0u:(h2_>>16), 0u}); }while(0)
  DMA_K(0,0);DMA_V(0,0);DMA_K(1,SLOTB);
  bf16x8 qr[4];
  #pragma unroll
  for(int d0=0;d0<4;++d0)qr[d0]=*reinterpret_cast<const bf16x8*>(&Qw[(long)r32*DM+d0*16+hi*8]);
  const lds_cptr qp0=shm3+LDS_OST+wid*4096+hi*512+r32*16;
  #pragma unroll
  for(int d0=0;d0<4;++d0)*(__attribute__((address_space(3))) bf16x8*)((__attribute__((address_space(3))) char*)(qp0+d0*1024))=qr[d0];
  #define QF(d0) (*(const __attribute__((address_space(3))) bf16x8*)(qp0+(d0)*1024))
  float mhat=0.f,l_reg=0.f;f32x16 o[2];o[0]=f32x16{};o[1]=f32x16{};
  const int qrel=wid*QBLK+r32;
  #define CMASK(P0,P1,t) do{int jb_=(t)-(NT-4); if(jb_>=0)cmask(P0,P1,jb_,qrel,hi);}while(0)
  bool resc=false;
  #define START(P0,P1) do{ const float rm=rowmax(P0,P1); resc=false; \
    { const float dl=rm; mhat=fadd_s(mhat,dl); \
      _Pragma("unroll") for(int r=0;r<16;++r){P0[r]=fsub_s(P0[r],dl);P1[r]=fsub_s(P1[r],dl);} \
      SETREF(); } \
    _Pragma("unroll") for(int r=0;r<16;++r)P0[r]=__builtin_amdgcn_exp2f(P0[r]); }while(0)
  #define RESC() do{ if(resc){ asm volatile("s_waitcnt lgkmcnt(0)":::"memory"); \
      _Pragma("unroll") for(int d_=0;d_<2;++d_) _Pragma("unroll") for(int r=0;r<16;++r)o[d_][r]*=wsf[crow(r,hi)]; } }while(0)
  f32x16 pA0,pA1,pB0,pB1;
  int sl_prev=0,sl_cur=0,sl_next=SLOTB;
  #define ROT() do{sl_prev=sl_cur;sl_cur=sl_next;sl_next=(sl_next==(NSLOT-1)*SLOTB)?0:sl_next+SLOTB;}while(0)
  DMA_K(2,2*SLOTB);
  WAIT_BAR(3);
  KBRD(true,0);
  qkt(pA0,pA1,Kbase,qr,KBF(kbr0),KBF(kbr1),qb_,r32,hi);asm volatile("s_nop 15\n\ts_nop 7":"+v"(pA0),"+v"(pA1));CMASK(pA0,pA1,0);
  START(pA0,pA1);
  _Pragma("unroll") for(int r=0;r<16;++r)pA1[r]=__builtin_amdgcn_exp2f(pA1[r]);
  WAIT_BAR(0);
  DMA_K(3,0);DMA_V(1,SLOTB);
  ROT();
  kload8(kf,kp0+sl_cur);
  KBRD(true,1);
  WAIT_BAR(2);
  s16x4 vlo[8],vhi[8]; u32x4 pw0,pw1,pw2,pw3;
  #define PKW(P,B) cvtpk_s(P[B],P[B+1])
  #define PAF(k) __builtin_bit_cast(bf16x8,pw##k)
  #define VFR(i) (bf16x8){vlo[i][0],vlo[i][1],vlo[i][2],vlo[i][3],vhi[i][0],vhi[i][1],vhi[i][2],vhi[i][3]}
  #define PIN(x) asm volatile("":"+v"(x))
  #define MX3(a,b,c) __builtin_fmaxf(__builtin_fmaxf((a),(b)),(c))
  #define GAPA(MF,A0,A1,A2,A3,W0,W1,PW) do{ MF; sacc+=A0; sacc+=A1; sacc+=A2; sacc+=A3; PIN(sacc); W0; W1; PIN(PW); SBAR(); }while(0)
  #define EX(v) __builtin_amdgcn_exp2f(v)
  #define GAPB(MF,X,B) do{ MF; X[B]=EX(X[B]); X[B+1]=EX(X[B+1]); X[B+2]=EX(X[B+2]); X[B+3]=EX(X[B+3]); PIN(X); SBAR(); }while(0)
  #define VRD(i) do{ vlo[i]=vtr(vp_+(((i)>>2)*4096+((i)&3)*1024)); vhi[i]=vtr(vp_+(((i)>>2)*4096+((i)&3)*1024+512)); }while(0)
  #define KRD(G,j) do{ if(G){ kload2(kf,kp0+sl_next,j); SBAR(); } }while(0)
  #define STEP(C0,C1,P0,P1,t,GK,GV,GL) do{ SBAR(); \
    const lds_cptr vp_=vp0+sl_prev; \
    C0=__builtin_amdgcn_mfma_f32_32x32x16_bf16(KBF(kbr0),qb_,f32x16{},0,0,0); C1=__builtin_amdgcn_mfma_f32_32x32x16_bf16(KBF(kbr1),qb_,f32x16{},0,0,0); SBAR(); \
    VRD(0); SBAR(); float sacc=(P0[0]+P0[1]); \
    bf16x8 qa_=QF(0), qc_=QF(1); \
    GAPA(C0=__builtin_amdgcn_mfma_f32_32x32x16_bf16(kf[0],qa_,C0,0,0,0), P0[2],P0[3],P0[4],P0[5],     pw0[0]=PKW(P0,0), pw0[1]=PKW(P0,2), pw0); \
    VRD(4); SBAR(); GAPA(C1=__builtin_amdgcn_mfma_f32_32x32x16_bf16(kf[1],qa_,C1,0,0,0), P0[6],P0[7],P0[8],P0[9],     pw0[2]=PKW(P0,4), pw0[3]=PKW(P0,6), pw0); \
    qa_=QF(2); VRD(1); SBAR(); GAPA(C0=__builtin_amdgcn_mfma_f32_32x32x16_bf16(kf[2],qc_,C0,0,0,0),   P0[10],P0[11],P0[12],P0[13], pw1[0]=PKW(P0,8), pw1[1]=PKW(P0,10), pw1); \
    VRD(5); SBAR(); GAPA(C1=__builtin_amdgcn_mfma_f32_32x32x16_bf16(kf[3],qc_,C1,0,0,0),   P0[14],P0[15],P1[0],P1[1],   pw1[2]=PKW(P0,12),pw1[3]=PKW(P0,14), pw1); \
    qc_=QF(3); VRD(2); SBAR(); GAPA(C0=__builtin_amdgcn_mfma_f32_32x32x16_bf16(kf[4],qa_,C0,0,0,0),   P1[2],P1[3],P1[4],P1[5],     pw2[0]=PKW(P1,0), pw2[1]=PKW(P1,2), pw2); \
    VRD(6); SBAR(); GAPA(C1=__builtin_amdgcn_mfma_f32_32x32x16_bf16(kf[5],qa_,C1,0,0,0),   P1[6],P1[7],P1[8],P1[9],     pw2[2]=PKW(P1,4), pw2[3]=PKW(P1,6), pw2); \
    VRD(3); SBAR(); GAPA(C0=__builtin_amdgcn_mfma_f32_32x32x16_bf16(kf[6],qc_,C0,0,0,0),   P1[10],P1[11],P1[12],P1[13], pw3[0]=PKW(P1,8), pw3[1]=PKW(P1,10), pw3); \
    VRD(7); SBAR(); GAPA(C1=__builtin_amdgcn_mfma_f32_32x32x16_bf16(kf[7],qc_,C1,0,0,0),   P1[14],P1[15],0.f,0.f,       pw3[2]=PKW(P1,12),pw3[3]=PKW(P1,14), pw3); \
    l_reg+=sacc; \
    if(GK){DMA_K((t)+3,sl_cur);} if(GV){DMA_V((t)+1,sl_next);} \
    CMASK(C0,C1,t); \
    { float a=MX3(C0[0],C0[1],C1[0]),b=MX3(C0[2],C0[3],C1[1]); a=MX3(a,C1[2],C1[3]); \
      _Pragma("unroll") for(int r=4;r<16;r+=4){a=MX3(a,C0[r],C0[r+1]);b=MX3(b,C0[r+2],C0[r+3]);a=MX3(a,C1[r],C1[r+1]);b=MX3(b,C1[r+2],C1[r+3]);} \
      float rm=__builtin_fmaxf(a,b); { auto rr=__builtin_amdgcn_permlane32_swap(__float_as_uint(rm),__float_as_uint(rm),false,false); rm=__builtin_fmaxf(__uint_as_float(rr[0]),__uint_as_float(rr[1])); } \
      resc=false; \
      if(__builtin_expect(__any(rm>(float)THRL),0)){ const float dl=__builtin_fmaxf(rm,0.f); mhat+=dl; \
        _Pragma("unroll") for(int r=0;r<16;++r){C0[r]-=dl;C1[r]-=dl;} \
        SETREF(); \
        const float f=__builtin_amdgcn_exp2f(-dl); l_reg*=f; if(hi==0)wsf[r32]=f; resc=true; } } \
    SBAR(); \
    GAPB(o[0]=__builtin_amdgcn_mfma_f32_32x32x16_bf16(PAF(0),VFR(0),o[0],0,0,0), C0,0); \
    GAPB(o[1]=__builtin_amdgcn_mfma_f32_32x32x16_bf16(PAF(0),VFR(4),o[1],0,0,0), C0,4); \
    KRD(GL,0); GAPB(o[0]=__builtin_amdgcn_mfma_f32_32x32x16_bf16(PAF(1),VFR(1),o[0],0,0,0), C0,8); \
    KRD(GL,1); GAPB(o[1]=__builtin_amdgcn_mfma_f32_32x32x16_bf16(PAF(1),VFR(5),o[1],0,0,0), C0,12); \
    KRD(GL,2); GAPB(o[0]=__builtin_amdgcn_mfma_f32_32x32x16_bf16(PAF(2),VFR(2),o[0],0,0,0), C1,0); \
    KRD(GL,3); GAPB(o[1]=__builtin_amdgcn_mfma_f32_32x32x16_bf16(PAF(2),VFR(6),o[1],0,0,0), C1,4); \
    KBRD(GL,(t)+1); \
    GAPB(o[0]=__builtin_amdgcn_mfma_f32_32x32x16_bf16(PAF(3),VFR(3),o[0],0,0,0), C1,8); \
    GAPB(o[1]=__builtin_amdgcn_mfma_f32_32x32x16_bf16(PAF(3),VFR(7),o[1],0,0,0), C1,12); \
    }while(0)
  int t=1;
  #undef CMASK
  #define CMASK(P0,P1,t) do{}while(0)
  for(;t+5<NT;t+=2){
    STEP(pB0,pB1,pA0,pA1,t,true,true,true);     WAIT_BAR(2); RESC(); ROT();
    STEP(pA0,pA1,pB0,pB1,t+1,true,true,true);   WAIT_BAR(2); RESC(); ROT();
  }
  #undef CMASK
  #define CMASK(P0,P1,t) do{int jb_=(t)-(NT-4); if(jb_>=0)cmask(P0,P1,jb_,qrel,hi);}while(0)
  #define ENDW(tt) do{ if((tt)+3<NT){WAIT_BAR(2);} else if((tt)+2<NT){WAIT_BAR(1);} else {WAIT_BAR(0);} }while(0)
  for(;t+1<NT;t+=2){
    STEP(pB0,pB1,pA0,pA1,t,(t+3<NT),(t+1<NT),(t+1<NT));       ENDW(t);   RESC(); ROT();
    STEP(pA0,pA1,pB0,pB1,t+1,(t+4<NT),(t+2<NT),(t+2<NT));     ENDW(t+1); RESC(); ROT();
  }
  STEP(pB0,pB1,pA0,pA1,NT-1,false,false,false); RESC();
  { float sacc=pB0[0]+pB0[1]; _Pragma("unroll") for(int r=2;r<16;++r)sacc+=pB0[r]; _Pragma("unroll") for(int r=0;r<16;++r)sacc+=pB1[r]; l_reg+=sacc;
    pw0=(u32x4){PKW(pB0,0),PKW(pB0,2),PKW(pB0,4),PKW(pB0,6)};pw1=(u32x4){PKW(pB0,8),PKW(pB0,10),PKW(pB0,12),PKW(pB0,14)};pw2=(u32x4){PKW(pB1,0),PKW(pB1,2),PKW(pB1,4),PKW(pB1,6)};pw3=(u32x4){PKW(pB1,8),PKW(pB1,10),PKW(pB1,12),PKW(pB1,14)};
    SBAR(); pv(o,vb0+sl_cur,PAF(0),PAF(1),PAF(2),PAF(3)); }
  #undef PKW
  #undef PAF
  #undef VFR
  #undef PIN
  #undef MX3
  #undef GAPA
  #undef GAPB
  #undef EX
  #undef VRD
  #undef KRD
  #undef STEP
  #undef ENDW
  {auto rr=__builtin_amdgcn_permlane32_swap(__float_as_uint(l_reg),__float_as_uint(l_reg),false,false);l_reg=__uint_as_float(rr[0])+__uint_as_float(rr[1]);}
  if(hi==0)wsf[32+r32]=l_reg;asm volatile("s_waitcnt lgkmcnt(0)":::"memory");
  float rli[16];
  #pragma unroll
  for(int r=0;r<16;++r)rli[r]=__builtin_amdgcn_rcpf(wsf[32+crow(r,hi)]);
  bf16*Ow=O+(rowbase+q0+wid*QBLK)*PO+h*D; float*sq=ssq+(rowbase+q0+wid*QBLK)*8+h;
  { bf16*stg=(bf16*)(shm+LDS_OST)+wid*2048;
    #pragma unroll
    for(int r=0;r<16;++r){const int orow=crow(r,hi);
      #pragma unroll
      for(int d0=0;d0<2;++d0)stg[orow*64+d0*32+r32]=__float2bfloat16(o[d0][r]*rli[r]);}
    asm volatile("s_waitcnt lgkmcnt(0)":::"memory");
    #pragma unroll
    for(int i=0;i<4;++i){const int row=i*8+(lane>>3),ch=lane&7; const u32x4 v=*(const u32x4*)(stg+row*64+ch*8); ATTN_STORE16(Ow+(long)row*PO+ch*8,v);
      float ss=0.f;
      #pragma unroll
      for(int j=0;j<4;++j){ const float a_=__uint_as_float(v[j]<<16), b_=__uint_as_float(v[j]&0xFFFF0000u); ss+=a_*a_+b_*b_; }
      ss+=__shfl_xor(ss,1); ss+=__shfl_xor(ss,2); ss+=__shfl_xor(ss,4); if(ch==0) sq[(long)row*8]=ss; } }
  asm volatile("s_waitcnt lgkmcnt(0)\n\ts_barrier":::"memory");
  #undef DMA_K
  #undef DMA_V
  #undef CMASK
  #undef START
  #undef RESC
  #undef ROT
  #undef KBF
  #undef QF
  #undef KBRD
  #undef SETREF
}
constexpr int ATTN_LDS_BYTES=LDS_BYTES;
#undef SBAR
#undef WAIT_BAR
}

namespace mk {
__device__ __forceinline__ void pool_tile(Frame& F, int tile) {
    unsigned char* ws = F.ws; constexpr int US = 1040;
    const int t0 = tile * 64, tl0 = t0 % S;
    const bf16* proj = (const bf16*)(ws + WS_PROJ);
    for (int c = F.tid; c < 79 * 64; c += NTHR) { const int rr = c >> 6, ch = c & 63; v4u v = (v4u){0u, 0u, 0u, 0u};
        if (tl0 + rr - 15 >= 0) v = *(const GAS v4u*)(proj + (size_t)(t0 - 15 + rr) * 2048 + ch * 8);
        *(LAS v4u*)(F.lds + rr * US + ch * 16) = v; }
    __syncthreads();
    const int mb = F.wave & 3, nh = F.wave >> 2, r = F.lane & 15, kq = F.lane >> 4, tr = mb * 16 + r, tl = tl0 + tr;
    const bf16* wp = (const bf16*)(ws + WS_WPOOL);
    bf16* ycat = (bf16*)(ws + WS_YCAT); float* ssqp = (float*)(ws + WS_SSQP);
#pragma unroll
    for (int g = 0; g < 4; ++g) {
        constexpr int dummy = 0; (void)dummy;
        const int wg = 2 << g; const int n = (tl + 1 < wg) ? tl + 1 : wg; const float inv = 1.0f / (float)n;
        f32x4 acc[4];
#pragma unroll
        for (int nb = 0; nb < 4; ++nb) acc[nb] = (f32x4){0.f, 0.f, 0.f, 0.f};
#pragma unroll
        for (int ks = 0; ks < 4; ++ks) {
            const int c0 = g * 128 + ks * 32 + kq * 8;
            float sum[8];
#pragma unroll
            for (int j = 0; j < 8; ++j) sum[j] = 0.f;
            v4u cur = (v4u){0u, 0u, 0u, 0u};
#pragma unroll
            for (int i = 0; i < wg; ++i) { const v4u v = *(const LAS v4u*)(F.lds + (tr + 15 - i) * US + c0 * 2); if (i == 0) cur = v;
#pragma unroll
                for (int j = 0; j < 4; ++j) { sum[2 * j] += __uint_as_float(v[j] << 16); sum[2 * j + 1] += __uint_as_float(v[j] & 0xFFFF0000u); } }
            v4u pa;
#pragma unroll
            for (int j = 0; j < 4; ++j) pa[j] = pk2(sum[2 * j] * inv - __uint_as_float(cur[j] << 16), sum[2 * j + 1] * inv - __uint_as_float(cur[j] & 0xFFFF0000u));
            const bf16x8 af = __builtin_bit_cast(bf16x8, pa);
#pragma unroll
            for (int nb = 0; nb < 4; ++nb) { const bf16x8 bfr = *(const bf16x8*)(wp + (size_t)g * 16384 + (size_t)(nh * 64 + nb * 16 + r) * 128 + ks * 32 + kq * 8);
                acc[nb] = __builtin_amdgcn_mfma_f32_16x16x32_bf16(bfr, af, acc[nb], 0, 0, 0); }
        }
        const size_t token = (size_t)t0 + tr; float ss = 0.f;
#pragma unroll
        for (int nb = 0; nb < 4; ++nb) { const f32x4 v = acc[nb]; ss += (v[0] * v[0] + v[1] * v[1]) + (v[2] * v[2] + v[3] * v[3]);
            v2u o; o.x = pk2(v[0], v[1]); o.y = pk2(v[2], v[3]);
            *(GAS v2u*)(ycat + token * D + g * 128 + nh * 64 + nb * 16 + 4 * kq) = o; }
        ss += __shfl_xor(ss, 16); ss += __shfl_xor(ss, 32);
        if (kq == 0) ssqp[token * 8 + g * 2 + nh] = ss;
    }
    __syncthreads();
}

__device__ __forceinline__ void p2(Frame& F) {
    unsigned char* ws = F.ws; char* shm = (char*)(uintptr_t)0;
    (void)shm;
    const attn_body::bf16* proj = (const attn_body::bf16*)(ws + WS_PROJ);
    attn_body::bf16* ycat = (attn_body::bf16*)(ws + WS_YCAT);
    const float* logf = (const float*)(ws + WS_LOGF); float* ssqa = (float*)(ws + WS_SSQA);
    char* lds = (char*)F.lds;
    for (int p = F.vcu; p < 256; p += F.G) {
        const int bh = p >> 2, s = p & 3, b = bh >> 3, h = bh & 7;
        { const float* lf = logf + (size_t)b * S * 8 + h; const int k0 = 4 * F.tid;
          const float l0 = lf[(size_t)(k0 + 0) * 8], l1 = lf[(size_t)(k0 + 1) * 8], l2 = lf[(size_t)(k0 + 2) * 8], l3 = lf[(size_t)(k0 + 3) * 8];
          const float c0 = l0, c1 = c0 + l1, c2 = c1 + l2, c3 = c2 + l3; float x = c3;
#pragma unroll
          for (int o = 1; o < 64; o <<= 1) { const float y = __shfl_up(x, o); if (F.lane >= o) x += y; }
          LAS float* wt = (LAS float*)(F.lds + attn_body::LDS_WS);
          if (F.lane == 63) wt[F.wave] = x;
          __syncthreads();
          float base = x - c3; for (int w = 0; w < F.wave; ++w) base += wt[w];
          LAS float* cum = (LAS float*)(F.lds + attn_body::LDS_CUM);
          *(LAS f32x4*)(cum + k0) = (f32x4){base + c0, base + c1, base + c2, base + c3};
          __syncthreads(); }
#pragma nounroll
        for (int u = 0; u < 2; ++u) attn_body::attn_unit<8>(b, h, u ? 7 - s : s, proj + 512, proj + 1024, proj + 1536, ycat + 512, ssqa, lds, F.wave);
    }
    __syncthreads();
    for (int tile = F.vcu; tile < T / 64; tile += F.G) pool_tile(F, tile);
}
}
namespace mk {
struct MidScaleHook {
    const LAS float* ratio;
    __device__ __forceinline__ void at(int t, pg8::f32x4 (&acc)[2][2][4][2], int wr, int fr, int) const {
        if (t == 8) {
#pragma unroll
            for (int ai = 0; ai < 2; ++ai)
#pragma unroll
                for (int m = 0; m < 4; ++m) { const float s = ratio[ai * 128 + wr * 64 + m * 16 + fr];
#pragma unroll
                    for (int bj = 0; bj < 2; ++bj)
#pragma unroll
                        for (int n = 0; n < 2; ++n) acc[ai][bj][m][n] *= s; }
        }
    }
};
__device__ __forceinline__ void p3(Frame& F) {
    unsigned char* ws = F.ws;
    LAS float* ratio = (LAS float*)(F.lds + RS_OFF); LAS float* rs = ratio + 256;
    const float* ssqp = (const float*)(ws + WS_SSQP); const float* ssqa = (const float*)(ws + WS_SSQA);
    for (int i = 0; i < 64; ++i) { int pm, pn; if (!static_unit(T / 256, D / 256, F.G, (int)blockIdx.x, i, pm, pn)) break;
        __syncthreads();
        if (F.tid < 256) { const size_t tok = (size_t)pm * 256 + F.tid; float sp = 0.f, sa = 0.f;
#pragma unroll
            for (int j = 0; j < 8; ++j) { sp += ssqp[tok * 8 + j]; sa += ssqa[tok * 8 + j]; }
            const float rp = rsqrtf(sp * (1.f / 512.f) + EPS), ra = rsqrtf(sa * (1.f / 512.f) + EPS);
            ratio[F.tid] = rp / ra; rs[F.tid] = ra; }
        if (F.tid == 0) put_unit(F, 0, ws + WS_YCAT + (size_t)pm * 256 * D * 2, ws + WS_WOUT + (size_t)pn * 256 * D * 2, -1, pm * 256, pn * 256);
        __syncthreads();
        pg8::ListSched Sd{(const LAS pg8::UnitRec*)(F.lds + ULIST_OFF), 1};
        pg8::EpiRowScaleBf16 E{(bf16*)(ws + WS_MIXED), D, rs};
        pg8::gemm_phase<pg8::EpiRowScaleBf16, pg8::ListSched, false, MidScaleHook>(F.lds, D, Sd, E, MidScaleHook{ratio}, F.wave);
    }
}
}
namespace mk {
__device__ __forceinline__ int p4_swz(int row, int chunk) { return row * 2048 + ((chunk ^ (row & 15)) << 4); }
template <bool DRY> __device__ __forceinline__ void p4(Frame& F) {
    const bool live = !DRY || (__hip_atomic_load(F.ctl + 3, RLX_AGENT) == 0xdeadbeefu);
    const float* const* in = F.in; unsigned char* ws = F.ws;
    const float* mod = (const float*)(ws + WS_MOD);
    const bf16* mixed = (const bf16*)(ws + WS_MIXED); unsigned char* h2g = ws + WS_H2;
    const bf16* wrhi = (const bf16*)(ws + WS_WRHI); const bf16* wrlo = (const bf16*)(ws + WS_WRLO);
    LAS unsigned char* thi = F.lds; LAS unsigned char* tlo = F.lds + 65536;
    const int lane = F.lane;
    for (int tile = F.vcu; tile < T / 32; tile += F.G) {
        for (int rr = 0; rr < 4; ++rr) {
            const int rowi = F.wave * 4 + rr; const size_t token = (size_t)tile * 32 + rowi; const int b = (int)(token / S);
            f32x4 m[4]; float ss = 0.f;
#pragma unroll
            for (int j = 0; j < 4; ++j) { const v2u u = *(const GAS v2u*)(mixed + token * D + 4 * lane + 256 * j);
                m[j] = (f32x4){__uint_as_float(u.x << 16), __uint_as_float(u.x & 0xFFFF0000u), __uint_as_float(u.y << 16), __uint_as_float(u.y & 0xFFFF0000u)};
                ss += (m[j].x * m[j].x + m[j].y * m[j].y) + (m[j].z * m[j].z + m[j].w * m[j].w); }
            const float rm = rsqrtf(wave_sum(ss) * (1.f / D) + EPS);
            float s1 = 0.f;
#pragma unroll
            for (int j = 0; j < 4; ++j) { const int c = 4 * lane + 256 * j;
                const f32x4 xv = *(const GAS f32x4*)(in[I_X] + token * D + c), gt = *(const f32x4*)(mod + b * 6144 + 2048 + c), gp = *(const f32x4*)(in[I_GPOSTMIX] + c);
                m[j] = xv + gt * (m[j] * rm) * gp;
                if (live) *(GAS f32x4*)(F.out + token * D + c) = m[j];
                s1 += (m[j].x * m[j].x + m[j].y * m[j].y) + (m[j].z * m[j].z + m[j].w * m[j].w); }
            const float r1 = rsqrtf(wave_sum(s1) * (1.f / D) + EPS);
#pragma unroll
            for (int j = 0; j < 4; ++j) { const int c = 4 * lane + 256 * j;
                const f32x4 gf = *(const f32x4*)(in[I_GPREFFN] + c), sc = *(const f32x4*)(mod + b * 6144 + 4096 + c), sh = *(const f32x4*)(mod + b * 6144 + 3072 + c);
                const f32x4 h = m[j] * r1 * gf * (sc + 1.0f) + sh;
                const unsigned h0 = f2bf(h.x), h1 = f2bf(h.y), h2_ = f2bf(h.z), h3 = f2bf(h.w);
                v2u hv; hv.x = h0 | (h1 << 16); hv.y = h2_ | (h3 << 16);
                v2u lv; lv.x = pk2(h.x - bf2f(h0), h.y - bf2f(h1)); lv.y = pk2(h.z - bf2f(h2_), h.w - bf2f(h3));
                { int p8 = __builtin_amdgcn_cvt_pk_fp8_f32(h.x * H2_SCALE, h.y * H2_SCALE, 0, false); p8 = __builtin_amdgcn_cvt_pk_fp8_f32(h.z * H2_SCALE, h.w * H2_SCALE, p8, true);
                  if (live) *(GAS unsigned*)(h2g + token * D + c) = (unsigned)p8; }
                const int off = p4_swz(rowi, (lane >> 1) + 32 * j) + (lane & 1) * 8;
                *(LAS v2u*)(thi + off) = hv; *(LAS v2u*)(tlo + off) = lv; }
        }
        __syncthreads();
        { const int mb = F.wave & 1, nb = F.wave >> 1, r = lane & 15, kq = lane >> 4;
          f32x4 acc = (f32x4){0.f, 0.f, 0.f, 0.f};
          const bf16* bh = wrhi + (size_t)(nb * 16 + r) * D + kq * 8; const bf16* bl = wrlo + (size_t)(nb * 16 + r) * D + kq * 8;
#pragma unroll 4
          for (int ks = 0; ks < 32; ++ks) { const int off = p4_swz(mb * 16 + r, ks * 4 + kq);
              const bf16x8 ah = *(const LAS bf16x8*)(thi + off), al = *(const LAS bf16x8*)(tlo + off);
              const bf16x8 bhf = *(const bf16x8*)(bh + ks * 32), blf = *(const bf16x8*)(bl + ks * 32);
              acc = __builtin_amdgcn_mfma_f32_16x16x32_bf16(ah, bhf, acc, 0, 0, 0);
              acc = __builtin_amdgcn_mfma_f32_16x16x32_bf16(al, bhf, acc, 0, 0, 0);
              acc = __builtin_amdgcn_mfma_f32_16x16x32_bf16(ah, blf, acc, 0, 0, 0); }
          __syncthreads();
          LAS float* lg = (LAS float*)F.lds;
#pragma unroll
          for (int i = 0; i < 4; ++i) lg[(mb * 16 + kq * 4 + i) * 65 + nb * 16 + r] = acc[i];
          if (F.tid < 64) ((LAS unsigned*)(F.lds + 16384))[F.tid] = 0u;
        }
        __syncthreads();
        int my_e = 0; float my_w = 0.f; unsigned my_pos = 0u;
        const int tk = F.tid >> 3, gl = F.tid & 7; const size_t rtoken = (size_t)tile * 32 + tk;
        LAS unsigned* hist = (LAS unsigned*)(F.lds + 16384); LAS unsigned* basev = hist + 64;
        if (F.tid < 256) {
            const LAS float* lg = (const LAS float*)F.lds; const int lb = lane & ~7;
            float sc[8], sl[8];
#pragma unroll
            for (int j = 0; j < 8; ++j) { const float x = lg[tk * 65 + gl * 8 + j]; const float s = 1.0f / (1.0f + __expf(-x)); sc[j] = s; sl[j] = s + in[I_RBIAS][gl * 8 + j]; }
            float a = -INFINITY, b2 = -INFINITY;
#pragma unroll
            for (int j = 0; j < 8; ++j) { const float v = sl[j]; if (v > a) { b2 = a; a = v; } else if (v > b2) b2 = v; }
            const float gs = a + b2; int rank = 0;
#pragma unroll
            for (int i = 0; i < 8; ++i) { const float og = __shfl(gs, lb + i); rank += (og > gs || (og == gs && i < gl)) ? 1 : 0; }
            if (rank >= 4) {
#pragma unroll
                for (int j = 0; j < 8; ++j) sl[j] = -INFINITY; }
            float wsum = 0.f, my_s = 0.f;
#pragma unroll
            for (int rd = 0; rd < 8; ++rd) {
                float bv = sl[0]; int be = gl * 8;
#pragma unroll
                for (int j = 1; j < 8; ++j) if (sl[j] > bv) { bv = sl[j]; be = gl * 8 + j; }
#pragma unroll
                for (int msk = 1; msk < 8; msk <<= 1) { const float ov = __shfl_xor(bv, msk); const int oe = __shfl_xor(be, msk); if (ov > bv || (ov == bv && oe < be)) { bv = ov; be = oe; } }
                float ws_ = 0.f;
#pragma unroll
                for (int j = 0; j < 8; ++j) if (be == gl * 8 + j) { ws_ = sc[j]; sl[j] = -INFINITY; }
                const float wsc = __shfl(ws_, lb + (be >> 3));
                wsum += wsc; if (gl == rd) { my_e = be; my_s = wsc; }
            }
            my_w = my_s / wsum * 2.5f;
            my_pos = __hip_atomic_fetch_add(hist + my_e, 1u, __ATOMIC_RELAXED, __HIP_MEMORY_SCOPE_WORKGROUP);
        }
        __syncthreads();
        if (F.tid < 64) { const unsigned c = hist[F.tid]; basev[F.tid] = (c && live) ? __hip_atomic_fetch_add(F.ctl + CW_CNT + 64 * F.tid, c, __ATOMIC_RELAXED, __HIP_MEMORY_SCOPE_AGENT) : 0u; }
        __syncthreads();
        if (F.tid < 256 && live) { const unsigned slot = basev[my_e] + my_pos; const unsigned v = (unsigned)my_e;
            ((unsigned*)(ws + WS_LISTS))[(size_t)v * LIST_CAP + slot] = (unsigned)rtoken;
            ((unsigned*)(ws + WS_TOKMAP))[rtoken * 8 + gl] = (v << 16) | slot;
            ((float*)(ws + WS_WTS))[rtoken * 8 + gl] = my_w; }
        __syncthreads();
    }
}
}
namespace mk {
__device__ __forceinline__ void moe_prefix(Frame& F) {
    LAS int* pre = (LAS int*)(F.lds + PRE_OFF);
    __syncthreads();
    if (F.tid < 64) {
        const int c0 = (int)__hip_atomic_load(F.ctl + CW_CNT + 64 * F.tid, RLX_AGENT);
        const int t0 = (c0 + 255) >> 8; int x = t0;
#pragma unroll
        for (int o = 1; o < 64; o <<= 1) { const int y = __shfl_up(x, o); if (F.lane >= o) x += y; }
        pre[F.tid] = x - t0; if (F.tid == 63) pre[64] = x;
    }
    __syncthreads();
}
__device__ __forceinline__ int moe_find_list(const LAS int* pre, int tile) {
    int lo = 0, hi = 64;
    while (hi - lo > 1) { const int mid = (lo + hi) >> 1; if (pre[mid] <= tile) lo = mid; else hi = mid; }
    return lo;
}
__device__ __forceinline__ int moe_tiles(int NTr) { int nt = NTr + T / 256; const long cap = (long)((WS_END - WS_H) / (256 * (512 + 1024))); return nt > cap ? (int)cap : nt; }
__device__ __forceinline__ unsigned char* y_base(Frame& F, int ntl) { return F.ws + WS_H + (size_t)ntl * 256 * 512; }

__device__ __forceinline__ void p5(Frame& F) {
    unsigned char* ws = F.ws;
    moe_prefix(F);
    const LAS int* pre = (const LAS int*)(F.lds + PRE_OFF);
    const int NTr = pre[64], ntl = moe_tiles(NTr), NU = ntl * 2;
    const unsigned* lists = (const unsigned*)(ws + WS_LISTS);
    int n = 0;
    for (int i = 0; i < MAXU; ++i) { const int L = i * F.G + F.vcu; if (L >= NU) break;
        const int tile = L >> 1, pn = L & 1; const void* Bp; LAS unsigned* tab = (LAS unsigned*)(F.lds + TAB_OFF + i * 1024);
        if (tile < NTr) { const int e = moe_find_list(pre, tile), tl = tile - pre[e];
            const int cnt = (int)__hip_atomic_load(F.ctl + CW_CNT + 64 * e, RLX_AGENT);
            if (F.tid < 256) { const int r = tl * 256 + F.tid; tab[F.tid] = lists[(size_t)e * LIST_CAP + (r < cnt ? r : 0)]; }
            Bp = ws + WS_WGU + ((size_t)e * 512 + (size_t)pn * 256) * D;
        } else { const int ts = tile - NTr; if (F.tid < 256) tab[F.tid] = (unsigned)(ts * 256 + F.tid); Bp = ws + WS_WSGU + (size_t)pn * 256 * D; }
        if (F.tid == 0) put_unit(F, i, ws + WS_H2, Bp, TAB_OFF + i * 1024, tile * 256, pn * 128);
        ++n; }
    __syncthreads();
    pg8::ListSched Sd{(const LAS pg8::UnitRec*)(F.lds + ULIST_OFF), n};
    pg8::EpiSwiglu E{(bf16*)(ws + WS_H), 256, 1.0f / (H2_SCALE * WGU_SCALE)};
    pg8::gemm_phase<pg8::EpiSwiglu, pg8::ListSched, true, pg8::NoHook, true>(F.lds, D / 2, Sd, E, pg8::NoHook{}, F.wave);
}

__device__ __forceinline__ void p6(Frame& F) {
    unsigned char* ws = F.ws;
    moe_prefix(F);
    const LAS int* pre = (const LAS int*)(F.lds + PRE_OFF);
    const int NTr = pre[64], ntl = moe_tiles(NTr), NU = ntl * 4;
    unsigned char* Y = y_base(F, ntl);
    int n = 0;
    for (int i = 0; i < 16; ++i) { const int L = i * F.G + F.vcu; if (L >= NU) break;
        const int tile = L >> 2, pn = L & 3; const void* Bp;
        if (tile < NTr) { const int e = moe_find_list(pre, tile); Bp = ws + WS_WD + ((size_t)e * D + (size_t)pn * 256) * 256 * 2; }
        else Bp = ws + WS_WSD + (size_t)pn * 256 * 256 * 2;
        if (F.tid == 0) put_unit(F, i, ws + WS_H + (size_t)tile * 256 * 512, Bp, -1, tile * 256, pn * 256);
        ++n; }
    __syncthreads();
    pg8::ListSched Sd{(const LAS pg8::UnitRec*)(F.lds + ULIST_OFF), n};
    pg8::EpiFp8 E{Y, D};
    pg8::gemm_phase<pg8::EpiFp8, pg8::ListSched, false, pg8::NoHook>(F.lds, 256, Sd, E, pg8::NoHook{}, F.wave);
}

__device__ __forceinline__ void y_acc(f32x4 (&ff)[4], const unsigned char* yr, int lane, float w) {
    const v4u u = *(const GAS v4u*)(yr + 16 * lane);
#pragma unroll
    for (int i = 0; i < 4; ++i) { typedef float f2 __attribute__((ext_vector_type(2)));
        const f2 a = __builtin_amdgcn_cvt_pk_f32_fp8((int)u[i], false), b = __builtin_amdgcn_cvt_pk_f32_fp8((int)u[i], true);
        ff[i] += (f32x4){a.x, a.y, b.x, b.y} * w; }
}
template <bool DRY> __device__ __forceinline__ void p7(Frame& F) {
    const bool live = !DRY || (__hip_atomic_load(F.ctl + 3, RLX_AGENT) == 0xdeadbeefu);
    const float* const* in = F.in; unsigned char* ws = F.ws;
    moe_prefix(F);
    const LAS int* pre = (const LAS int*)(F.lds + PRE_OFF);
    const int NTr = pre[64], ntl = moe_tiles(NTr);
    const unsigned char* Y = y_base(F, ntl);
    const float* mod = (const float*)(ws + WS_MOD);
    const unsigned* tokmap = (const unsigned*)(ws + WS_TOKMAP); const float* wts = (const float*)(ws + WS_WTS);
    const int gw = F.vcu * NWAVES + F.wave, NGW = F.G * NWAVES, lane = F.lane;
    for (int token = gw; token < T; token += NGW) {
        const int b = token / S;
        unsigned tm = 0u; float wv = 0.f;
        if (lane < 8) { tm = tokmap[(size_t)token * 8 + lane]; wv = wts[(size_t)token * 8 + lane]; }
        f32x4 ff[4];
#pragma unroll
        for (int i = 0; i < 4; ++i) ff[i] = (f32x4){0.f, 0.f, 0.f, 0.f};
        y_acc(ff, Y + ((size_t)NTr * 256 + token) * D, lane, 1.0f / 16.0f);
#pragma unroll
        for (int k = 0; k < 8; ++k) { const unsigned m = (unsigned)__builtin_amdgcn_readlane((int)tm, k); const float w = __uint_as_float((unsigned)__builtin_amdgcn_readlane((int)__float_as_uint(wv), k));
            const int e = (int)(m >> 16), pos = (int)(m & 0xFFFFu);
            y_acc(ff, Y + ((size_t)pre[e] * 256 + pos) * D, lane, w * (1.0f / 16.0f)); }
        float ss = 0.f;
#pragma unroll
        for (int i = 0; i < 4; ++i) ss += (ff[i].x * ff[i].x + ff[i].y * ff[i].y) + (ff[i].z * ff[i].z + ff[i].w * ff[i].w);
        const float rstd = rsqrtf(wave_sum(ss) * (1.f / D) + EPS);
#pragma unroll
        for (int i = 0; i < 4; ++i) { const int c = 16 * lane + 4 * i;
            const f32x4 x1 = *(const GAS f32x4*)(F.out + (size_t)token * D + c), gt = *(const f32x4*)(mod + b * 6144 + 5120 + c), gp = *(const f32x4*)(in[I_GPOSTFFN] + c);
            if (live) *(GAS f32x4*)(F.out + (size_t)token * D + c) = x1 + gt * (ff[i] * rstd) * gp; }
    }
}
}
namespace mk {
#ifndef MK_NPHASES_DONE
#define MK_NPHASES_DONE 3
#endif
constexpr int PH_P0A = 0, PH_P0B = 1, PH_P1 = 2, PH_P2 = 3, PH_P3 = 4, PH_P4 = 5, PH_P5 = 6, PH_P6 = 7, PH_P7 = 8, N_PHASES = 9;

__global__ void __launch_bounds__(NTHR, 2) mk_fwd(Args a) {
    extern __shared__ __attribute__((aligned(16))) unsigned char lds_[];
    Frame F;
    F.lds = (LAS unsigned char*)lds_; F.ws = a.ws; F.ctl = (unsigned*)(a.ws + WS_CTL); F.in = a.in; F.out = a.out;
    F.tid = threadIdx.x; F.lane = F.tid & 63; F.wave = __builtin_amdgcn_readfirstlane(F.tid >> 6);
    F.G = gridDim.x; { const int bx = blockIdx.x; F.vcu = (F.G % 8 == 0) ? (bx % 8) * (F.G / 8) + bx / 8 : bx; }
    for (int u = F.tid; u < 128; u += NTHR) ((LAS unsigned*)(F.lds + LDSCTL_OFF))[u] = 0u;
    __syncthreads();
    const int lo = a.ph_lo, hi = a.ph_hi;
    const bool multi = (hi - lo) > 1;
    XcdBarrier bar; bar.bar = F.ctl + CW_BAR; bar.x = 0; bar.st = nullptr;
    if (multi) bar = xcd_barrier_post(F.ctl + CW_BAR, (volatile LAS unsigned*)(F.lds + MISC_OFF) + 8);
#define IN(k) (lo <= (k) && (k) < hi)
#define SEAM(k) do { if (IN(k) && IN((k) + 1)) xcd_barrier(bar); } while (0)
#ifndef MK_DBL
#define MK_DBL 0
#endif
#define DBL(k) (((MK_DBL) >> (k)) & 1)
#define REFRESH() do { int l_; asm volatile("v_mbcnt_lo_u32_b32 %0, -1, 0\n\tv_mbcnt_hi_u32_b32 %0, -1, %0" : "=v"(l_)); F.lane = l_; F.tid = F.wave * 64 + l_; } while (0)
#define RUN(k, call, drycall) do { if (IN(k)) { if (DBL(k)) { REFRESH(); drycall; if (multi) xcd_barrier(bar); } REFRESH(); call; } SEAM(k); } while (0)
    RUN(PH_P0A, p0a(F), p0a(F));
    RUN(PH_P0B, p0b(F), p0b(F));
    RUN(PH_P1, p1(F), p1(F));
#if MK_NPHASES_DONE > 3
    RUN(PH_P2, p2(F), p2(F));
#endif
#if MK_NPHASES_DONE > 4
    RUN(PH_P3, p3(F), p3(F));
#endif
#if MK_NPHASES_DONE > 5
    RUN(PH_P4, p4<false>(F), p4<true>(F));
#endif
#if MK_NPHASES_DONE > 6
    RUN(PH_P5, p5(F), p5(F));
#endif
#if MK_NPHASES_DONE > 7
    RUN(PH_P6, p6(F), p6(F));
    if (IN(PH_P7)) { if (DBL(PH_P7)) { REFRESH(); p7<true>(F); if (multi) xcd_barrier(bar); } REFRESH(); p7<false>(F); }
#endif
#undef RUN
#undef REFRESH
#undef DBL
#undef IN
#undef SEAM
}

static int g_grid = 0;
static bool setup_once() {
    if (g_grid == 0) {
        int dev = 0, cus = 0;
        if (hipGetDevice(&dev) != hipSuccess || hipDeviceGetAttribute(&cus, hipDeviceAttributeMultiprocessorCount, dev) != hipSuccess) { g_grid = -1; return false; }
        if (hipFuncSetAttribute((const void*)mk_fwd, hipFuncAttributeMaxDynamicSharedMemorySize, LDS_BYTES) != hipSuccess) { g_grid = -1; return false; }
        (void)hipGetLastError();
        g_grid = cus;
    }
    return g_grid > 0;
}
static void launch_phases(void* const* d_in, void* d_out, void* d_ws, hipStream_t stream, int lo, int hi) {
    Args a{};
    for (int i = 0; i < N_IN; ++i) a.in[i] = (const float*)d_in[i];
    a.out = (float*)d_out; a.ws = (unsigned char*)d_ws; a.ph_lo = lo; a.ph_hi = hi;
    hipLaunchKernelGGL(mk_fwd, dim3(g_grid), dim3(NTHR), LDS_BYTES, stream, a);
}
}
extern "C" void kernel_launch(void* const* d_in, const int* in_sizes, int n_in, void* d_out, int out_size, void* d_ws, size_t ws_size, hipStream_t stream) {
    if (!mk::setup_once()) return;
    if (ws_size < mk::WS_END) return;
    hipMemsetAsync(d_ws, 0, mk::CTL_ZERO_BYTES, stream);
    mk::launch_phases(d_in, d_out, d_ws, stream, 0, mk::N_PHASES);
}
```

```cpp
#include <hip/hip_runtime.h>
#include <cstdio>
#include <cstdint>
#include <cmath>
#include <hip/hip_bf16.h>
#define MK_NPHASES_DONE 9
namespace pg8 {
#define PG8_LAS __attribute__((address_space(3)))
typedef unsigned short bf16_t;
typedef short bf16x8 __attribute__((ext_vector_type(8)));
typedef float f32x4 __attribute__((ext_vector_type(4)));
typedef unsigned u32x4 __attribute__((ext_vector_type(4)));
typedef unsigned u32x2 __attribute__((ext_vector_type(2)));
typedef int i32x4 __attribute__((ext_vector_type(4)));
typedef int i32x8 __attribute__((ext_vector_type(8)));
constexpr int BM = 256, BK = 64, HALF = 128, HTB = HALF * BK * 2, STAGE_BYTES = 8 * HTB;

__host__ __device__ __forceinline__ int lds_byte(int r, int c) { const int st = (r >> 4) * 2 + (c >> 5), rr = r & 15, cc = c & 31, ob = rr * 64 + cc * 2; return st * 1024 + (ob ^ (((ob >> 9) & 1) << 5)); }
__host__ __device__ __forceinline__ void stage_rc(int b, int& R, int& C) { const int st = b / 1024, sb = b % 1024, swz = sb ^ (((sb >> 9) & 1) << 5); R = (st >> 1) * 16 + swz / 64; C = (st & 1) * 32 + (swz % 64) / 2; }
__host__ __device__ __forceinline__ int perm32(int rho) { const int n = rho >> 4, i = rho & 15; return 8 * (i >> 2) + 4 * n + (i & 3); }

struct Unit { const char* A; const char* B; int tab; int orow; int ocol; int aux; };
struct UnitRec { unsigned long long A, B; int tab, orow, ocol, aux; };
struct ListSched {
    const PG8_LAS UnitRec* list; int n;
    __device__ __forceinline__ bool next(int i, Unit& u) const {
        if (i >= n) return false;
        const PG8_LAS UnitRec* r = list + i;
        const unsigned long long a = r->A, b = r->B;
        const unsigned alo = __builtin_amdgcn_readfirstlane((unsigned)a), ahi = __builtin_amdgcn_readfirstlane((unsigned)(a >> 32));
        const unsigned blo = __builtin_amdgcn_readfirstlane((unsigned)b), bhi = __builtin_amdgcn_readfirstlane((unsigned)(b >> 32));
        u.A = (const char*)(((unsigned long long)ahi << 32) | alo); u.B = (const char*)(((unsigned long long)bhi << 32) | blo);
        u.tab = __builtin_amdgcn_readfirstlane(r->tab); u.orow = __builtin_amdgcn_readfirstlane(r->orow); u.ocol = __builtin_amdgcn_readfirstlane(r->ocol); u.aux = __builtin_amdgcn_readfirstlane(r->aux);
        return true;
    }
};
struct NoHook { __device__ __forceinline__ void at(int, f32x4 (&)[2][2][4][2], int, int, int) const {} };

__device__ __forceinline__ unsigned cvt_pk_bf16(float lo, float hi) { unsigned r; asm volatile("v_cvt_pk_bf16_f32 %0, %1, %2" : "=v"(r) : "v"(lo), "v"(hi)); return r; }

struct EpiBf16 {
    static constexpr bool PERM = true, STAGED = false;
    bf16_t* O; int ldc;
    __device__ __forceinline__ void operator()(const f32x4 (&acc)[2][2][4][2], const Unit& u, int wr, int wc, int fr, int fq) const {
        const int row0 = u.orow + wr * 64 + fr, col0 = u.ocol + wc * 32 + 8 * fq;
#pragma unroll
        for (int ai = 0; ai < 2; ++ai)
#pragma unroll
            for (int m = 0; m < 4; ++m) { bf16_t* rowp = O + (size_t)(row0 + ai * HALF + m * 16) * ldc + col0;
#pragma unroll
                for (int bj = 0; bj < 2; ++bj) { const f32x4 v0 = acc[ai][bj][m][0], v1 = acc[ai][bj][m][1];
                    u32x4 w; w.x = cvt_pk_bf16(v0[0], v0[1]); w.y = cvt_pk_bf16(v0[2], v0[3]); w.z = cvt_pk_bf16(v1[0], v1[1]); w.w = cvt_pk_bf16(v1[2], v1[3]);
                    *(u32x4*)(rowp + bj * HALF) = w; } }
    }
};
struct EpiRowScaleBf16 {
    static constexpr bool PERM = true, STAGED = false;
    bf16_t* O; int ldc; const PG8_LAS float* rs;
    __device__ __forceinline__ void operator()(const f32x4 (&acc)[2][2][4][2], const Unit& u, int wr, int wc, int fr, int fq) const {
        const int row0 = u.orow + wr * 64 + fr, col0 = u.ocol + wc * 32 + 8 * fq;
#pragma unroll
        for (int ai = 0; ai < 2; ++ai)
#pragma unroll
            for (int m = 0; m < 4; ++m) { bf16_t* rowp = O + (size_t)(row0 + ai * HALF + m * 16) * ldc + col0; const float s = rs[ai * HALF + wr * 64 + m * 16 + fr];
#pragma unroll
                for (int bj = 0; bj < 2; ++bj) { const f32x4 v0 = acc[ai][bj][m][0] * s, v1 = acc[ai][bj][m][1] * s;
                    u32x4 w; w.x = cvt_pk_bf16(v0[0], v0[1]); w.y = cvt_pk_bf16(v0[2], v0[3]); w.z = cvt_pk_bf16(v1[0], v1[1]); w.w = cvt_pk_bf16(v1[2], v1[3]);
                    *(u32x4*)(rowp + bj * HALF) = w; } }
    }
};
constexpr int STG_OFF = 143360, STG_HALF = 32 * 272;
struct EpiFp8 {
    static constexpr bool PERM = true, STAGED = true;
    unsigned char* O; int ldc; bool live;
    __device__ __forceinline__ void staged(const f32x4 (&acc)[2][2][4][2], const Unit& u, int wr, int wc, int lane, PG8_LAS unsigned char* lds) const {
        const int fr = lane & 15, fq = lane >> 4;
        PG8_LAS unsigned char* stg = lds + STG_OFF + wr * STG_HALF;
#pragma unroll
        for (int ai = 0; ai < 2; ++ai)
#pragma unroll
            for (int mp = 0; mp < 2; ++mp) {
#pragma unroll
                for (int mm = 0; mm < 2; ++mm)
#pragma unroll
                    for (int bj = 0; bj < 2; ++bj) { const int m = 2 * mp + mm; f32x4 v0 = acc[ai][bj][m][0] * 16.0f, v1 = acc[ai][bj][m][1] * 16.0f;
#pragma unroll
                        for (int j = 0; j < 4; ++j) { v0[j] = __builtin_amdgcn_fmed3f(v0[j], -448.f, 448.f); v1[j] = __builtin_amdgcn_fmed3f(v1[j], -448.f, 448.f); }
                        int p0 = __builtin_amdgcn_cvt_pk_fp8_f32(v0[0], v0[1], 0, false); p0 = __builtin_amdgcn_cvt_pk_fp8_f32(v0[2], v0[3], p0, true);
                        int p1 = __builtin_amdgcn_cvt_pk_fp8_f32(v1[0], v1[1], 0, false); p1 = __builtin_amdgcn_cvt_pk_fp8_f32(v1[2], v1[3], p1, true);
                        u32x2 w; w.x = (unsigned)p0; w.y = (unsigned)p1; *(PG8_LAS u32x2*)(stg + (mm * 16 + fr) * 272 + bj * 128 + wc * 32 + 8 * fq) = w; }
                asm volatile("s_waitcnt lgkmcnt(0)\n\ts_barrier" ::: "memory");
#pragma unroll
                for (int i = 0; i < 2; ++i) { const int p = i * 256 + wc * 64 + lane, q = p >> 4, c16 = p & 15;
                    const u32x4 v = *(const PG8_LAS u32x4*)(stg + q * 272 + c16 * 16);
                    const int grow = u.orow + 128 * ai + 64 * wr + 16 * (2 * mp + (q >> 4)) + (q & 15);
                    if (live) *(u32x4*)(O + (size_t)grow * ldc + u.ocol + c16 * 16) = v; }
                asm volatile("s_waitcnt lgkmcnt(0)\n\ts_barrier" ::: "memory");
            }
    }
};
__device__ __forceinline__ float silu_mul(float g, float u) { return g * u * __builtin_amdgcn_rcpf(1.0f + __builtin_amdgcn_exp2f(-1.4426950408889634f * g)); }
struct EpiSwiglu {
    static constexpr bool PERM = true, STAGED = false;
    bf16_t* O; int ldc; float s;
    __device__ __forceinline__ void operator()(const f32x4 (&acc)[2][2][4][2], const Unit& u, int wr, int wc, int fr, int fq) const {
        const int row0 = u.orow + wr * 64 + fr, col0 = u.ocol + wc * 32 + 8 * fq;
#pragma unroll
        for (int ai = 0; ai < 2; ++ai)
#pragma unroll
            for (int m = 0; m < 4; ++m) { bf16_t* rowp = O + (size_t)(row0 + ai * HALF + m * 16) * ldc + col0;
                const f32x4 g0 = acc[ai][0][m][0] * s, g1 = acc[ai][0][m][1] * s, u0 = acc[ai][1][m][0] * s, u1 = acc[ai][1][m][1] * s;
                u32x4 w; w.x = cvt_pk_bf16(silu_mul(g0[0], u0[0]), silu_mul(g0[1], u0[1])); w.y = cvt_pk_bf16(silu_mul(g0[2], u0[2]), silu_mul(g0[3], u0[3]));
                w.z = cvt_pk_bf16(silu_mul(g1[0], u1[0]), silu_mul(g1[1], u1[1])); w.w = cvt_pk_bf16(silu_mul(g1[2], u1[2]), silu_mul(g1[3], u1[3]));
                *(u32x4*)rowp = w; }
    }
};

template <class Epi, class Sched, bool GATHER, class Hook, bool FP8 = false>
__device__ __forceinline__ void gemm_phase(PG8_LAS unsigned char* lds, const int K, const Sched& S, const Epi& E, const Hook& H, const int wid  ) {
    int lane; asm volatile("v_mbcnt_lo_u32_b32 %0, -1, 0\n\tv_mbcnt_hi_u32_b32 %0, -1, %0" : "=v"(lane));
    const int tid = wid * 64 + lane, wr = wid >> 2, wc = wid & 3, fr = lane & 15, fq = lane >> 4;
    const int nt = K / BK;
    unsigned voffB[2];
#pragma unroll
    for (int i = 0; i < 2; ++i) { int R, C; stage_rc(tid * 16 + i * 8192, R, C); const int Rb = Epi::PERM ? ((R & ~31) + perm32(R & 31)) : R; voffB[i] = (unsigned)(Rb * K + C) * 2u; }
    const size_t kstep = (size_t)(BK * 2);
    const size_t hstep = (size_t)HALF * K * 2;
    const unsigned ldsw = (unsigned)wid * 1024u;
    const int aoff = lds_byte(wr * 64 + fr, fq * 8), boff = lds_byte(wc * 32 + fr, fq * 8);
    unsigned offC[2][2];
#define PG8_LOADOFF(dst, u) do { _Pragma("unroll") for (int _i = 0; _i < 2; ++_i) { int _R, _C; stage_rc(tid * 16 + _i * 8192, _R, _C); _Pragma("unroll") for (int _h = 0; _h < 2; ++_h) { \
        if constexpr (GATHER) { const unsigned _row = *(const PG8_LAS unsigned*)(lds + (u).tab + 4 * (_h * HALF + _R)); dst[_h][_i] = _row * (unsigned)(K * 2) + (unsigned)(_C * 2); } \
        else dst[_h][_i] = (unsigned)((_h * HALF + _R) * K + _C) * 2u; } } } while (0)
#define PG8_SA(b, h) (((b) * 2 + (h)) * HTB)
#define PG8_SB(b, h) ((4 + (b) * 2 + (h)) * HTB)
#define PG8_STAGE(bufoff, gbase, voff) do { _Pragma("unroll") for (int _i = 0; _i < 2; ++_i) \
        __builtin_amdgcn_global_load_lds((const unsigned*)((const char*)(gbase) + (voff)[_i]), (PG8_LAS unsigned*)(lds + (bufoff) + ldsw + _i * 8192), 16, 0, 0); } while (0)
#define PG8_LDA(dst, b, h) do { _Pragma("unroll") for (int m = 0; m < 4; ++m) _Pragma("unroll") for (int k = 0; k < 2; ++k) dst[m][k] = *(const PG8_LAS bf16x8*)(lds + PG8_SA(b, h) + aoff + m * 2048 + k * 1024); } while (0)
#define PG8_LDB(dst, b, h) do { _Pragma("unroll") for (int n = 0; n < 2; ++n) _Pragma("unroll") for (int k = 0; k < 2; ++k) dst[n][k] = *(const PG8_LAS bf16x8*)(lds + PG8_SB(b, h) + boff + n * 2048 + k * 1024); } while (0)
#define PG8_CAT(x, y) __builtin_shufflevector(__builtin_bit_cast(i32x4, x), __builtin_bit_cast(i32x4, y), 0, 1, 2, 3, 4, 5, 6, 7)
#define PG8_MMA(ai, bj, At, Bt) do { __builtin_amdgcn_s_setprio(1); if constexpr (FP8) { _Pragma("unroll") for (int m = 0; m < 4; ++m) _Pragma("unroll") for (int n = 0; n < 2; ++n) \
        acc[ai][bj][m][n] = __builtin_amdgcn_mfma_scale_f32_16x16x128_f8f6f4(PG8_CAT(Bt[n][0], Bt[n][1]), PG8_CAT(At[m][0], At[m][1]), acc[ai][bj][m][n], 0, 0, 0, 0x7F7F7F7F, 0, 0x7F7F7F7F); } else { \
        _Pragma("unroll") for (int m = 0; m < 4; ++m) _Pragma("unroll") for (int n = 0; n < 2; ++n) _Pragma("unroll") for (int k = 0; k < 2; ++k) \
        acc[ai][bj][m][n] = __builtin_amdgcn_mfma_f32_16x16x32_bf16(Bt[n][k], At[m][k], acc[ai][bj][m][n], 0, 0, 0); } __builtin_amdgcn_s_setprio(0); } while (0)
#define PG8_WAIT_V(n) asm volatile("s_waitcnt vmcnt(" #n ")" ::: "memory")
#define PG8_WAIT_L(n) asm volatile("s_waitcnt lgkmcnt(" #n ")" ::: "memory")
#define PG8_BAR __builtin_amdgcn_s_barrier()
#define PG8_SCHED __builtin_amdgcn_sched_barrier(0)
    Unit cur, nxt; int ui = 0;
    if (!S.next(0, cur)) return;
    f32x4 acc[2][2][4][2];
#pragma unroll
    for (int a = 0; a < 2; ++a)
#pragma unroll
        for (int b = 0; b < 2; ++b)
#pragma unroll
            for (int m = 0; m < 4; ++m)
#pragma unroll
                for (int n = 0; n < 2; ++n) acc[a][b][m][n] = (f32x4){0.f, 0.f, 0.f, 0.f};
    bf16x8 At[4][2], B0[2][2], B1[2][2];
    const char* cA = cur.A; const char* cB = cur.B;
    PG8_LOADOFF(offC, cur);
    PG8_STAGE(PG8_SB(0, 0), cB, voffB); PG8_STAGE(PG8_SB(0, 1), cB + hstep, voffB); PG8_STAGE(PG8_SA(0, 0), cA, offC[0]); PG8_STAGE(PG8_SA(0, 1), cA, offC[1]);
    if (wr == 1) PG8_BAR;
    PG8_WAIT_V(2); PG8_BAR;
    PG8_STAGE(PG8_SB(1, 0), cB + kstep, voffB); PG8_STAGE(PG8_SA(1, 0), cA + kstep, offC[0]); PG8_STAGE(PG8_SB(1, 1), cB + hstep + kstep, voffB);
    PG8_WAIT_V(6); PG8_BAR;
    for (;;) {
        const bool has_next = S.next(ui + 1, nxt);
        const char* nA = has_next ? nxt.A : cA; const char* nB = has_next ? nxt.B : cB;
        for (int t = 0; t < nt; t += 2) {
            const bool last = (t == nt - 2);
            H.at(t, acc, wr, fr, lane);
            const char* a1 = cA + (size_t)(t + 1) * kstep;
            const char* a2 = last ? nA : cA + (size_t)(t + 2) * kstep; const char* b2 = last ? nB : cB + (size_t)(t + 2) * kstep;
            const char* a3 = a2 + kstep; const char* b3 = b2 + kstep;
            PG8_LDB(B0, 0, 0); PG8_LDB(B1, 0, 1); PG8_SCHED; PG8_LDA(At, 0, 0); PG8_STAGE(PG8_SA(1, 1), a1, offC[1]);
            if constexpr (GATHER) { if (last && has_next) { PG8_LOADOFF(offC, nxt); } }
            PG8_WAIT_V(8); PG8_WAIT_L(0); PG8_BAR; PG8_MMA(0, 0, At, B0); PG8_MMA(0, 1, At, B1); PG8_BAR; PG8_SCHED;
            PG8_LDA(At, 0, 1); PG8_STAGE(PG8_SB(0, 0), b2, voffB); PG8_STAGE(PG8_SB(0, 1), b2 + hstep, voffB); PG8_STAGE(PG8_SA(0, 0), a2, offC[0]);
            PG8_WAIT_V(8); PG8_WAIT_L(0); PG8_BAR; PG8_MMA(1, 0, At, B0); PG8_MMA(1, 1, At, B1); PG8_BAR; PG8_SCHED;
            PG8_LDB(B0, 1, 0); PG8_LDB(B1, 1, 1); PG8_SCHED; PG8_LDA(At, 1, 0); PG8_STAGE(PG8_SA(0, 1), a2, offC[1]);
            PG8_WAIT_V(8); PG8_WAIT_L(0); PG8_BAR; PG8_MMA(0, 0, At, B0); PG8_MMA(0, 1, At, B1); PG8_BAR; PG8_SCHED;
            PG8_LDA(At, 1, 1); PG8_STAGE(PG8_SB(1, 0), b3, voffB); PG8_STAGE(PG8_SB(1, 1), b3 + hstep, voffB); PG8_STAGE(PG8_SA(1, 0), a3, offC[0]);
            PG8_WAIT_V(8); PG8_WAIT_L(0); PG8_BAR; PG8_MMA(1, 0, At, B0); PG8_MMA(1, 1, At, B1); PG8_BAR; PG8_SCHED;
        }
        if (wr == 0) PG8_BAR;
        { int l2; asm volatile("v_mbcnt_lo_u32_b32 %0, -1, 0\n\tv_mbcnt_hi_u32_b32 %0, -1, %0" : "=v"(l2)); if constexpr (Epi::STAGED) E.staged(acc, cur, wr, wc, l2, lds); else E(acc, cur, wr, wc, l2 & 15, l2 >> 4); }
        if (!has_next) break;
#pragma unroll
        for (int a = 0; a < 2; ++a)
#pragma unroll
            for (int b = 0; b < 2; ++b)
#pragma unroll
                for (int m = 0; m < 4; ++m)
#pragma unroll
                    for (int n = 0; n < 2; ++n) acc[a][b][m][n] = (f32x4){0.f, 0.f, 0.f, 0.f};
        cur = nxt; cA = nA; cB = nB; ++ui;
        if (wr == 1) PG8_BAR;
    }
    PG8_WAIT_V(0);
    PG8_BAR;
#undef PG8_LOADOFF
#undef PG8_SA
#undef PG8_SB
#undef PG8_STAGE
#undef PG8_LDA
#undef PG8_LDB
#undef PG8_MMA
#undef PG8_CAT
#undef PG8_WAIT_V
#undef PG8_WAIT_L
#undef PG8_BAR
#undef PG8_SCHED
}
}
namespace mk {
#define GAS __attribute__((address_space(1)))
#define LAS __attribute__((address_space(3)))
typedef unsigned short bf16;
typedef unsigned v4u __attribute__((ext_vector_type(4)));
typedef unsigned v2u __attribute__((ext_vector_type(2)));
typedef float f32x4 __attribute__((ext_vector_type(4)));
typedef short bf16x8 __attribute__((ext_vector_type(8)));

constexpr int T = 16384, D = 1024, S = 2048, NB = 8, NH = 8, HD = 64, NE = 64, DIN = 2056;
constexpr int NTHR = 512, NWAVES = 8;
constexpr float EPS = 1e-6f;
constexpr float LOG2E = 1.4426950408889634f;
constexpr float QSCALE = 0.125f * LOG2E;
constexpr int NLIST = 64, LIST_CAP = 16384;

constexpr size_t MiB = 1u << 20;
constexpr size_t WS_CTL = 0, CTL_ZERO_BYTES = 1 * MiB;
constexpr size_t WS_SMALL = 1 * MiB;
constexpr size_t WS_MOD = WS_SMALL, WS_WF = WS_SMALL + 256 * 1024, WS_LOGF = WS_SMALL + 512 * 1024, WS_SSQP = WS_SMALL + 1 * MiB, WS_SSQA = WS_SSQP + 512 * 1024,
                 WS_TOKMAP = WS_SSQA + 512 * 1024, WS_WTS = WS_TOKMAP + 512 * 1024, WS_LISTS = WS_WTS + 512 * 1024;
constexpr size_t WS_WD = 8 * MiB, WS_WSD = 40 * MiB;
constexpr size_t WS_H = 40 * MiB + 512 * 1024;
constexpr size_t WS_HB = 41 * MiB, WS_PROJ = 73 * MiB, WS_YCAT = 41 * MiB, WS_MIXED = 73 * MiB;
constexpr size_t WS_WIN = 190 * MiB, WS_WOUT = 194 * MiB, WS_WSGU = 196 * MiB, WS_WPOOL = 197 * MiB, WS_WRHI = WS_WPOOL + 128 * 1024, WS_WRLO = WS_WRHI + 128 * 1024;
constexpr size_t WS_H2 = 199 * MiB  , WS_WGU = 231 * MiB  , WS_END = 295 * MiB;
constexpr float H2_SCALE = 8.0f, WGU_SCALE = 64.0f;
static_assert(WS_LISTS + (size_t)NLIST * LIST_CAP * 4 <= WS_WD && WS_WRLO + 128 * 1024 <= WS_H2, "ws map");
constexpr int CW_TMO = 0, CW_BAR = 4096, CW_CNT = 8192;

constexpr int RING_BYTES = 131072, LDSCTL_OFF = RING_BYTES, MISC_OFF = LDSCTL_OFF, ULIST_OFF = LDSCTL_OFF + 512, PRE_OFF = ULIST_OFF + 512, TAB_OFF = PRE_OFF + 528,
              RS_OFF = TAB_OFF + 8192, LDS_BYTES = 163840;
constexpr int MAXU = 8;
static_assert(RS_OFF + 2048 <= pg8::STG_OFF && pg8::STG_OFF + 2 * pg8::STG_HALF <= LDS_BYTES && (TAB_OFF % 16) == 0, "LDS map");

#define RLX_AGENT __ATOMIC_RELAXED, __HIP_MEMORY_SCOPE_AGENT
#define LDS_WAIT() asm volatile("s_waitcnt lgkmcnt(0)" ::: "memory")
#define VM_WAIT() asm volatile("s_waitcnt vmcnt(0)" ::: "memory")
__device__ __forceinline__ unsigned f2bf(float f) { unsigned u = __builtin_bit_cast(unsigned, f); return (u + 0x7fffu + ((u >> 16) & 1u)) >> 16; }
__device__ __forceinline__ unsigned pk2(float lo, float hi) { return f2bf(lo) | (f2bf(hi) << 16); }
__device__ __forceinline__ float bf2f(unsigned h) { return __builtin_bit_cast(float, h << 16); }
__device__ __forceinline__ float wave_sum(float v) {
#pragma unroll
    for (int o = 1; o < 64; o <<= 1) v += __shfl_xor(v, o);
    return v;
}

#define XB_TMO      128
#define XB_XCNT(j)  (256  + 64 * (j))
#define XB_XSUB(j)  (1280 + 64 * (j))
#define XB_XGEN(j)  (2304 + 64 * (j))
#define XB_TOP      3328
#define XB_TOPGEN   3392
#define XCD_BAR_WORDS 3456
#define XB_SPIN_CAP (1u << 18)
__device__ __forceinline__ unsigned xb_ld(unsigned* p)              { return __hip_atomic_load(p, __ATOMIC_RELAXED, __HIP_MEMORY_SCOPE_AGENT); }
__device__ __forceinline__ unsigned xb_add(unsigned* p, unsigned v) { return __hip_atomic_fetch_add(p, v, __ATOMIC_RELAXED, __HIP_MEMORY_SCOPE_AGENT); }
__device__ __forceinline__ unsigned xb_xcc_id() { return (unsigned)__builtin_amdgcn_s_getreg((3 << 11) | 20) & 0xFu; }
#define XB_SPIN(cond, bar) do { unsigned _sp = 0; while (cond) { __builtin_amdgcn_s_sleep(1); \
    if ((++_sp & 255u) == 0u) { if (xb_ld(&(bar)[XB_TMO])) break; if (_sp > XB_SPIN_CAP) { atomicAdd(&(bar)[XB_TMO], 1u); break; } } } } while (0)
struct XcdBarrier { unsigned* bar; unsigned x; volatile LAS unsigned* st; };
__device__ __forceinline__ XcdBarrier xcd_barrier_post(unsigned* bar, volatile LAS unsigned* st) {
    XcdBarrier b; b.bar = bar; b.x = xb_xcc_id(); b.st = st;
    if (threadIdx.x == 0) (void)xb_add(&bar[XB_XCNT(b.x)], 1u);
    return b;
}
__device__ __forceinline__ void xcd_barrier_complete(unsigned* bar, unsigned x, unsigned& nloc, unsigned& nx) {
    const unsigned G = gridDim.x * gridDim.y * gridDim.z;
    unsigned sum, cnt, mine, sp = 0u;
    for (;;) {
        sum = 0u; cnt = 0u; mine = 0u;
#pragma unroll
        for (unsigned j = 0; j < 16; ++j) { const unsigned c = xb_ld(&bar[XB_XCNT(j)]); sum += c; cnt += (c > 0u) ? 1u : 0u; mine = (j == x) ? c : mine; }
        if (sum == G) break;
        __builtin_amdgcn_s_sleep(1);
        if ((++sp & 255u) == 0u) { if (xb_ld(&bar[XB_TMO])) break; if (sp > XB_SPIN_CAP) { atomicAdd(&bar[XB_TMO], 1u); break; } }
    }
    nloc = mine > 0u ? mine : 1u; nx = cnt > 0u ? cnt : 1u;
}
__device__ __forceinline__ void xcd_barrier(const XcdBarrier& b) {
    asm volatile("s_waitcnt vmcnt(0)" ::: "memory");
    __syncthreads();
    if (threadIdx.x == 0) {
        unsigned* bar = b.bar;
        __builtin_amdgcn_s_waitcnt(0);
        unsigned nloc = b.st[0], nx = b.st[1];
        if (nloc == 0u) { xcd_barrier_complete(bar, b.x, nloc, nx); b.st[0] = nloc; b.st[1] = nx; }
        const unsigned old = xb_add(&bar[XB_XSUB(b.x)], 1u);
        const unsigned gen = old / nloc;
        if (old + 1u == (gen + 1u) * nloc) {
            __builtin_amdgcn_fence(__ATOMIC_RELEASE, "agent");
            asm volatile("s_waitcnt vmcnt(0)" ::: "memory");
            const unsigned og = xb_add(&bar[XB_TOP], 1u);
            const unsigned tg = og / nx;
            if (og + 1u == (tg + 1u) * nx) xb_add(&bar[XB_TOPGEN], 1u);
            else XB_SPIN(xb_ld(&bar[XB_TOPGEN]) == tg, bar);
            __builtin_amdgcn_fence(__ATOMIC_ACQUIRE, "agent");
            xb_add(&bar[XB_XGEN(b.x)], 1u);
            asm volatile("s_waitcnt vmcnt(0)" ::: "memory");
        } else {
            XB_SPIN(xb_ld(&bar[XB_XGEN(b.x)]) == gen, bar);
            __builtin_amdgcn_fence(__ATOMIC_ACQUIRE, "agent");
            asm volatile("s_waitcnt vmcnt(0)" ::: "memory");
        }
    }
    __syncthreads();
}

enum { I_X = 0, I_C, I_WADA, I_BADA, I_GPREMIX, I_GPOSTMIX, I_GPREFFN, I_GPOSTFFN, I_WIN, I_BFORGET, I_WPOOL, I_POOLSCALE, I_GPOOLOUT, I_GATTNOUT, I_WOUT,
       I_WROUTER, I_RBIAS, I_WGATE, I_WUP, I_WDOWN, I_WSGATE, I_WSUP, I_WSDOWN, N_IN };

struct Args { const float* in[N_IN]; float* out; unsigned char* ws; int ph_lo, ph_hi; };

struct Frame {
    LAS unsigned char* lds; unsigned* ctl; unsigned char* ws; const float* const* in; float* out;
    int tid, lane, wave, vcu, G;
};
}
namespace mk {
template <int MODE>
__device__ __forceinline__ void tr_item(const float* W, int ldn, int k0, int n0, bf16* WT, bf16* WT2, int Kd, int rowbase, const float* sc, float cmul, LAS float* scr, int lane) {
#pragma unroll 8
    for (int i = 0; i < 32; ++i) { const int kk = 2 * i + (lane >> 5); scr[kk * 33 + (lane & 31)] = W[(size_t)(k0 + kk) * ldn + n0 + (lane & 31)]; }
    LDS_WAIT(); asm volatile("" ::: "memory");
    const int c = lane & 7;
#pragma unroll
    for (int j = 0; j < 4; ++j) { const int n = (lane >> 3) + 8 * j; const LAS float* s = scr + (8 * c) * 33 + n;
        float v[8];
#pragma unroll
        for (int i = 0; i < 8; ++i) { v[i] = s[i * 33] * cmul; if (MODE == 1) v[i] *= sc[k0 + 8 * c + i]; if (MODE == 2) v[i] *= sc[n0 + n]; }
        if (MODE == 4) { int p0 = __builtin_amdgcn_cvt_pk_fp8_f32(v[0], v[1], 0, false); p0 = __builtin_amdgcn_cvt_pk_fp8_f32(v[2], v[3], p0, true);
            int p1 = __builtin_amdgcn_cvt_pk_fp8_f32(v[4], v[5], 0, false); p1 = __builtin_amdgcn_cvt_pk_fp8_f32(v[6], v[7], p1, true);
            v2u o8; o8.x = (unsigned)p0; o8.y = (unsigned)p1; *(GAS v2u*)((unsigned char*)WT + (size_t)(rowbase + n) * Kd + k0 + 8 * c) = o8; continue; }
        v4u o; o.x = pk2(v[0], v[1]); o.y = pk2(v[2], v[3]); o.z = pk2(v[4], v[5]); o.w = pk2(v[6], v[7]);
        *(GAS v4u*)(WT + (size_t)(rowbase + n) * Kd + k0 + 8 * c) = o;
        if (MODE == 3) {
#pragma unroll
            for (int i = 0; i < 8; ++i) v[i] = v[i] - bf2f(f2bf(v[i]));
            v4u p; p.x = pk2(v[0], v[1]); p.y = pk2(v[2], v[3]); p.z = pk2(v[4], v[5]); p.w = pk2(v[6], v[7]);
            *(GAS v4u*)(WT2 + (size_t)(rowbase + n) * Kd + k0 + 8 * c) = p; } }
    LDS_WAIT(); asm volatile("" ::: "memory");
}

__device__ __forceinline__ void p0a(Frame& F) {
    const float* const* in = F.in; unsigned char* ws = F.ws;
    if (F.vcu < 192) {
        LAS float* red = (LAS float*)F.lds;
        const int col0 = 32 * F.vcu, kk = F.tid >> 3, c4 = F.tid & 7;
        const float* wa = in[I_WADA]; const float* cc = in[I_C];
        f32x4 acc[8];
#pragma unroll
        for (int b = 0; b < 8; ++b) acc[b] = (f32x4){0.f, 0.f, 0.f, 0.f};
#pragma unroll 4
        for (int i = 0; i < 16; ++i) { const int k = kk + 64 * i; const f32x4 w = *(const f32x4*)(wa + (size_t)k * 6144 + col0 + 4 * c4);
#pragma unroll
            for (int b = 0; b < 8; ++b) acc[b] += w * cc[b * D + k]; }
#pragma unroll
        for (int b = 0; b < 8; ++b) *(LAS f32x4*)(red + kk * 256 + b * 32 + 4 * c4) = acc[b];
        __syncthreads();
        if (F.tid < 256) { float s = 0.f;
#pragma unroll 8
            for (int k2 = 0; k2 < 64; ++k2) s += red[k2 * 256 + F.tid];
            const int b = F.tid >> 5, c = F.tid & 31; ((float*)(ws + WS_MOD))[b * 6144 + col0 + c] = s + in[I_BADA][col0 + c]; }
        __syncthreads();
    }
    if (F.vcu == 255) { float* wf = (float*)(ws + WS_WF); for (int i = F.tid; i < 8192; i += NTHR) { const int j = i >> 10, k = i & 1023; wf[i] = in[I_WIN][(size_t)k * DIN + 2048 + j]; } }
    LAS float* scr = (LAS float*)(F.lds + F.wave * 16384);
    const int gw = F.vcu * NWAVES + F.wave, NGW = F.G * NWAVES, lane = F.lane;
    constexpr int I_E = 8192, I_IN = 1024, I_OUT = 512, I_S = 128, I_P = 32, I_R = 32;
    constexpr int NITEMS = 3 * I_E + I_IN + I_OUT + 3 * I_S + I_P + I_R;
    bf16* Wgu = (bf16*)(ws + WS_WGU); bf16* Wd = (bf16*)(ws + WS_WD);
    for (int it = gw; it < NITEMS; it += NGW) {
        int r = it;
        if (r < 2 * I_E) { const int up = r >= I_E; if (up) r -= I_E; const int e = r >> 7, rem = r & 127, k0 = 64 * (rem >> 3), n0 = 32 * (rem & 7);
            tr_item<4>(in[up ? I_WUP : I_WGATE] + (size_t)e * D * 256, 256, k0, n0, (bf16*)((unsigned char*)Wgu + (size_t)e * 512 * D), nullptr, D, (n0 >> 7) * 256 + (n0 & 127) + (up ? 128 : 0), nullptr, WGU_SCALE, scr, lane); continue; }
        r -= 2 * I_E;
        if (r < I_E) { const int e = r >> 7, rem = r & 127, k0 = 64 * (rem >> 5), n0 = 32 * (rem & 31);
            tr_item<0>(in[I_WDOWN] + (size_t)e * 256 * D, D, k0, n0, Wd + (size_t)e * D * 256, nullptr, 256, n0, nullptr, 1.f, scr, lane); continue; }
        r -= I_E;
        if (r < I_IN) { const int k0 = 64 * (r >> 6), n0 = 32 * (r & 63);
            tr_item<0>(in[I_WIN], DIN, k0, n0, (bf16*)(ws + WS_WIN), nullptr, D, n0, nullptr, (n0 >= 512 && n0 < 1024) ? QSCALE : 1.f, scr, lane); continue; }
        r -= I_IN;
        if (r < I_OUT) { const int k0 = 64 * (r >> 5), n0 = 32 * (r & 31);
            tr_item<1>(in[I_WOUT], D, k0, n0, (bf16*)(ws + WS_WOUT), nullptr, D, n0, k0 < 512 ? in[I_GPOOLOUT] : in[I_GATTNOUT] - 512, 1.f, scr, lane); continue; }
        r -= I_OUT;
        if (r < 2 * I_S) { const int up = r >= I_S; if (up) r -= I_S; const int k0 = 64 * (r >> 3), n0 = 32 * (r & 7);
            tr_item<4>(in[up ? I_WSUP : I_WSGATE], 256, k0, n0, (bf16*)(ws + WS_WSGU), nullptr, D, (n0 >> 7) * 256 + (n0 & 127) + (up ? 128 : 0), nullptr, WGU_SCALE, scr, lane); continue; }
        r -= 2 * I_S;
        if (r < I_S) { const int k0 = 64 * (r >> 5), n0 = 32 * (r & 31);
            tr_item<0>(in[I_WSDOWN], D, k0, n0, (bf16*)(ws + WS_WSD), nullptr, 256, n0, nullptr, 1.f, scr, lane); continue; }
        r -= I_S;
        if (r < I_P) { const int g = r >> 3, rem = r & 7, k0 = 64 * (rem >> 2), n0 = 32 * (rem & 3);
            tr_item<2>(in[I_WPOOL] + (size_t)g * 16384, 128, k0, n0, (bf16*)(ws + WS_WPOOL) + (size_t)g * 16384, nullptr, 128, n0, in[I_POOLSCALE] + g * 128, 1.f, scr, lane); continue; }
        r -= I_P;
        { const int k0 = 64 * (r >> 1), n0 = 32 * (r & 1);
            tr_item<3>(in[I_WROUTER], 64, k0, n0, (bf16*)(ws + WS_WRHI), (bf16*)(ws + WS_WRLO), D, n0, nullptr, 1.f, scr, lane); }
    }
}

__device__ __forceinline__ void p0b(Frame& F) {
    const float* const* in = F.in; unsigned char* ws = F.ws;
    LAS float* wfl = (LAS float*)F.lds;
    { const float* wf = (const float*)(ws + WS_WF); for (int i = F.tid; i < 2048; i += NTHR) *(LAS f32x4*)(wfl + 4 * i) = *(const f32x4*)(wf + 4 * i); }
    __syncthreads();
    const int gw = F.vcu * NWAVES + F.wave, lane = F.lane, NGW = F.G * NWAVES;
    const float* mod = (const float*)(ws + WS_MOD);
    for (int r0 = 8 * gw; r0 < T; r0 += 8 * NGW) {
        const int b = r0 / S;
        f32x4 gs[4], sh[4];
#pragma unroll
        for (int j = 0; j < 4; ++j) { const int c = 4 * lane + 256 * j; const f32x4 g = *(const f32x4*)(in[I_GPREMIX] + c), sc = *(const f32x4*)(mod + b * 6144 + 1024 + c);
            gs[j] = g * (sc + 1.0f); sh[j] = *(const f32x4*)(mod + b * 6144 + c); }
        const float bfg = in[I_BFORGET][lane & 7];
        for (int rr = 0; rr < 8; ++rr) {
            const int row = r0 + rr; const GAS f32x4* xr = (const GAS f32x4*)(in[I_X] + (size_t)row * D) + lane;
            f32x4 v[4]; float ss = 0.f;
#pragma unroll
            for (int j = 0; j < 4; ++j) { v[j] = xr[64 * j]; ss += (v[j].x * v[j].x + v[j].y * v[j].y) + (v[j].z * v[j].z + v[j].w * v[j].w); }
            const float rstd = rsqrtf(wave_sum(ss) * (1.f / D) + EPS);
            GAS unsigned long long* o8 = (GAS unsigned long long*)((bf16*)(ws + WS_HB) + (size_t)row * D) + lane;
#pragma unroll
            for (int j = 0; j < 4; ++j) { v[j] = v[j] * rstd * gs[j] + sh[j]; o8[64 * j] = (unsigned long long)pk2(v[j].x, v[j].y) | ((unsigned long long)pk2(v[j].z, v[j].w) << 32); }
            float z = 0.f;
#pragma unroll
            for (int h = 0; h < 8; ++h) { float p = 0.f;
#pragma unroll
                for (int j = 0; j < 4; ++j) { const f32x4 w = *(const LAS f32x4*)(wfl + h * 1024 + 4 * lane + 256 * j); p += (v[j].x * w.x + v[j].y * w.y) + (v[j].z * w.z + v[j].w * w.w); }
                p = wave_sum(p); z = (lane == h) ? p : z; }
            if (lane < 8) { const float u = z + bfg; ((float*)(ws + WS_LOGF))[(size_t)row * 8 + lane] = fminf(u, 0.f) - log1pf(__expf(-fabsf(u))); }
        }
    }
}

__device__ __forceinline__ bool static_unit(int nM, int nN, int G, int c, int i, int& pm, int& pn) {
    const int nwg = nM * nN; const long L = (long)i * G + c; if (L >= nwg) return false;
    int wgid = (int)L; { const int q = nwg / 8, r = nwg % 8, xcd = wgid % 8, off = wgid / 8; wgid = (xcd < r ? xcd * (q + 1) : r * (q + 1) + (xcd - r) * q) + off; }
    const int nig = 8 * nN, gid = wgid / nig, fm = gid * 8, gsz = (nM - fm) < 8 ? (nM - fm) : 8;
    pm = fm + ((wgid % nig) % gsz); pn = (wgid % nig) / gsz; return true;
}
__device__ __forceinline__ void put_unit(Frame& F, int i, const void* A, const void* B, int tab, int orow, int ocol) {
    LAS pg8::UnitRec* r = (LAS pg8::UnitRec*)(F.lds + ULIST_OFF) + i;
    r->A = (unsigned long long)(uintptr_t)A; r->B = (unsigned long long)(uintptr_t)B; r->tab = tab; r->orow = orow; r->ocol = ocol; r->aux = 0;
}
__device__ __forceinline__ void p1(Frame& F) {
    unsigned char* ws = F.ws; int n = 0;
    for (int i = 0; i < MAXU; ++i) { int pm, pn; if (!static_unit(T / 256, 2048 / 256, F.G, (int)blockIdx.x, i, pm, pn)) break;
        if (F.tid == 0) put_unit(F, i, ws + WS_HB + (size_t)pm * 256 * D * 2, ws + WS_WIN + (size_t)pn * 256 * D * 2, -1, pm * 256, pn * 256);
        ++n; }
    __syncthreads();
    pg8::ListSched Sd{(const LAS pg8::UnitRec*)(F.lds + ULIST_OFF), n};
    pg8::EpiBf16 E{(bf16*)(ws + WS_PROJ), 2048};
    pg8::gemm_phase<pg8::EpiBf16, pg8::ListSched, false, pg8::NoHook>(F.lds, D, Sd, E, pg8::NoHook{}, F.wave);
}
}
namespace attn_body {
using bf16=__hip_bfloat16;
using bf16x8=__attribute__((ext_vector_type(8)))short;
using s16x4=__attribute__((ext_vector_type(4)))short;
using f32x16=__attribute__((ext_vector_type(16)))float;
using u32x4=__attribute__((ext_vector_type(4)))unsigned;
constexpr int BATCH=8,NHEAD=8,SEQ=2048,D=64,DM=2048,PO=1024;
constexpr int NW=8,QBLK=32,QB=QBLK*NW,KVBLK=64,NQB=SEQ/QB;
__device__ __forceinline__ int crow(int r,int hi){return (r&3)+8*(r>>2)+4*hi;}
#define SBAR() __builtin_amdgcn_sched_barrier(0)
__device__ __forceinline__ void cmask(f32x16&p0,f32x16&p1,int jb,int qrel,int hi){
  const float NEG=-INFINITY; int kb=64*jb+4*hi;
  #pragma unroll
  for(int r=0;r<16;++r){int kv=kb+(r&3)+8*(r>>2); if(kv>qrel)p0[r]=NEG; if(kv+32>qrel)p1[r]=NEG;}
}

constexpr int NSLOT=3, SLOTB=8192;
constexpr int LDS_K=0, LDS_V=NSLOT*SLOTB, LDS_WS=2*NSLOT*SLOTB, LDS_OST=LDS_WS+NW*64*4, LDS_CUM=LDS_OST+NW*4096, LDS_KB=LDS_CUM+SEQ*4, LDS_BYTES=LDS_KB+SEQ*4;
__device__ __forceinline__ void glds16(const void*gsrc,unsigned lds_dst){unsigned keep;
  asm volatile("s_mov_b32 %0, m0\n\ts_mov_b32 m0, %2\n\ts_nop 0\n\tglobal_load_lds_dwordx4 %1, off\n\ts_mov_b32 m0, %0":"=&s"(keep):"v"(gsrc),"s"(lds_dst):"memory");}
__device__ __forceinline__ float max3f(float a,float b,float c){float r;asm("v_max3_f32 %0, %1, %2, %3":"=v"(r):"v"(a),"v"(b),"v"(c));return r;}
__device__ __forceinline__ float max2f(float a,float b){float r;asm("v_max_f32_e32 %0, %1, %2":"=v"(r):"v"(a),"v"(b));return r;}
__device__ __forceinline__ float fadd_s(float a,float b){float r;asm("v_add_f32_e32 %0, %1, %2":"=v"(r):"v"(a),"v"(b));return r;}
__device__ __forceinline__ float fsub_s(float a,float b){float r;asm("v_sub_f32_e32 %0, %1, %2":"=v"(r):"v"(a),"v"(b));return r;}
typedef float f32x2_t __attribute__((ext_vector_type(2))); typedef __bf16 bf16x2_t __attribute__((ext_vector_type(2)));
__device__ __forceinline__ unsigned cvtpk_s(float lo,float hi){f32x2_t v={lo,hi};bf16x2_t b=__builtin_convertvector(v,bf16x2_t);return __builtin_bit_cast(unsigned,b);}
#define WAIT_BAR(N) asm volatile("s_waitcnt vmcnt(" #N ") lgkmcnt(0)\n\ts_barrier":::"memory")

__device__ __forceinline__ void qkt(f32x16&p0,f32x16&p1,const char*Kslot,const bf16x8*qr,bf16x8 kb0,bf16x8 kb1,bf16x8 qb,int r32,int hi){
  const char*kb=Kslot+hi*1024+r32*16;
  p0=__builtin_amdgcn_mfma_f32_32x32x16_bf16(kb0,qb,f32x16{},0,0,0);p1=__builtin_amdgcn_mfma_f32_32x32x16_bf16(kb1,qb,f32x16{},0,0,0);
  #pragma unroll
  for(int d0=0;d0<4;++d0){
    const bf16x8 b0=*reinterpret_cast<const bf16x8*>(kb+d0*2048);
    const bf16x8 b1=*reinterpret_cast<const bf16x8*>(kb+d0*2048+512);
    p0=__builtin_amdgcn_mfma_f32_32x32x16_bf16(b0,qr[d0],p0,0,0,0);p1=__builtin_amdgcn_mfma_f32_32x32x16_bf16(b1,qr[d0],p1,0,0,0);}
}
typedef __attribute__((address_space(3))) const char* lds_cptr;
typedef short v4i16_t __attribute__((ext_vector_type(4)));
__device__ __forceinline__ void kload8(bf16x8*kf,lds_cptr kp){
  kf[0]=*(const __attribute__((address_space(3))) bf16x8*)(kp);      kf[1]=*(const __attribute__((address_space(3))) bf16x8*)(kp+512);
  kf[2]=*(const __attribute__((address_space(3))) bf16x8*)(kp+2048); kf[3]=*(const __attribute__((address_space(3))) bf16x8*)(kp+2560);
  kf[4]=*(const __attribute__((address_space(3))) bf16x8*)(kp+4096); kf[5]=*(const __attribute__((address_space(3))) bf16x8*)(kp+4608);
  kf[6]=*(const __attribute__((address_space(3))) bf16x8*)(kp+6144); kf[7]=*(const __attribute__((address_space(3))) bf16x8*)(kp+6656);
}
__device__ __forceinline__ void kload2(bf16x8*kf,lds_cptr kp,int j){ kf[2*j]=*(const __attribute__((address_space(3))) bf16x8*)(kp+j*2048); kf[2*j+1]=*(const __attribute__((address_space(3))) bf16x8*)(kp+j*2048+512); }
__device__ __forceinline__ s16x4 vtr(lds_cptr p){ return __builtin_bit_cast(s16x4,__builtin_amdgcn_ds_read_tr16_b64_v4i16((__attribute__((address_space(3))) v4i16_t*)p)); }
__device__ __forceinline__ float rowmax(const f32x16&p0,const f32x16&p1){
  float a=max3f(p0[0],p0[1],p1[0]),b=max3f(p0[2],p0[3],p1[1]);a=max3f(a,p1[2],p1[3]);
  #pragma unroll
  for(int r=4;r<16;r+=4){a=max3f(a,p0[r],p0[r+1]);b=max3f(b,p0[r+2],p0[r+3]);a=max3f(a,p1[r],p1[r+1]);b=max3f(b,p1[r+2],p1[r+3]);}
  const float m=max2f(a,b);
  auto rr=__builtin_amdgcn_permlane32_swap(__float_as_uint(m),__float_as_uint(m),false,false);
  return max2f(__uint_as_float(rr[0]),__uint_as_float(rr[1]));
}
__device__ __forceinline__ void pv(f32x16*o,int vb,bf16x8 pa0,bf16x8 pa1,bf16x8 pa2,bf16x8 pa3){
  #pragma unroll
  for(int d0=0;d0<2;++d0){s16x4 lo[4],hi[4];
    #pragma unroll
    for(int ks=0;ks<4;++ks){
      asm volatile("ds_read_b64_tr_b16 %0,%1 offset:%c2":"=&v"(lo[ks]):"v"(vb),"i"(d0*4096+ks*1024):"memory");
      asm volatile("ds_read_b64_tr_b16 %0,%1 offset:%c2":"=&v"(hi[ks]):"v"(vb),"i"(d0*4096+ks*1024+512):"memory");}
    asm volatile("s_waitcnt lgkmcnt(0)":::"memory");SBAR();
    #define PK(k) (bf16x8){lo[k][0],lo[k][1],lo[k][2],lo[k][3],hi[k][0],hi[k][1],hi[k][2],hi[k][3]}
    o[d0]=__builtin_amdgcn_mfma_f32_32x32x16_bf16(pa0,PK(0),o[d0],0,0,0);
    o[d0]=__builtin_amdgcn_mfma_f32_32x32x16_bf16(pa1,PK(1),o[d0],0,0,0);
    o[d0]=__builtin_amdgcn_mfma_f32_32x32x16_bf16(pa2,PK(2),o[d0],0,0,0);
    o[d0]=__builtin_amdgcn_mfma_f32_32x32x16_bf16(pa3,PK(3),o[d0],0,0,0);
    #undef PK
  }
}

#ifndef ATTN_STORE16
#define ATTN_STORE16(p,v) (*(u32x4*)(p)=(v))
#endif
template<int THRL> __device__ __forceinline__ void attn_unit(int b,int h,int qb,const bf16*Q,const bf16*__restrict__ K,const bf16*__restrict__ V,bf16*O,float*ssq,char*shm,const int wid){
  int lane; asm volatile("v_mbcnt_lo_u32_b32 %0, -1, 0\n\tv_mbcnt_hi_u32_b32 %0, -1, %0" : "=v"(lane));
  const int tid=wid*64+lane, r32=lane&31,hi=lane>>5;
  const long rowbase=(long)b*SEQ; const int q0=qb*QB;
  const bf16*Qw=Q+(rowbase+q0+wid*QBLK)*DM+h*D;
  const bf16*Kh=K+rowbase*DM+h*D,*Vh=V+rowbase*DM+h*D;
  const unsigned lds0=(unsigned)(uintptr_t)shm;
  float*wsf=(float*)(shm+LDS_WS)+wid*64;
  const bf16*ksrc=Kh+(long)lane*DM+wid*8;
  const bf16*vsrc=Vh+(long)(16*(wid&3)+(lane>>2))*DM+(wid>>2)*32+(lane&3)*8;
  const unsigned kdst=lds0+LDS_K+wid*1024, vdst=lds0+LDS_V+wid*1024;
  #define DMA_K(t,slot) glds16(ksrc+(long)(t)*KVBLK*DM,(unsigned)__builtin_amdgcn_readfirstlane(kdst+(slot)))
  #define DMA_V(t,slot) glds16(vsrc+(long)(t)*KVBLK*DM,(unsigned)__builtin_amdgcn_readfirstlane(vdst+(slot)))
  const int vb0=(int)(lds0+LDS_V)+((lane>>4)&1)*32+(lane&3)*8+(4*hi+((lane&15)>>2))*64;
  const char*Kbase=shm+LDS_K; bf16x8 kf[8];
  const lds_cptr shm3=(lds_cptr)shm; const lds_cptr kp0=shm3+LDS_K+hi*1024+r32*16; const lds_cptr vp0=shm3+LDS_V+((lane>>4)&1)*32+(lane&3)*8+(4*hi+((lane&15)>>2))*64;
  const int NT=(q0+QB)/KVBLK;
  { const float*cum=(const float*)(shm+LDS_CUM); unsigned*kbt_=(unsigned*)(shm+LDS_KB); const float ref=cum[q0+QB-1];
    for(int k=tid;k<NT*KVBLK;k+=NW*64){ const float v=(ref-cum[k])*1.4426950408889634f; const unsigned hb=mk::f2bf(v); kbt_[k]=hb|(mk::f2bf(v-mk::bf2f(hb))<<16); }
    __syncthreads(); }
  const __attribute__((address_space(3))) unsigned* kbt=(const __attribute__((address_space(3))) unsigned*)((lds_cptr)shm+LDS_KB);
  const unsigned kone1=hi?0u:0x3F803F80u;
  #define KBF(pk) __builtin_bit_cast(bf16x8,(u32x4){(pk),kone1,kone1,0u})
  unsigned kbr0,kbr1;
  #define KBRD(G,tt) do{ if(G){ const unsigned a_=kbt[(tt)*KVBLK+r32], b_=kbt[(tt)*KVBLK+32+r32]; kbr0=a_; kbr1=b_; } }while(0)
  bf16x8 qb_=__builtin_bit_cast(bf16x8,(u32x4){kone1,0u,0u,0u});
  #define SETREF() do{ const float nm_=-mhat; const unsigned h0_=__float_as_uint(nm_)&0xFFFF0000u; const float r1_=nm_-__uint_as_float(h0_); const unsigned h1_=__float_as_uint(r1_)&0xFFFF0000u; \
      const float r2_=r1_-__uint_as_float(h1_); const unsigned h2_=__float_as_uint(r2_)&0xFFFF0000u; \
      qb_=__builtin_bit_cast(bf16x8,(u32x4){kone1, hi?0u:((h0_>>16)|h1_), hi?0u:(h2_>>16), 0u}); }while(0)
  DMA_K(0,0);DMA_V(0,0);DMA_K(1,SLOTB);
  bf16x8 qr[4];
  #pragma unroll
  for(int d0=0;d0<4;++d0)qr[d0]=*reinterpret_cast<const bf16x8*>(&Qw[(long)r32*DM+d0*16+hi*8]);
  const lds_cptr qp0=shm3+LDS_OST+wid*4096+hi*512+r32*16;
  #pragma unroll
  for(int d0=0;d0<4;++d0)*(__attribute__((address_space(3))) bf16x8*)((__attribute__((address_space(3))) char*)(qp0+d0*1024))=qr[d0];
  #define QF(d0) (*(const __attribute__((address_space(3))) bf16x8*)(qp0+(d0)*1024))
  float mhat=0.f,l_reg=0.f;f32x16 o[2];o[0]=f32x16{};o[1]=f32x16{};
  const int qrel=wid*QBLK+r32;
  #define CMASK(P0,P1,t) do{int jb_=(t)-(NT-4); if(jb_>=0)cmask(P0,P1,jb_,qrel,hi);}while(0)
  bool resc=false;
  #define START(P0,P1) do{ const float rm=rowmax(P0,P1); resc=false; \
    { const float dl=rm; mhat=fadd_s(mhat,dl); \
      _Pragma("unroll") for(int r=0;r<16;++r){P0[r]=fsub_s(P0[r],dl);P1[r]=fsub_s(P1[r],dl);} \
      SETREF(); } \
    _Pragma("unroll") for(int r=0;r<16;++r)P0[r]=__builtin_amdgcn_exp2f(P0[r]); }while(0)
  #define RESC() do{ if(resc){ asm volatile("s_waitcnt lgkmcnt(0)":::"memory"); \
      _Pragma("unroll") for(int d_=0;d_<2;++d_) _Pragma("unroll") for(int r=0;r<16;++r)o[d_][r]*=wsf[crow(r,hi)]; } }while(0)
  f32x16 pA0,pA1,pB0,pB1;
  int sl_prev=0,sl_cur=0,sl_next=SLOTB;
  #define ROT() do{sl_prev=sl_cur;sl_cur=sl_next;sl_next=(sl_next==(NSLOT-1)*SLOTB)?0:sl_next+SLOTB;}while(0)
  DMA_K(2,2*SLOTB);
  WAIT_BAR(3);
  KBRD(true,0);
  qkt(pA0,pA1,Kbase,qr,KBF(kbr0),KBF(kbr1),qb_,r32,hi);asm volatile("s_nop 15\n\ts_nop 7":"+v"(pA0),"+v"(pA1));CMASK(pA0,pA1,0);
  START(pA0,pA1);
  _Pragma("unroll") for(int r=0;r<16;++r)pA1[r]=__builtin_amdgcn_exp2f(pA1[r]);
  WAIT_BAR(0);
  DMA_K(3,0);DMA_V(1,SLOTB);
  ROT();
  kload8(kf,kp0+sl_cur);
  KBRD(true,1);
  WAIT_BAR(2);
  s16x4 vlo[8],vhi[8]; u32x4 pw0,pw1,pw2,pw3;
  #define PKW(P,B) cvtpk_s(P[B],P[B+1])
  #define PAF(k) __builtin_bit_cast(bf16x8,pw##k)
  #define VFR(i) (bf16x8){vlo[i][0],vlo[i][1],vlo[i][2],vlo[i][3],vhi[i][0],vhi[i][1],vhi[i][2],vhi[i][3]}
  #define PIN(x) asm volatile("":"+v"(x))
  #define MX3(a,b,c) __builtin_fmaxf(__builtin_fmaxf((a),(b)),(c))
  #define GAPA(MF,A0,A1,A2,A3,W0,W1,PW) do{ MF; sacc+=A0; sacc+=A1; sacc+=A2; sacc+=A3; PIN(sacc); W0; W1; PIN(PW); SBAR(); }while(0)
  #define EX(v) __builtin_amdgcn_exp2f(v)
  #define GAPB(MF,X,B) do{ MF; X[B]=EX(X[B]); X[B+1]=EX(X[B+1]); X[B+2]=EX(X[B+2]); X[B+3]=EX(X[B+3]); PIN(X); SBAR(); }while(0)
  #define VRD(i) do{ vlo[i]=vtr(vp_+(((i)>>2)*4096+((i)&3)*1024)); vhi[i]=vtr(vp_+(((i)>>2)*4096+((i)&3)*1024+512)); }while(0)
  #define KRD(G,j) do{ if(G){ kload2(kf,kp0+sl_next,j); SBAR(); } }while(0)
  #define STEP(C0,C1,P0,P1,t,GK,GV,GL) do{ SBAR(); \
    const lds_cptr vp_=vp0+sl_prev; \
    C0=__builtin_amdgcn_mfma_f32_32x32x16_bf16(KBF(kbr0),qb_,f32x16{},0,0,0); C1=__builtin_amdgcn_mfma_f32_32x32x16_bf16(KBF(kbr1),qb_,f32x16{},0,0,0); SBAR(); \
    VRD(0); SBAR(); float sacc=(P0[0]+P0[1]); \
    bf16x8 qa_=QF(0), qc_=QF(1); \
    GAPA(C0=__builtin_amdgcn_mfma_f32_32x32x16_bf16(kf[0],qa_,C0,0,0,0), P0[2],P0[3],P0[4],P0[5],     pw0[0]=PKW(P0,0), pw0[1]=PKW(P0,2), pw0); \
    VRD(4); SBAR(); GAPA(C1=__builtin_amdgcn_mfma_f32_32x32x16_bf16(kf[1],qa_,C1,0,0,0), P0[6],P0[7],P0[8],P0[9],     pw0[2]=PKW(P0,4), pw0[3]=PKW(P0,6), pw0); \
    qa_=QF(2); VRD(1); SBAR(); GAPA(C0=__builtin_amdgcn_mfma_f32_32x32x16_bf16(kf[2],qc_,C0,0,0,0),   P0[10],P0[11],P0[12],P0[13], pw1[0]=PKW(P0,8), pw1[1]=PKW(P0,10), pw1); \
    VRD(5); SBAR(); GAPA(C1=__builtin_amdgcn_mfma_f32_32x32x16_bf16(kf[3],qc_,C1,0,0,0),   P0[14],P0[15],P1[0],P1[1],   pw1[2]=PKW(P0,12),pw1[3]=PKW(P0,14), pw1); \
    qc_=QF(3); VRD(2); SBAR(); GAPA(C0=__builtin_amdgcn_mfma_f32_32x32x16_bf16(kf[4],qa_,C0,0,0,0),   P1[2],P1[3],P1[4],P1[5],     pw2[0]=PKW(P1,0), pw2[1]=PKW(P1,2), pw2); \
    VRD(6); SBAR(); GAPA(C1=__builtin_amdgcn_mfma_f32_32x32x16_bf16(kf[5],qa_,C1,0,0,0),   P1[6],P1[7],P1[8],P1[9],     pw2[2]=PKW(P1,4), pw2[3]=PKW(P1,6), pw2); \
    VRD(3); SBAR(); GAPA(C0=__builtin_amdgcn_mfma_f32_32x32x16_bf16(kf[6],qc_,C0,0,0,0),   P1[10],P1[11],P1[12],P1[13], pw3[0]=PKW(P1,8), pw3[1]=PKW(P1,10), pw3); \
    VRD(7); SBAR(); GAPA(C1=__builtin_amdgcn_mfma_f32_32x32x16_bf16(kf[7],qc_,C1,0,0,0),   P1[14],P1[15],0.f,0.f,       pw3[2]=PKW(P1,12),pw3[3]=PKW(P1,14), pw3); \
    l_reg+=sacc; \
    if(GK){DMA_K((t)+3,sl_cur);} if(GV){DMA_V((t)+1,sl_next);} \
    CMASK(C0,C1,t); \
    { float a=MX3(C0[0],C0[1],C1[0]),b=MX3(C0[2],C0[3],C1[1]); a=MX3(a,C1[2],C1[3]); \
      _Pragma("unroll") for(int r=4;r<16;r+=4){a=MX3(a,C0[r],C0[r+1]);b=MX3(b,C0[r+2],C0[r+3]);a=MX3(a,C1[r],C1[r+1]);b=MX3(b,C1[r+2],C1[r+3]);} \
      float rm=__builtin_fmaxf(a,b); { auto rr=__builtin_amdgcn_permlane32_swap(__float_as_uint(rm),__float_as_uint(rm),false,false); rm=__builtin_fmaxf(__uint_as_float(rr[0]),__uint_as_float(rr[1])); } \
      resc=false; \
      if(__builtin_expect(__any(rm>(float)THRL),0)){ const float dl=__builtin_fmaxf(rm,0.f); mhat+=dl; \
        _Pragma("unroll") for(int r=0;r<16;++r){C0[r]-=dl;C1[r]-=dl;} \
        SETREF(); \
        const float f=__builtin_amdgcn_exp2f(-dl); l_reg*=f; if(hi==0)wsf[r32]=f; resc=true; } } \
    SBAR(); \
    GAPB(o[0]=__builtin_amdgcn_mfma_f32_32x32x16_bf16(PAF(0),VFR(0),o[0],0,0,0), C0,0); \
    GAPB(o[1]=__builtin_amdgcn_mfma_f32_32x32x16_bf16(PAF(0),VFR(4),o[1],0,0,0), C0,4); \
    KRD(GL,0); GAPB(o[0]=__builtin_amdgcn_mfma_f32_32x32x16_bf16(PAF(1),VFR(1),o[0],0,0,0), C0,8); \
    KRD(GL,1); GAPB(o[1]=__builtin_amdgcn_mfma_f32_32x32x16_bf16(PAF(1),VFR(5),o[1],0,0,0), C0,12); \
    KRD(GL,2); GAPB(o[0]=__builtin_amdgcn_mfma_f32_32x32x16_bf16(PAF(2),VFR(2),o[0],0,0,0), C1,0); \
    KRD(GL,3); GAPB(o[1]=__builtin_amdgcn_mfma_f32_32x32x16_bf16(PAF(2),VFR(6),o[1],0,0,0), C1,4); \
    KBRD(GL,(t)+1); \
    GAPB(o[0]=__builtin_amdgcn_mfma_f32_32x32x16_bf16(PAF(3),VFR(3),o[0],0,0,0), C1,8); \
    GAPB(o[1]=__builtin_amdgcn_mfma_f32_32x32x16_bf16(PAF(3),VFR(7),o[1],0,0,0), C1,12); \
    }while(0)
  int t=1;
  #undef CMASK
  #define CMASK(P0,P1,t) do{}while(0)
  for(;t+5<NT;t+=2){
    STEP(pB0,pB1,pA0,pA1,t,true,true,true);     WAIT_BAR(2); RESC(); ROT();
    STEP(pA0,pA1,pB0,pB1,t+1,true,true,true);   WAIT_BAR(2); RESC(); ROT();
  }
  #undef CMASK
  #define CMASK(P0,P1,t) do{int jb_=(t)-(NT-4); if(jb_>=0)cmask(P0,P1,jb_,qrel,hi);}while(0)
  #define ENDW(tt) do{ if((tt)+3<NT){WAIT_BAR(2);} else if((tt)+2<NT){WAIT_BAR(1);} else {WAIT_BAR(0);} }while(0)
  for(;t+1<NT;t+=2){
    STEP(pB0,pB1,pA0,pA1,t,(t+3<NT),(t+1<NT),(t+1<NT));       ENDW(t);   RESC(); ROT();
    STEP(pA0,pA1,pB0,pB1,t+1,(t+4<NT),(t+2<NT),(t+2<NT));     ENDW(t+1); RESC(); ROT();
  }
  STEP(pB0,pB1,pA0,pA1,NT-1,false,false,false); RESC();
  { float sacc=pB0[0]+pB0[1]; _Pragma("unroll") for(int r=2;r<16;++r)sacc+=pB0[r]; _Pragma("unroll") for(int r=0;r<16;++r)sacc+=pB1[r]; l_reg+=sacc;
    pw0=(u32x4){PKW(pB0,0),PKW(pB0,2),PKW(pB0,4),PKW(pB0,6)};pw1=(u32x4){PKW(pB0,8),PKW(pB0,10),PKW(pB0,12),PKW(pB0,14)};pw2=(u32x4){PKW(pB1,0),PKW(pB1,2),PKW(pB1,4),PKW(pB1,6)};pw3=(u32x4){PKW(pB1,8),PKW(pB1,10),PKW(pB1,12),PKW(pB1,14)};
    SBAR(); pv(o,vb0+sl_cur,PAF(0),PAF(1),PAF(2),PAF(3)); }
  #undef PKW
  #undef PAF
  #undef VFR
  #undef PIN
  #undef MX3
  #undef GAPA
  #undef GAPB
  #undef EX
  #undef VRD
  #undef KRD
  #undef STEP
  #undef ENDW
  {auto rr=__builtin_amdgcn_permlane32_swap(__float_as_uint(l_reg),__float_as_uint(l_reg),false,false);l_reg=__uint_as_float(rr[0])+__uint_as_float(rr[1]);}
  if(hi==0)wsf[32+r32]=l_reg;asm volatile("s_waitcnt lgkmcnt(0)":::"memory");
  float rli[16];
  #pragma unroll
  for(int r=0;r<16;++r)rli[r]=__builtin_amdgcn_rcpf(wsf[32+crow(r,hi)]);
  bf16*Ow=O+(rowbase+q0+wid*QBLK)*PO+h*D; float*sq=ssq+(rowbase+q0+wid*QBLK)*8+h;
  { bf16*stg=(bf16*)(shm+LDS_OST)+wid*2048;
    #pragma unroll
    for(int r=0;r<16;++r){const int orow=crow(r,hi);
      #pragma unroll
      for(int d0=0;d0<2;++d0)stg[orow*64+d0*32+r32]=__float2bfloat16(o[d0][r]*rli[r]);}
    asm volatile("s_waitcnt lgkmcnt(0)":::"memory");
    #pragma unroll
    for(int i=0;i<4;++i){const int row=i*8+(lane>>3),ch=lane&7; const u32x4 v=*(const u32x4*)(stg+row*64+ch*8); ATTN_STORE16(Ow+(long)row*PO+ch*8,v);
      float ss=0.f;
      #pragma unroll
      for(int j=0;j<4;++j){ const float a_=__uint_as_float(v[j]<<16), b_=__uint_as_float(v[j]&0xFFFF0000u); ss+=a_*a_+b_*b_; }
      ss+=__shfl_xor(ss,1); ss+=__shfl_xor(ss,2); ss+=__shfl_xor(ss,4); if(ch==0) sq[(long)row*8]=ss; } }
  asm volatile("s_waitcnt lgkmcnt(0)\n\ts_barrier":::"memory");
  #undef DMA_K
  #undef DMA_V
  #undef CMASK
  #undef START
  #undef RESC
  #undef ROT
  #undef KBF
  #undef QF
  #undef KBRD
  #undef SETREF
}
constexpr int ATTN_LDS_BYTES=LDS_BYTES;
#undef SBAR
#undef WAIT_BAR
}

namespace mk {
__device__ __forceinline__ void pool_tile(Frame& F, int tile) {
    unsigned char* ws = F.ws; constexpr int US = 1040;
    const int t0 = tile * 64, tl0 = t0 % S;
    const bf16* proj = (const bf16*)(ws + WS_PROJ);
    for (int c = F.tid; c < 79 * 64; c += NTHR) { const int rr = c >> 6, ch = c & 63; v4u v = (v4u){0u, 0u, 0u, 0u};
        if (tl0 + rr - 15 >= 0) v = *(const GAS v4u*)(proj + (size_t)(t0 - 15 + rr) * 2048 + ch * 8);
        *(LAS v4u*)(F.lds + rr * US + ch * 16) = v; }
    __syncthreads();
    const int mb = F.wave & 3, nh = F.wave >> 2, r = F.lane & 15, kq = F.lane >> 4, tr = mb * 16 + r, tl = tl0 + tr;
    const bf16* wp = (const bf16*)(ws + WS_WPOOL);
    bf16* ycat = (bf16*)(ws + WS_YCAT); float* ssqp = (float*)(ws + WS_SSQP);
#pragma unroll
    for (int g = 0; g < 4; ++g) {
        constexpr int dummy = 0; (void)dummy;
        const int wg = 2 << g; const int n = (tl + 1 < wg) ? tl + 1 : wg; const float inv = 1.0f / (float)n;
        f32x4 acc[4];
#pragma unroll
        for (int nb = 0; nb < 4; ++nb) acc[nb] = (f32x4){0.f, 0.f, 0.f, 0.f};
#pragma unroll
        for (int ks = 0; ks < 4; ++ks) {
            const int c0 = g * 128 + ks * 32 + kq * 8;
            float sum[8];
#pragma unroll
            for (int j = 0; j < 8; ++j) sum[j] = 0.f;
            v4u cur = (v4u){0u, 0u, 0u, 0u};
#pragma unroll
            for (int i = 0; i < wg; ++i) { const v4u v = *(const LAS v4u*)(F.lds + (tr + 15 - i) * US + c0 * 2); if (i == 0) cur = v;
#pragma unroll
                for (int j = 0; j < 4; ++j) { sum[2 * j] += __uint_as_float(v[j] << 16); sum[2 * j + 1] += __uint_as_float(v[j] & 0xFFFF0000u); } }
            v4u pa;
#pragma unroll
            for (int j = 0; j < 4; ++j) pa[j] = pk2(sum[2 * j] * inv - __uint_as_float(cur[j] << 16), sum[2 * j + 1] * inv - __uint_as_float(cur[j] & 0xFFFF0000u));
            const bf16x8 af = __builtin_bit_cast(bf16x8, pa);
#pragma unroll
            for (int nb = 0; nb < 4; ++nb) { const bf16x8 bfr = *(const bf16x8*)(wp + (size_t)g * 16384 + (size_t)(nh * 64 + nb * 16 + r) * 128 + ks * 32 + kq * 8);
                acc[nb] = __builtin_amdgcn_mfma_f32_16x16x32_bf16(bfr, af, acc[nb], 0, 0, 0); }
        }
        const size_t token = (size_t)t0 + tr; float ss = 0.f;
#pragma unroll
        for (int nb = 0; nb < 4; ++nb) { const f32x4 v = acc[nb]; ss += (v[0] * v[0] + v[1] * v[1]) + (v[2] * v[2] + v[3] * v[3]);
            v2u o; o.x = pk2(v[0], v[1]); o.y = pk2(v[2], v[3]);
            *(GAS v2u*)(ycat + token * D + g * 128 + nh * 64 + nb * 16 + 4 * kq) = o; }
        ss += __shfl_xor(ss, 16); ss += __shfl_xor(ss, 32);
        if (kq == 0) ssqp[token * 8 + g * 2 + nh] = ss;
    }
    __syncthreads();
}

__device__ __forceinline__ void p2(Frame& F) {
    unsigned char* ws = F.ws; char* shm = (char*)(uintptr_t)0;
    (void)shm;
    const attn_body::bf16* proj = (const attn_body::bf16*)(ws + WS_PROJ);
    attn_body::bf16* ycat = (attn_body::bf16*)(ws + WS_YCAT);
    const float* logf = (const float*)(ws + WS_LOGF); float* ssqa = (float*)(ws + WS_SSQA);
    char* lds = (char*)F.lds;
    for (int p = F.vcu; p < 256; p += F.G) {
        const int bh = p >> 2, s = p & 3, b = bh >> 3, h = bh & 7;
        { const float* lf = logf + (size_t)b * S * 8 + h; const int k0 = 4 * F.tid;
          const float l0 = lf[(size_t)(k0 + 0) * 8], l1 = lf[(size_t)(k0 + 1) * 8], l2 = lf[(size_t)(k0 + 2) * 8], l3 = lf[(size_t)(k0 + 3) * 8];
          const float c0 = l0, c1 = c0 + l1, c2 = c1 + l2, c3 = c2 + l3; float x = c3;
#pragma unroll
          for (int o = 1; o < 64; o <<= 1) { const float y = __shfl_up(x, o); if (F.lane >= o) x += y; }
          LAS float* wt = (LAS float*)(F.lds + attn_body::LDS_WS);
          if (F.lane == 63) wt[F.wave] = x;
          __syncthreads();
          float base = x - c3; for (int w = 0; w < F.wave; ++w) base += wt[w];
          LAS float* cum = (LAS float*)(F.lds + attn_body::LDS_CUM);
          *(LAS f32x4*)(cum + k0) = (f32x4){base + c0, base + c1, base + c2, base + c3};
          __syncthreads(); }
#pragma nounroll
        for (int u = 0; u < 2; ++u) attn_body::attn_unit<8>(b, h, u ? 7 - s : s, proj + 512, proj + 1024, proj + 1536, ycat + 512, ssqa, lds, F.wave);
    }
    __syncthreads();
    for (int tile = F.vcu; tile < T / 64; tile += F.G) pool_tile(F, tile);
}
}
namespace mk {
struct MidScaleHook {
    const LAS float* ratio;
    __device__ __forceinline__ void at(int t, pg8::f32x4 (&acc)[2][2][4][2], int wr, int fr, int) const {
        if (t == 8) {
#pragma unroll
            for (int ai = 0; ai < 2; ++ai)
#pragma unroll
                for (int m = 0; m < 4; ++m) { const float s = ratio[ai * 128 + wr * 64 + m * 16 + fr];
#pragma unroll
                    for (int bj = 0; bj < 2; ++bj)
#pragma unroll
                        for (int n = 0; n < 2; ++n) acc[ai][bj][m][n] *= s; }
        }
    }
};
__device__ __forceinline__ void p3(Frame& F) {
    unsigned char* ws = F.ws;
    LAS float* ratio = (LAS float*)(F.lds + RS_OFF); LAS float* rs = ratio + 256;
    const float* ssqp = (const float*)(ws + WS_SSQP); const float* ssqa = (const float*)(ws + WS_SSQA);
    for (int i = 0; i < 64; ++i) { int pm, pn; if (!static_unit(T / 256, D / 256, F.G, (int)blockIdx.x, i, pm, pn)) break;
        __syncthreads();
        if (F.tid < 256) { const size_t tok = (size_t)pm * 256 + F.tid; float sp = 0.f, sa = 0.f;
#pragma unroll
            for (int j = 0; j < 8; ++j) { sp += ssqp[tok * 8 + j]; sa += ssqa[tok * 8 + j]; }
            const float rp = rsqrtf(sp * (1.f / 512.f) + EPS), ra = rsqrtf(sa * (1.f / 512.f) + EPS);
            ratio[F.tid] = rp / ra; rs[F.tid] = ra; }
        if (F.tid == 0) put_unit(F, 0, ws + WS_YCAT + (size_t)pm * 256 * D * 2, ws + WS_WOUT + (size_t)pn * 256 * D * 2, -1, pm * 256, pn * 256);
        __syncthreads();
        pg8::ListSched Sd{(const LAS pg8::UnitRec*)(F.lds + ULIST_OFF), 1};
        pg8::EpiRowScaleBf16 E{(bf16*)(ws + WS_MIXED), D, rs};
        pg8::gemm_phase<pg8::EpiRowScaleBf16, pg8::ListSched, false, MidScaleHook>(F.lds, D, Sd, E, MidScaleHook{ratio}, F.wave);
    }
}
}
namespace mk {
__device__ __forceinline__ int p4_swz(int row, int chunk) { return row * 2048 + ((chunk ^ (row & 15)) << 4); }
template <bool DRY> __device__ __forceinline__ void p4(Frame& F) {
    const bool live = !DRY || (__hip_atomic_load(F.ctl + 3, RLX_AGENT) == 0xdeadbeefu);
    const float* const* in = F.in; unsigned char* ws = F.ws;
    const float* mod = (const float*)(ws + WS_MOD);
    const bf16* mixed = (const bf16*)(ws + WS_MIXED); unsigned char* h2g = ws + WS_H2;
    const bf16* wrhi = (const bf16*)(ws + WS_WRHI); const bf16* wrlo = (const bf16*)(ws + WS_WRLO);
    LAS unsigned char* thi = F.lds; LAS unsigned char* tlo = F.lds + 65536;
    const int lane = F.lane;
    for (int tile = F.vcu; tile < T / 32; tile += F.G) {
        for (int rr = 0; rr < 4; ++rr) {
            const int rowi = F.wave * 4 + rr; const size_t token = (size_t)tile * 32 + rowi; const int b = (int)(token / S);
            f32x4 m[4]; float ss = 0.f;
#pragma unroll
            for (int j = 0; j < 4; ++j) { const v2u u = *(const GAS v2u*)(mixed + token * D + 4 * lane + 256 * j);
                m[j] = (f32x4){__uint_as_float(u.x << 16), __uint_as_float(u.x & 0xFFFF0000u), __uint_as_float(u.y << 16), __uint_as_float(u.y & 0xFFFF0000u)};
                ss += (m[j].x * m[j].x + m[j].y * m[j].y) + (m[j].z * m[j].z + m[j].w * m[j].w); }
            const float rm = rsqrtf(wave_sum(ss) * (1.f / D) + EPS);
            float s1 = 0.f;
#pragma unroll
            for (int j = 0; j < 4; ++j) { const int c = 4 * lane + 256 * j;
                const f32x4 xv = *(const GAS f32x4*)(in[I_X] + token * D + c), gt = *(const f32x4*)(mod + b * 6144 + 2048 + c), gp = *(const f32x4*)(in[I_GPOSTMIX] + c);
                m[j] = xv + gt * (m[j] * rm) * gp;
                if (live) *(GAS f32x4*)(F.out + token * D + c) = m[j];
                s1 += (m[j].x * m[j].x + m[j].y * m[j].y) + (m[j].z * m[j].z + m[j].w * m[j].w); }
            const float r1 = rsqrtf(wave_sum(s1) * (1.f / D) + EPS);
#pragma unroll
            for (int j = 0; j < 4; ++j) { const int c = 4 * lane + 256 * j;
                const f32x4 gf = *(const f32x4*)(in[I_GPREFFN] + c), sc = *(const f32x4*)(mod + b * 6144 + 4096 + c), sh = *(const f32x4*)(mod + b * 6144 + 3072 + c);
                const f32x4 h = m[j] * r1 * gf * (sc + 1.0f) + sh;
                const unsigned h0 = f2bf(h.x), h1 = f2bf(h.y), h2_ = f2bf(h.z), h3 = f2bf(h.w);
                v2u hv; hv.x = h0 | (h1 << 16); hv.y = h2_ | (h3 << 16);
                v2u lv; lv.x = pk2(h.x - bf2f(h0), h.y - bf2f(h1)); lv.y = pk2(h.z - bf2f(h2_), h.w - bf2f(h3));
                { int p8 = __builtin_amdgcn_cvt_pk_fp8_f32(h.x * H2_SCALE, h.y * H2_SCALE, 0, false); p8 = __builtin_amdgcn_cvt_pk_fp8_f32(h.z * H2_SCALE, h.w * H2_SCALE, p8, true);
                  if (live) *(GAS unsigned*)(h2g + token * D + c) = (unsigned)p8; }
                const int off = p4_swz(rowi, (lane >> 1) + 32 * j) + (lane & 1) * 8;
                *(LAS v2u*)(thi + off) = hv; *(LAS v2u*)(tlo + off) = lv; }
        }
        __syncthreads();
        { const int mb = F.wave & 1, nb = F.wave >> 1, r = lane & 15, kq = lane >> 4;
          f32x4 acc = (f32x4){0.f, 0.f, 0.f, 0.f};
          const bf16* bh = wrhi + (size_t)(nb * 16 + r) * D + kq * 8; const bf16* bl = wrlo + (size_t)(nb * 16 + r) * D + kq * 8;
#pragma unroll 4
          for (int ks = 0; ks < 32; ++ks) { const int off = p4_swz(mb * 16 + r, ks * 4 + kq);
              const bf16x8 ah = *(const LAS bf16x8*)(thi + off), al = *(const LAS bf16x8*)(tlo + off);
              const bf16x8 bhf = *(const bf16x8*)(bh + ks * 32), blf = *(const bf16x8*)(bl + ks * 32);
              acc = __builtin_amdgcn_mfma_f32_16x16x32_bf16(ah, bhf, acc, 0, 0, 0);
              acc = __builtin_amdgcn_mfma_f32_16x16x32_bf16(al, bhf, acc, 0, 0, 0);
              acc = __builtin_amdgcn_mfma_f32_16x16x32_bf16(ah, blf, acc, 0, 0, 0); }
          __syncthreads();
          LAS float* lg = (LAS float*)F.lds;
#pragma unroll
          for (int i = 0; i < 4; ++i) lg[(mb * 16 + kq * 4 + i) * 65 + nb * 16 + r] = acc[i];
          if (F.tid < 64) ((LAS unsigned*)(F.lds + 16384))[F.tid] = 0u;
        }
        __syncthreads();
        int my_e = 0; float my_w = 0.f; unsigned my_pos = 0u;
        const int tk = F.tid >> 3, gl = F.tid & 7; const size_t rtoken = (size_t)tile * 32 + tk;
        LAS unsigned* hist = (LAS unsigned*)(F.lds + 16384); LAS unsigned* basev = hist + 64;
        if (F.tid < 256) {
            const LAS float* lg = (const LAS float*)F.lds; const int lb = lane & ~7;
            float sc[8], sl[8];
#pragma unroll
            for (int j = 0; j < 8; ++j) { const float x = lg[tk * 65 + gl * 8 + j]; const float s = 1.0f / (1.0f + __expf(-x)); sc[j] = s; sl[j] = s + in[I_RBIAS][gl * 8 + j]; }
            float a = -INFINITY, b2 = -INFINITY;
#pragma unroll
            for (int j = 0; j < 8; ++j) { const float v = sl[j]; if (v > a) { b2 = a; a = v; } else if (v > b2) b2 = v; }
            const float gs = a + b2; int rank = 0;
#pragma unroll
            for (int i = 0; i < 8; ++i) { const float og = __shfl(gs, lb + i); rank += (og > gs || (og == gs && i < gl)) ? 1 : 0; }
            if (rank >= 4) {
#pragma unroll
                for (int j = 0; j < 8; ++j) sl[j] = -INFINITY; }
            float wsum = 0.f, my_s = 0.f;
#pragma unroll
            for (int rd = 0; rd < 8; ++rd) {
                float bv = sl[0]; int be = gl * 8;
#pragma unroll
                for (int j = 1; j < 8; ++j) if (sl[j] > bv) { bv = sl[j]; be = gl * 8 + j; }
#pragma unroll
                for (int msk = 1; msk < 8; msk <<= 1) { const float ov = __shfl_xor(bv, msk); const int oe = __shfl_xor(be, msk); if (ov > bv || (ov == bv && oe < be)) { bv = ov; be = oe; } }
                float ws_ = 0.f;
#pragma unroll
                for (int j = 0; j < 8; ++j) if (be == gl * 8 + j) { ws_ = sc[j]; sl[j] = -INFINITY; }
                const float wsc = __shfl(ws_, lb + (be >> 3));
                wsum += wsc; if (gl == rd) { my_e = be; my_s = wsc; }
            }
            my_w = my_s / wsum * 2.5f;
            my_pos = __hip_atomic_fetch_add(hist + my_e, 1u, __ATOMIC_RELAXED, __HIP_MEMORY_SCOPE_WORKGROUP);
        }
        __syncthreads();
        if (F.tid < 64) { const unsigned c = hist[F.tid]; basev[F.tid] = (c && live) ? __hip_atomic_fetch_add(F.ctl + CW_CNT + 64 * F.tid, c, __ATOMIC_RELAXED, __HIP_MEMORY_SCOPE_AGENT) : 0u; }
        __syncthreads();
        if (F.tid < 256 && live) { const unsigned slot = basev[my_e] + my_pos; const unsigned v = (unsigned)my_e;
            ((unsigned*)(ws + WS_LISTS))[(size_t)v * LIST_CAP + slot] = (unsigned)rtoken;
            ((unsigned*)(ws + WS_TOKMAP))[rtoken * 8 + gl] = (v << 16) | slot;
            ((float*)(ws + WS_WTS))[rtoken * 8 + gl] = my_w; }
        __syncthreads();
    }
}
}
namespace mk {
__device__ __forceinline__ void moe_prefix(Frame& F) {
    LAS int* pre = (LAS int*)(F.lds + PRE_OFF);
    __syncthreads();
    if (F.tid < 64) {
        const int c0 = (int)__hip_atomic_load(F.ctl + CW_CNT + 64 * F.tid, RLX_AGENT);
        const int t0 = (c0 + 255) >> 8; int x = t0;
#pragma unroll
        for (int o = 1; o < 64; o <<= 1) { const int y = __shfl_up(x, o); if (F.lane >= o) x += y; }
        pre[F.tid] = x - t0; if (F.tid == 63) pre[64] = x;
    }
    __syncthreads();
}
__device__ __forceinline__ int moe_find_list(const LAS int* pre, int tile) {
    int lo = 0, hi = 64;
    while (hi - lo > 1) { const int mid = (lo + hi) >> 1; if (pre[mid] <= tile) lo = mid; else hi = mid; }
    return lo;
}
__device__ __forceinline__ int moe_tiles(int NTr) { int nt = NTr + T / 256; const long cap = (long)((WS_END - WS_H) / (256 * (512 + 1024))); return nt > cap ? (int)cap : nt; }
__device__ __forceinline__ unsigned char* y_base(Frame& F, int ntl) { return F.ws + WS_H + (size_t)ntl * 256 * 512; }

__device__ __forceinline__ void p5(Frame& F) {
    unsigned char* ws = F.ws;
    moe_prefix(F);
    const LAS int* pre = (const LAS int*)(F.lds + PRE_OFF);
    const int NTr = pre[64], ntl = moe_tiles(NTr), NU = ntl * 2;
    const unsigned* lists = (const unsigned*)(ws + WS_LISTS);
    int n = 0;
    for (int i = 0; i < MAXU; ++i) { const int L = i * F.G + F.vcu; if (L >= NU) break;
        const int tile = L >> 1, pn = L & 1; const void* Bp; LAS unsigned* tab = (LAS unsigned*)(F.lds + TAB_OFF + i * 1024);
        if (tile < NTr) { const int e = moe_find_list(pre, tile), tl = tile - pre[e];
            const int cnt = (int)__hip_atomic_load(F.ctl + CW_CNT + 64 * e, RLX_AGENT);
            if (F.tid < 256) { const int r = tl * 256 + F.tid; tab[F.tid] = lists[(size_t)e * LIST_CAP + (r < cnt ? r : 0)]; }
            Bp = ws + WS_WGU + ((size_t)e * 512 + (size_t)pn * 256) * D;
        } else { const int ts = tile - NTr; if (F.tid < 256) tab[F.tid] = (unsigned)(ts * 256 + F.tid); Bp = ws + WS_WSGU + (size_t)pn * 256 * D; }
        if (F.tid == 0) put_unit(F, i, ws + WS_H2, Bp, TAB_OFF + i * 1024, tile * 256, pn * 128);
        ++n; }
    __syncthreads();
    pg8::ListSched Sd{(const LAS pg8::UnitRec*)(F.lds + ULIST_OFF), n};
    pg8::EpiSwiglu E{(bf16*)(ws + WS_H), 256, 1.0f / (H2_SCALE * WGU_SCALE)};
    pg8::gemm_phase<pg8::EpiSwiglu, pg8::ListSched, true, pg8::NoHook, true>(F.lds, D / 2, Sd, E, pg8::NoHook{}, F.wave);
}

template <bool DRY> __device__ __forceinline__ void p6(Frame& F) {
    const bool live = !DRY || (__hip_atomic_load(F.ctl + 3, RLX_AGENT) == 0xdeadbeefu);
    unsigned char* ws = F.ws;
    moe_prefix(F);
    const LAS int* pre = (const LAS int*)(F.lds + PRE_OFF);
    const int NTr = pre[64], ntl = moe_tiles(NTr), NU = ntl * 4;
    unsigned char* Y = y_base(F, ntl);
    int n = 0;
    for (int i = 0; i < 16; ++i) { const int L = i * F.G + F.vcu; if (L >= NU) break;
        const int tile = L >> 2, pn = L & 3; const void* Bp;
        if (tile < NTr) { const int e = moe_find_list(pre, tile); Bp = ws + WS_WD + ((size_t)e * D + (size_t)pn * 256) * 256 * 2; }
        else Bp = ws + WS_WSD + (size_t)pn * 256 * 256 * 2;
        if (F.tid == 0) put_unit(F, i, ws + WS_H + (size_t)tile * 256 * 512, Bp, -1, tile * 256, pn * 256);
        ++n; }
    __syncthreads();
    pg8::ListSched Sd{(const LAS pg8::UnitRec*)(F.lds + ULIST_OFF), n};
    pg8::EpiFp8 E{Y, D, live};
    pg8::gemm_phase<pg8::EpiFp8, pg8::ListSched, false, pg8::NoHook>(F.lds, 256, Sd, E, pg8::NoHook{}, F.wave);
}

__device__ __forceinline__ void y_acc(f32x4 (&ff)[4], const unsigned char* yr, int lane, float w) {
    const v4u u = *(const GAS v4u*)(yr + 16 * lane);
#pragma unroll
    for (int i = 0; i < 4; ++i) { typedef float f2 __attribute__((ext_vector_type(2)));
        const f2 a = __builtin_amdgcn_cvt_pk_f32_fp8((int)u[i], false), b = __builtin_amdgcn_cvt_pk_f32_fp8((int)u[i], true);
        ff[i] += (f32x4){a.x, a.y, b.x, b.y} * w; }
}
template <bool DRY> __device__ __forceinline__ void p7(Frame& F) {
    const bool live = !DRY || (__hip_atomic_load(F.ctl + 3, RLX_AGENT) == 0xdeadbeefu);
    const float* const* in = F.in; unsigned char* ws = F.ws;
    moe_prefix(F);
    const LAS int* pre = (const LAS int*)(F.lds + PRE_OFF);
    const int NTr = pre[64], ntl = moe_tiles(NTr);
    const unsigned char* Y = y_base(F, ntl);
    const float* mod = (const float*)(ws + WS_MOD);
    const unsigned* tokmap = (const unsigned*)(ws + WS_TOKMAP); const float* wts = (const float*)(ws + WS_WTS);
    const int gw = F.vcu * NWAVES + F.wave, NGW = F.G * NWAVES, lane = F.lane;
    for (int token = gw; token < T; token += NGW) {
        const int b = token / S;
        unsigned tm = 0u; float wv = 0.f;
        if (lane < 8) { tm = tokmap[(size_t)token * 8 + lane]; wv = wts[(size_t)token * 8 + lane]; }
        f32x4 ff[4];
#pragma unroll
        for (int i = 0; i < 4; ++i) ff[i] = (f32x4){0.f, 0.f, 0.f, 0.f};
        y_acc(ff, Y + ((size_t)NTr * 256 + token) * D, lane, 1.0f / 16.0f);
#pragma unroll
        for (int k = 0; k < 8; ++k) { const unsigned m = (unsigned)__builtin_amdgcn_readlane((int)tm, k); const float w = __uint_as_float((unsigned)__builtin_amdgcn_readlane((int)__float_as_uint(wv), k));
            const int e = (int)(m >> 16), pos = (int)(m & 0xFFFFu);
            y_acc(ff, Y + ((size_t)pre[e] * 256 + pos) * D, lane, w * (1.0f / 16.0f)); }
        float ss = 0.f;
#pragma unroll
        for (int i = 0; i < 4; ++i) ss += (ff[i].x * ff[i].x + ff[i].y * ff[i].y) + (ff[i].z * ff[i].z + ff[i].w * ff[i].w);
        const float rstd = rsqrtf(wave_sum(ss) * (1.f / D) + EPS);
#pragma unroll
        for (int i = 0; i < 4; ++i) { const int c = 16 * lane + 4 * i;
            const f32x4 x1 = *(const GAS f32x4*)(F.out + (size_t)token * D + c), gt = *(const f32x4*)(mod + b * 6144 + 5120 + c), gp = *(const f32x4*)(in[I_GPOSTFFN] + c);
            if (live) *(GAS f32x4*)(F.out + (size_t)token * D + c) = x1 + gt * (ff[i] * rstd) * gp; }
    }
}
}
namespace mk {
#ifndef MK_NPHASES_DONE
#define MK_NPHASES_DONE 3
#endif
constexpr int PH_P0A = 0, PH_P0B = 1, PH_P1 = 2, PH_P2 = 3, PH_P3 = 4, PH_P4 = 5, PH_P5 = 6, PH_P6 = 7, PH_P7 = 8, N_PHASES = 9;

__global__ void __launch_bounds__(NTHR, 2) mk_fwd(Args a) {
    extern __shared__ __attribute__((aligned(16))) unsigned char lds_[];
    Frame F;
    F.lds = (LAS unsigned char*)lds_; F.ws = a.ws; F.ctl = (unsigned*)(a.ws + WS_CTL); F.in = a.in; F.out = a.out;
    F.tid = threadIdx.x; F.lane = F.tid & 63; F.wave = __builtin_amdgcn_readfirstlane(F.tid >> 6);
    F.G = gridDim.x; { const int bx = blockIdx.x; F.vcu = (F.G % 8 == 0) ? (bx % 8) * (F.G / 8) + bx / 8 : bx; }
    for (int u = F.tid; u < 128; u += NTHR) ((LAS unsigned*)(F.lds + LDSCTL_OFF))[u] = 0u;
    __syncthreads();
    const int lo = a.ph_lo, hi = a.ph_hi;
    const bool multi = (hi - lo) > 1;
    XcdBarrier bar; bar.bar = F.ctl + CW_BAR; bar.x = 0; bar.st = nullptr;
    if (multi) bar = xcd_barrier_post(F.ctl + CW_BAR, (volatile LAS unsigned*)(F.lds + MISC_OFF) + 8);
#define IN(k) (lo <= (k) && (k) < hi)
#define SEAM(k) do { if (IN(k) && IN((k) + 1)) xcd_barrier(bar); } while (0)
#ifndef MK_DBL
#define MK_DBL 0
#endif
#define DBL(k) (((MK_DBL) >> (k)) & 1)
#define REFRESH() do { int l_; asm volatile("v_mbcnt_lo_u32_b32 %0, -1, 0\n\tv_mbcnt_hi_u32_b32 %0, -1, %0" : "=v"(l_)); F.lane = l_; F.tid = F.wave * 64 + l_; } while (0)
#define RUN(k, call, drycall) do { if (IN(k)) { if (DBL(k)) { REFRESH(); drycall; if (multi) xcd_barrier(bar); } REFRESH(); call; } SEAM(k); } while (0)
    RUN(PH_P0A, p0a(F), p0a(F));
    RUN(PH_P0B, p0b(F), p0b(F));
    RUN(PH_P1, p1(F), p1(F));
#if MK_NPHASES_DONE > 3
    RUN(PH_P2, p2(F), p2(F));
#endif
#if MK_NPHASES_DONE > 4
    RUN(PH_P3, p3(F), p3(F));
#endif
#if MK_NPHASES_DONE > 5
    RUN(PH_P4, p4<false>(F), p4<true>(F));
#endif
#if MK_NPHASES_DONE > 6
    RUN(PH_P5, p5(F), p5(F));
#endif
#if MK_NPHASES_DONE > 7
    RUN(PH_P6, p6<false>(F), p6<true>(F));
    if (IN(PH_P7)) { if (DBL(PH_P7)) { REFRESH(); p7<true>(F); if (multi) xcd_barrier(bar); } REFRESH(); p7<false>(F); }
#endif
#undef RUN
#undef REFRESH
#undef DBL
#undef IN
#undef SEAM
}

static int g_grid = 0;
static bool setup_once() {
    if (g_grid == 0) {
        int dev = 0, cus = 0;
        if (hipGetDevice(&dev) != hipSuccess || hipDeviceGetAttribute(&cus, hipDeviceAttributeMultiprocessorCount, dev) != hipSuccess) { g_grid = -1; return false; }
        if (hipFuncSetAttribute((const void*)mk_fwd, hipFuncAttributeMaxDynamicSharedMemorySize, LDS_BYTES) != hipSuccess) { g_grid = -1; return false; }
        (void)hipGetLastError();
        g_grid = cus;
    }
    return g_grid > 0;
}
static void launch_phases(void* const* d_in, void* d_out, void* d_ws, hipStream_t stream, int lo, int hi) {
    Args a{};
    for (int i = 0; i < N_IN; ++i) a.in[i] = (const float*)d_in[i];
    a.out = (float*)d_out; a.ws = (unsigned char*)d_ws; a.ph_lo = lo; a.ph_hi = hi;
    hipLaunchKernelGGL(mk_fwd, dim3(g_grid), dim3(NTHR), LDS_BYTES, stream, a);
}
}
extern "C" void kernel_launch(void* const* d_in, const int* in_sizes, int n_in, void* d_out, int out_size, void* d_ws, size_t ws_size, hipStream_t stream) {
    if (!mk::setup_once()) return;
    if (ws_size < mk::WS_END) return;
    hipMemsetAsync(d_ws, 0, mk::CTL_ZERO_BYTES, stream);
    mk::launch_phases(d_in, d_out, d_ws, stream, 0, mk::N_PHASES);
}
```

```cpp
#include <hip/hip_runtime.h>
#include <cstdio>
#include <cstdint>
#include <cmath>
#include <hip/hip_bf16.h>
#define MK_NPHASES_DONE 99
#define MK_WT 271
namespace pg8 {
#define PG8_LAS __attribute__((address_space(3)))
typedef unsigned short bf16_t;
typedef short bf16x8 __attribute__((ext_vector_type(8)));
typedef float f32x4 __attribute__((ext_vector_type(4)));
typedef unsigned u32x4 __attribute__((ext_vector_type(4)));
typedef unsigned u32x2 __attribute__((ext_vector_type(2)));
typedef int i32x4 __attribute__((ext_vector_type(4)));
typedef int i32x8 __attribute__((ext_vector_type(8)));
constexpr int BM = 256, BK = 64, HALF = 128, HTB = HALF * BK * 2, STAGE_BYTES = 8 * HTB;

__host__ __device__ __forceinline__ int lds_byte(int r, int c) { const int st = (r >> 4) * 2 + (c >> 5), rr = r & 15, cc = c & 31, ob = rr * 64 + cc * 2; return st * 1024 + (ob ^ (((ob >> 9) & 1) << 5)); }
__host__ __device__ __forceinline__ void stage_rc(int b, int& R, int& C) { const int st = b / 1024, sb = b % 1024, swz = sb ^ (((sb >> 9) & 1) << 5); R = (st >> 1) * 16 + swz / 64; C = (st & 1) * 32 + (swz % 64) / 2; }
__host__ __device__ __forceinline__ int perm32(int rho) { const int n = rho >> 4, i = rho & 15; return 8 * (i >> 2) + 4 * n + (i & 3); }

struct Unit { const char* A; const char* B; int tab; int orow; int ocol; int aux; };
struct UnitRec { unsigned long long A, B; int tab, orow, ocol, aux; };
struct ListSched {
    const PG8_LAS UnitRec* list; int n;
    __device__ __forceinline__ bool next(int i, Unit& u) const {
        if (i >= n) return false;
        const PG8_LAS UnitRec* r = list + i;
        const unsigned long long a = r->A, b = r->B;
        const unsigned alo = __builtin_amdgcn_readfirstlane((unsigned)a), ahi = __builtin_amdgcn_readfirstlane((unsigned)(a >> 32));
        const unsigned blo = __builtin_amdgcn_readfirstlane((unsigned)b), bhi = __builtin_amdgcn_readfirstlane((unsigned)(b >> 32));
        u.A = (const char*)(((unsigned long long)ahi << 32) | alo); u.B = (const char*)(((unsigned long long)bhi << 32) | blo);
        u.tab = __builtin_amdgcn_readfirstlane(r->tab); u.orow = __builtin_amdgcn_readfirstlane(r->orow); u.ocol = __builtin_amdgcn_readfirstlane(r->ocol); u.aux = __builtin_amdgcn_readfirstlane(r->aux);
        return true;
    }
};
struct NoHook { __device__ __forceinline__ void at(int, f32x4 (&)[2][2][4][2], int, int, int) const {} };

#ifndef MK_WT
#define MK_WT 15
#endif
template <typename V> __device__ __forceinline__ void st16_wt(void* p, V v) { asm volatile("global_store_dwordx4 %0, %1, off sc1\n\ts_nop 1" :: "v"(p), "v"(v)); }
__device__ __forceinline__ unsigned cvt_pk_bf16(float lo, float hi) { unsigned r; asm volatile("v_cvt_pk_bf16_f32 %0, %1, %2" : "=v"(r) : "v"(lo), "v"(hi)); return r; }

struct EpiBf16 {
    static constexpr bool PERM = true, STAGED = false;
    bf16_t* O; int ldc;
    __device__ __forceinline__ void operator()(const f32x4 (&acc)[2][2][4][2], const Unit& u, int wr, int wc, int fr, int fq) const {
        const int row0 = u.orow + wr * 64 + fr, col0 = u.ocol + wc * 32 + 8 * fq;
#pragma unroll
        for (int ai = 0; ai < 2; ++ai)
#pragma unroll
            for (int m = 0; m < 4; ++m) { bf16_t* rowp = O + (size_t)(row0 + ai * HALF + m * 16) * ldc + col0;
#pragma unroll
                for (int bj = 0; bj < 2; ++bj) { const f32x4 v0 = acc[ai][bj][m][0], v1 = acc[ai][bj][m][1];
                    u32x4 w; w.x = cvt_pk_bf16(v0[0], v0[1]); w.y = cvt_pk_bf16(v0[2], v0[3]); w.z = cvt_pk_bf16(v1[0], v1[1]); w.w = cvt_pk_bf16(v1[2], v1[3]);
                    if (MK_WT & 1) st16_wt(rowp + bj * HALF, w); else *(u32x4*)(rowp + bj * HALF) = w; } }
    }
};
struct EpiRowScaleBf16 {
    static constexpr bool PERM = true, STAGED = false;
    bf16_t* O; int ldc; const PG8_LAS float* rs;
    __device__ __forceinline__ void operator()(const f32x4 (&acc)[2][2][4][2], const Unit& u, int wr, int wc, int fr, int fq) const {
        const int row0 = u.orow + wr * 64 + fr, col0 = u.ocol + wc * 32 + 8 * fq;
#pragma unroll
        for (int ai = 0; ai < 2; ++ai)
#pragma unroll
            for (int m = 0; m < 4; ++m) { bf16_t* rowp = O + (size_t)(row0 + ai * HALF + m * 16) * ldc + col0; const float s = rs[ai * HALF + wr * 64 + m * 16 + fr];
#pragma unroll
                for (int bj = 0; bj < 2; ++bj) { const f32x4 v0 = acc[ai][bj][m][0] * s, v1 = acc[ai][bj][m][1] * s;
                    u32x4 w; w.x = cvt_pk_bf16(v0[0], v0[1]); w.y = cvt_pk_bf16(v0[2], v0[3]); w.z = cvt_pk_bf16(v1[0], v1[1]); w.w = cvt_pk_bf16(v1[2], v1[3]);
                    if (MK_WT & 4) st16_wt(rowp + bj * HALF, w); else *(u32x4*)(rowp + bj * HALF) = w; } }
    }
};
constexpr int STG_OFF = 143360, STG_HALF = 32 * 272;
struct EpiFp8 {
    static constexpr bool PERM = true, STAGED = true;
    unsigned char* O; int ldc; bool live; float sc;
    __device__ __forceinline__ void staged(const f32x4 (&acc)[2][2][4][2], const Unit& u, int wr, int wc, int lane, PG8_LAS unsigned char* lds) const {
        const int fr = lane & 15, fq = lane >> 4;
        PG8_LAS unsigned char* stg = lds + STG_OFF + wr * STG_HALF;
#pragma unroll
        for (int ai = 0; ai < 2; ++ai)
#pragma unroll
            for (int mp = 0; mp < 2; ++mp) {
#pragma unroll
                for (int mm = 0; mm < 2; ++mm)
#pragma unroll
                    for (int bj = 0; bj < 2; ++bj) { const int m = 2 * mp + mm; f32x4 v0 = acc[ai][bj][m][0] * sc, v1 = acc[ai][bj][m][1] * sc;
#pragma unroll
                        for (int j = 0; j < 4; ++j) { v0[j] = __builtin_amdgcn_fmed3f(v0[j], -448.f, 448.f); v1[j] = __builtin_amdgcn_fmed3f(v1[j], -448.f, 448.f); }
                        int p0 = __builtin_amdgcn_cvt_pk_fp8_f32(v0[0], v0[1], 0, false); p0 = __builtin_amdgcn_cvt_pk_fp8_f32(v0[2], v0[3], p0, true);
                        int p1 = __builtin_amdgcn_cvt_pk_fp8_f32(v1[0], v1[1], 0, false); p1 = __builtin_amdgcn_cvt_pk_fp8_f32(v1[2], v1[3], p1, true);
                        u32x2 w; w.x = (unsigned)p0; w.y = (unsigned)p1; *(PG8_LAS u32x2*)(stg + (mm * 16 + fr) * 272 + bj * 128 + wc * 32 + 8 * fq) = w; }
                asm volatile("s_waitcnt lgkmcnt(0)\n\ts_barrier" ::: "memory");
#pragma unroll
                for (int i = 0; i < 2; ++i) { const int p = i * 256 + wc * 64 + lane, q = p >> 4, c16 = p & 15;
                    const u32x4 v = *(const PG8_LAS u32x4*)(stg + q * 272 + c16 * 16);
                    const int grow = u.orow + 128 * ai + 64 * wr + 16 * (2 * mp + (q >> 4)) + (q & 15);
                    if (live) { if (MK_WT & 16) st16_wt(O + (size_t)grow * ldc + u.ocol + c16 * 16, v); else if (MK_WT & 256) *(u32x4*)(O + (size_t)grow * ldc + u.ocol + c16 * 16) = v; else __builtin_nontemporal_store(v, (u32x4*)(O + (size_t)grow * ldc + u.ocol + c16 * 16)); } }
                asm volatile("s_waitcnt lgkmcnt(0)\n\ts_barrier" ::: "memory");
            }
    }
};
__device__ __forceinline__ float silu_mul(float g, float u) { return g * u * __builtin_amdgcn_rcpf(1.0f + __builtin_amdgcn_exp2f(-1.4426950408889634f * g)); }
struct EpiSwiglu {
    static constexpr bool PERM = true, STAGED = false;
    unsigned char* O; int ldc; float s, so;
    __device__ __forceinline__ void operator()(const f32x4 (&acc)[2][2][4][2], const Unit& u, int wr, int wc, int fr, int fq) const {
        const int row0 = u.orow + wr * 64 + fr, col0 = u.ocol + wc * 32 + 8 * fq;
#pragma unroll
        for (int ai = 0; ai < 2; ++ai)
#pragma unroll
            for (int m = 0; m < 4; ++m) { unsigned char* rowp = O + (size_t)(row0 + ai * HALF + m * 16) * ldc + col0;
                const f32x4 g0 = acc[ai][0][m][0] * s, g1 = acc[ai][0][m][1] * s, u0 = acc[ai][1][m][0] * (s * so), u1 = acc[ai][1][m][1] * (s * so);
                float h[8];
#pragma unroll
                for (int j = 0; j < 4; ++j) { h[j] = __builtin_amdgcn_fmed3f(silu_mul(g0[j], u0[j]), -448.f, 448.f); h[4 + j] = __builtin_amdgcn_fmed3f(silu_mul(g1[j], u1[j]), -448.f, 448.f); }
                int p0 = __builtin_amdgcn_cvt_pk_fp8_f32(h[0], h[1], 0, false); p0 = __builtin_amdgcn_cvt_pk_fp8_f32(h[2], h[3], p0, true);
                int p1 = __builtin_amdgcn_cvt_pk_fp8_f32(h[4], h[5], 0, false); p1 = __builtin_amdgcn_cvt_pk_fp8_f32(h[6], h[7], p1, true);
                u32x2 w; w.x = (unsigned)p0; w.y = (unsigned)p1; *(u32x2*)rowp = w; }
    }
};

template <class Epi, class Sched, bool GATHER, class Hook, bool FP8 = false>
__device__ __forceinline__ void gemm_phase(PG8_LAS unsigned char* lds, const int K, const Sched& S, const Epi& E, const Hook& H, const int wid  ) {
    int lane; asm volatile("v_mbcnt_lo_u32_b32 %0, -1, 0\n\tv_mbcnt_hi_u32_b32 %0, -1, %0" : "=v"(lane));
    const int tid = wid * 64 + lane, wr = wid >> 2, wc = wid & 3, fr = lane & 15, fq = lane >> 4;
    const int nt = K / BK;
    unsigned voffB[2];
#pragma unroll
    for (int i = 0; i < 2; ++i) { int R, C; stage_rc(tid * 16 + i * 8192, R, C); const int Rb = Epi::PERM ? ((R & ~31) + perm32(R & 31)) : R; voffB[i] = (unsigned)(Rb * K + C) * 2u; }
    const size_t kstep = (size_t)(BK * 2);
    const size_t hstep = (size_t)HALF * K * 2;
    const unsigned ldsw = (unsigned)wid * 1024u;
    const int aoff = lds_byte(wr * 64 + fr, fq * 8), boff = lds_byte(wc * 32 + fr, fq * 8);
    unsigned offC[2][2];
#define PG8_LOADOFF(dst, u) do { _Pragma("unroll") for (int _i = 0; _i < 2; ++_i) { int _R, _C; stage_rc(tid * 16 + _i * 8192, _R, _C); _Pragma("unroll") for (int _h = 0; _h < 2; ++_h) { \
        if constexpr (GATHER) { const unsigned _row = *(const PG8_LAS unsigned*)(lds + (u).tab + 4 * (_h * HALF + _R)); dst[_h][_i] = _row * (unsigned)(K * 2) + (unsigned)(_C * 2); } \
        else dst[_h][_i] = (unsigned)((_h * HALF + _R) * K + _C) * 2u; } } } while (0)
#define PG8_SA(b, h) (((b) * 2 + (h)) * HTB)
#define PG8_SB(b, h) ((4 + (b) * 2 + (h)) * HTB)
#define PG8_STAGE(bufoff, gbase, voff) do { _Pragma("unroll") for (int _i = 0; _i < 2; ++_i) { unsigned _o = (voff)[_i]; if constexpr (FP8) asm volatile("" : "+v"(_o));     \
        __builtin_amdgcn_global_load_lds((const unsigned*)((const char*)(gbase) + _o), (PG8_LAS unsigned*)(lds + (bufoff) + ldsw + _i * 8192), 16, 0, 0); } } while (0)
#define PG8_LDA(dst, b, h) do { _Pragma("unroll") for (int m = 0; m < 4; ++m) _Pragma("unroll") for (int k = 0; k < 2; ++k) dst[m][k] = *(const PG8_LAS bf16x8*)(lds + PG8_SA(b, h) + aoff + m * 2048 + k * 1024); } while (0)
#define PG8_LDB(dst, b, h) do { _Pragma("unroll") for (int n = 0; n < 2; ++n) _Pragma("unroll") for (int k = 0; k < 2; ++k) dst[n][k] = *(const PG8_LAS bf16x8*)(lds + PG8_SB(b, h) + boff + n * 2048 + k * 1024); } while (0)
#define PG8_CAT(x, y) __builtin_shufflevector(__builtin_bit_cast(i32x4, x), __builtin_bit_cast(i32x4, y), 0, 1, 2, 3, 4, 5, 6, 7)
#define PG8_MMA(ai, bj, At, Bt) do { __builtin_amdgcn_s_setprio(1); if constexpr (FP8) { _Pragma("unroll") for (int m = 0; m < 4; ++m) _Pragma("unroll") for (int n = 0; n < 2; ++n) \
        acc[ai][bj][m][n] = __builtin_amdgcn_mfma_scale_f32_16x16x128_f8f6f4(PG8_CAT(Bt[n][0], Bt[n][1]), PG8_CAT(At[m][0], At[m][1]), acc[ai][bj][m][n], 0, 0, 0, 0, 0, 0);   } else { \
        _Pragma("unroll") for (int m = 0; m < 4; ++m) _Pragma("unroll") for (int n = 0; n < 2; ++n) _Pragma("unroll") for (int k = 0; k < 2; ++k) \
        acc[ai][bj][m][n] = __builtin_amdgcn_mfma_f32_16x16x32_bf16(Bt[n][k], At[m][k], acc[ai][bj][m][n], 0, 0, 0); } __builtin_amdgcn_s_setprio(0); } while (0)
#define PG8_WAIT_V(n) asm volatile("s_waitcnt vmcnt(" #n ")" ::: "memory")
#define PG8_WAIT_L(n) asm volatile("s_waitcnt lgkmcnt(" #n ")" ::: "memory")
#define PG8_BAR __builtin_amdgcn_s_barrier()
#define PG8_SCHED __builtin_amdgcn_sched_barrier(0)
    Unit cur, nxt; int ui = 0;
    if (!S.next(0, cur)) return;
    f32x4 acc[2][2][4][2];
#pragma unroll
    for (int a = 0; a < 2; ++a)
#pragma unroll
        for (int b = 0; b < 2; ++b)
#pragma unroll
            for (int m = 0; m < 4; ++m)
#pragma unroll
                for (int n = 0; n < 2; ++n) acc[a][b][m][n] = (f32x4){0.f, 0.f, 0.f, 0.f};
    bf16x8 At[4][2], B0[2][2], B1[2][2];
    const char* cA = cur.A; const char* cB = cur.B;
    PG8_LOADOFF(offC, cur);
    PG8_STAGE(PG8_SB(0, 0), cB, voffB); PG8_STAGE(PG8_SB(0, 1), cB + hstep, voffB); PG8_STAGE(PG8_SA(0, 0), cA, offC[0]); PG8_STAGE(PG8_SA(0, 1), cA, offC[1]);
    if (wr == 1) PG8_BAR;
    PG8_WAIT_V(2); PG8_BAR;
    PG8_STAGE(PG8_SB(1, 0), cB + kstep, voffB); PG8_STAGE(PG8_SA(1, 0), cA + kstep, offC[0]); PG8_STAGE(PG8_SB(1, 1), cB + hstep + kstep, voffB);
    PG8_WAIT_V(6); PG8_BAR;
    for (;;) {
        const bool has_next = S.next(ui + 1, nxt);
        const char* nA = has_next ? nxt.A : cA; const char* nB = has_next ? nxt.B : cB;
        for (int t = 0; t < nt; t += 2) {
            const bool last = (t == nt - 2);
            H.at(t, acc, wr, fr, lane);
            const char* a1 = cA + (size_t)(t + 1) * kstep;
            const char* a2 = last ? nA : cA + (size_t)(t + 2) * kstep; const char* b2 = last ? nB : cB + (size_t)(t + 2) * kstep;
            const char* a3 = a2 + kstep; const char* b3 = b2 + kstep;
            PG8_LDB(B0, 0, 0); PG8_LDB(B1, 0, 1); PG8_SCHED; PG8_LDA(At, 0, 0); PG8_STAGE(PG8_SA(1, 1), a1, offC[1]);
            if constexpr (GATHER) { if (last && has_next) { PG8_LOADOFF(offC, nxt); } }
            PG8_WAIT_V(8); PG8_WAIT_L(0); PG8_BAR; PG8_MMA(0, 0, At, B0); PG8_MMA(0, 1, At, B1); PG8_BAR; PG8_SCHED;
            PG8_LDA(At, 0, 1); PG8_STAGE(PG8_SB(0, 0), b2, voffB); PG8_STAGE(PG8_SB(0, 1), b2 + hstep, voffB); PG8_STAGE(PG8_SA(0, 0), a2, offC[0]);
            PG8_WAIT_V(8); PG8_WAIT_L(0); PG8_BAR; PG8_MMA(1, 0, At, B0); PG8_MMA(1, 1, At, B1); PG8_BAR; PG8_SCHED;
            PG8_LDB(B0, 1, 0); PG8_LDB(B1, 1, 1); PG8_SCHED; PG8_LDA(At, 1, 0); PG8_STAGE(PG8_SA(0, 1), a2, offC[1]);
            PG8_WAIT_V(8); PG8_WAIT_L(0); PG8_BAR; PG8_MMA(0, 0, At, B0); PG8_MMA(0, 1, At, B1); PG8_BAR; PG8_SCHED;
            PG8_LDA(At, 1, 1); PG8_STAGE(PG8_SB(1, 0), b3, voffB); PG8_STAGE(PG8_SB(1, 1), b3 + hstep, voffB); PG8_STAGE(PG8_SA(1, 0), a3, offC[0]);
            PG8_WAIT_V(8); PG8_WAIT_L(0); PG8_BAR; PG8_MMA(1, 0, At, B0); PG8_MMA(1, 1, At, B1); PG8_BAR; PG8_SCHED;
        }
        if (wr == 0) PG8_BAR;
        { int l2; asm volatile("v_mbcnt_lo_u32_b32 %0, -1, 0\n\tv_mbcnt_hi_u32_b32 %0, -1, %0" : "=v"(l2)); if constexpr (Epi::STAGED) E.staged(acc, cur, wr, wc, l2, lds); else E(acc, cur, wr, wc, l2 & 15, l2 >> 4); }
        if (!has_next) break;
#pragma unroll
        for (int a = 0; a < 2; ++a)
#pragma unroll
            for (int b = 0; b < 2; ++b)
#pragma unroll
                for (int m = 0; m < 4; ++m)
#pragma unroll
                    for (int n = 0; n < 2; ++n) acc[a][b][m][n] = (f32x4){0.f, 0.f, 0.f, 0.f};
        cur = nxt; cA = nA; cB = nB; ++ui;
        if (wr == 1) PG8_BAR;
    }
    PG8_WAIT_V(0);
    PG8_BAR;
#undef PG8_LOADOFF
#undef PG8_SA
#undef PG8_SB
#undef PG8_STAGE
#undef PG8_LDA
#undef PG8_LDB
#undef PG8_MMA
#undef PG8_CAT
#undef PG8_WAIT_V
#undef PG8_WAIT_L
#undef PG8_BAR
#undef PG8_SCHED
}
}
namespace mk {
#define GAS __attribute__((address_space(1)))
#define LAS __attribute__((address_space(3)))
typedef unsigned short bf16;
typedef unsigned v4u __attribute__((ext_vector_type(4)));
typedef unsigned v2u __attribute__((ext_vector_type(2)));
typedef float f32x4 __attribute__((ext_vector_type(4)));
typedef short bf16x8 __attribute__((ext_vector_type(8)));

constexpr int T = 16384, D = 1024, S = 2048, NB = 8, NH = 8, HD = 64, NE = 64, DIN = 2056;
constexpr int NTHR = 512, NWAVES = 8;
constexpr float EPS = 1e-6f;
constexpr float LOG2E = 1.4426950408889634f;
constexpr float QSCALE = 0.125f * LOG2E;
constexpr int NLIST = 64, LIST_CAP = 16384;

constexpr size_t MiB = 1u << 20;
constexpr size_t WS_CTL = 0, CTL_ZERO_BYTES = 64 * 1024;
constexpr size_t WS_SMALL = 1 * MiB;
constexpr size_t WS_MOD = WS_SMALL, WS_WF = WS_SMALL + 256 * 1024, WS_LOGF = WS_SMALL + 512 * 1024, WS_SSQP = WS_SMALL + 1 * MiB, WS_SSQA = WS_SSQP + 512 * 1024,
                 WS_TOKMAP = WS_SSQA + 512 * 1024, WS_WTS = WS_TOKMAP + 512 * 1024, WS_LISTS = WS_WTS + 512 * 1024;
constexpr size_t WS_WD = 8 * MiB, WS_WSD = 40 * MiB;
constexpr size_t WS_H = 40 * MiB + 512 * 1024;
constexpr size_t WS_HB = 41 * MiB, WS_PROJ = 73 * MiB, WS_YCAT = 41 * MiB, WS_MIXED = 73 * MiB;
constexpr size_t WS_WIN = 190 * MiB, WS_WOUT = 194 * MiB, WS_WSGU = 196 * MiB, WS_WPOOL = 197 * MiB, WS_WRHI = WS_WPOOL + 128 * 1024, WS_WRLO = WS_WRHI + 128 * 1024;
constexpr size_t WS_H2 = 199 * MiB  , WS_WGU = 231 * MiB  , WS_YS = 264 * MiB  , WS_END = 295 * MiB;
constexpr float H2_SCALE = 8.0f, WGU_SCALE = 64.0f, HH_SCALE = 8.0f, WD_SCALE = 64.0f;
static_assert(WS_LISTS + (size_t)NLIST * LIST_CAP * 4 <= WS_WD && WS_WRLO + 128 * 1024 <= WS_H2 && WS_WGU + 32 * MiB <= WS_YS && WS_YS + 16 * MiB <= WS_END, "ws map");
constexpr int CW_TMO = 0, CW_MODCNT = 64, CW_BAR = 4096, CW_CNT = 8192;

constexpr int RING_BYTES = 131072, LDSCTL_OFF = RING_BYTES, MISC_OFF = LDSCTL_OFF, ULIST_OFF = LDSCTL_OFF + 512, PRE_OFF = ULIST_OFF + 512, TAB_OFF = PRE_OFF + 528,
              RS_OFF = TAB_OFF + 8192, LDS_BYTES = 163840;
constexpr int MAXU = 8;
static_assert(RS_OFF + 2048 <= pg8::STG_OFF && pg8::STG_OFF + 2 * pg8::STG_HALF <= LDS_BYTES && (TAB_OFF % 16) == 0, "LDS map");

#define RLX_AGENT __ATOMIC_RELAXED, __HIP_MEMORY_SCOPE_AGENT
#define LDS_WAIT() asm volatile("s_waitcnt lgkmcnt(0)" ::: "memory")
#define VM_WAIT() asm volatile("s_waitcnt vmcnt(0)" ::: "memory")
__device__ __forceinline__ unsigned f2bf(float f) { unsigned u = __builtin_bit_cast(unsigned, f); return (u + 0x7fffu + ((u >> 16) & 1u)) >> 16; }
__device__ __forceinline__ unsigned pk2(float lo, float hi) { return f2bf(lo) | (f2bf(hi) << 16); }
__device__ __forceinline__ float bf2f(unsigned h) { return __builtin_bit_cast(float, h << 16); }
__device__ __forceinline__ float wave_sum(float v) {
#pragma unroll
    for (int o = 1; o < 64; o <<= 1) v += __shfl_xor(v, o);
    return v;
}

#define XB_TMO      128
#define XB_XCNT(j)  (256  + 64 * (j))
#define XB_XSUB(j)  (1280 + 64 * (j))
#define XB_XGEN(j)  (2304 + 64 * (j))
#define XB_TOP      3328
#define XB_TOPGEN   3392
#define XCD_BAR_WORDS 3456
#define XB_SPIN_CAP (1u << 18)
__device__ __forceinline__ unsigned xb_ld(unsigned* p)              { return __hip_atomic_load(p, __ATOMIC_RELAXED, __HIP_MEMORY_SCOPE_AGENT); }
__device__ __forceinline__ unsigned xb_add(unsigned* p, unsigned v) { return __hip_atomic_fetch_add(p, v, __ATOMIC_RELAXED, __HIP_MEMORY_SCOPE_AGENT); }
__device__ __forceinline__ unsigned xb_xcc_id() { return (unsigned)__builtin_amdgcn_s_getreg((3 << 11) | 20) & 0xFu; }
#define XB_SPIN(cond, bar) do { unsigned _sp = 0; while (cond) { __builtin_amdgcn_s_sleep(1); \
    if ((++_sp & 255u) == 0u) { if (xb_ld(&(bar)[XB_TMO])) break; if (_sp > XB_SPIN_CAP) { atomicAdd(&(bar)[XB_TMO], 1u); break; } } } } while (0)
struct XcdBarrier { unsigned* bar; unsigned x; volatile LAS unsigned* st; };
__device__ __forceinline__ XcdBarrier xcd_barrier_post(unsigned* bar, volatile LAS unsigned* st) {
    XcdBarrier b; b.bar = bar; b.x = xb_xcc_id(); b.st = st;
    if (threadIdx.x == 0) (void)xb_add(&bar[XB_XCNT(b.x)], 1u);
    return b;
}
__device__ __forceinline__ void xcd_barrier_complete(unsigned* bar, unsigned x, unsigned& nloc, unsigned& nx) {
    const unsigned G = gridDim.x * gridDim.y * gridDim.z;
    unsigned sum, cnt, mine, sp = 0u;
    for (;;) {
        sum = 0u; cnt = 0u; mine = 0u;
#pragma unroll
        for (unsigned j = 0; j < 16; ++j) { const unsigned c = xb_ld(&bar[XB_XCNT(j)]); sum += c; cnt += (c > 0u) ? 1u : 0u; mine = (j == x) ? c : mine; }
        if (sum == G) break;
        __builtin_amdgcn_s_sleep(1);
        if ((++sp & 255u) == 0u) { if (xb_ld(&bar[XB_TMO])) break; if (sp > XB_SPIN_CAP) { atomicAdd(&bar[XB_TMO], 1u); break; } }
    }
    nloc = mine > 0u ? mine : 1u; nx = cnt > 0u ? cnt : 1u;
}
__device__ __forceinline__ void xcd_barrier(const XcdBarrier& b, const int wave  ) {
    asm volatile("s_waitcnt vmcnt(0)" ::: "memory");
    __syncthreads();
    int l_; asm volatile("v_mbcnt_lo_u32_b32 %0, -1, 0\n\tv_mbcnt_hi_u32_b32 %0, -1, %0" : "=v"(l_));
    if (wave == 0 && l_ == 0) {
        unsigned* bar = b.bar;
        __builtin_amdgcn_s_waitcnt(0);
        unsigned nloc = b.st[0], nx = b.st[1];
        if (nloc == 0u) { xcd_barrier_complete(bar, b.x, nloc, nx); b.st[0] = nloc; b.st[1] = nx; }
        const unsigned old = xb_add(&bar[XB_XSUB(b.x)], 1u);
        const unsigned gen = old / nloc;
        if (old + 1u == (gen + 1u) * nloc) {
            __builtin_amdgcn_fence(__ATOMIC_RELEASE, "agent");
            asm volatile("s_waitcnt vmcnt(0)" ::: "memory");
            const unsigned og = xb_add(&bar[XB_TOP], 1u);
            const unsigned tg = og / nx;
            if (og + 1u == (tg + 1u) * nx) xb_add(&bar[XB_TOPGEN], 1u);
            else XB_SPIN(xb_ld(&bar[XB_TOPGEN]) == tg, bar);
            __builtin_amdgcn_fence(__ATOMIC_ACQUIRE, "agent");
            xb_add(&bar[XB_XGEN(b.x)], 1u);
            asm volatile("s_waitcnt vmcnt(0)" ::: "memory");
        } else {
            XB_SPIN(xb_ld(&bar[XB_XGEN(b.x)]) == gen, bar);
            __builtin_amdgcn_fence(__ATOMIC_ACQUIRE, "agent");
            asm volatile("s_waitcnt vmcnt(0)" ::: "memory");
        }
    }
    __syncthreads();
}

enum { I_X = 0, I_C, I_WADA, I_BADA, I_GPREMIX, I_GPOSTMIX, I_GPREFFN, I_GPOSTFFN, I_WIN, I_BFORGET, I_WPOOL, I_POOLSCALE, I_GPOOLOUT, I_GATTNOUT, I_WOUT,
       I_WROUTER, I_RBIAS, I_WGATE, I_WUP, I_WDOWN, I_WSGATE, I_WSUP, I_WSDOWN, N_IN };

struct Args { const float* in[N_IN]; float* out; unsigned char* ws; int ph_lo, ph_hi; };

#ifndef MK_PROBE_BLK
#define MK_PROBE_BLK 0
#endif
#ifdef MK_PROBE_A
#define SUBSTAMP(F, k) do { int l_; asm volatile("v_mbcnt_lo_u32_b32 %0, -1, 0\n\tv_mbcnt_hi_u32_b32 %0, -1, %0" : "=v"(l_)); if (blockIdx.x == MK_PROBE_BLK && (F).wave == 0 && l_ == 0) ((unsigned long long*)((F).ctl + 512))[16 + (k)] = __builtin_amdgcn_s_memrealtime(); } while (0)
#else
#define SUBSTAMP(F, k) do { } while (0)
#endif
struct Frame {
    LAS unsigned char* lds; unsigned* ctl; unsigned char* ws; const float* const* in; float* out;
    int tid, lane, wave, vcu, G;
};
}
namespace mk {
template <int MODE>
__device__ __forceinline__ void tr_item(const float* W, int ldn, int k0, int n0, bf16* WT, bf16* WT2, int Kd, int rowbase, const float* sc, float cmul, LAS float* scr, int lane) {
#pragma unroll 8
    for (int i = 0; i < 32; ++i) { const int kk = 2 * i + (lane >> 5); scr[kk * 33 + (lane & 31)] = __builtin_nontemporal_load(W + (size_t)(k0 + kk) * ldn + n0 + (lane & 31)); }
    LDS_WAIT(); asm volatile("" ::: "memory");
    const int c = lane & 7;
#pragma unroll
    for (int j = 0; j < 4; ++j) { const int n = (lane >> 3) + 8 * j; const LAS float* s = scr + (8 * c) * 33 + n;
        float v[8];
#pragma unroll
        for (int i = 0; i < 8; ++i) { v[i] = s[i * 33] * cmul; if (MODE == 1) v[i] *= sc[k0 + 8 * c + i]; if (MODE == 2) v[i] *= sc[n0 + n]; }
        if (MODE == 4) { int p0 = __builtin_amdgcn_cvt_pk_fp8_f32(v[0], v[1], 0, false); p0 = __builtin_amdgcn_cvt_pk_fp8_f32(v[2], v[3], p0, true);
            int p1 = __builtin_amdgcn_cvt_pk_fp8_f32(v[4], v[5], 0, false); p1 = __builtin_amdgcn_cvt_pk_fp8_f32(v[6], v[7], p1, true);
            v2u o8; o8.x = (unsigned)p0; o8.y = (unsigned)p1; *(GAS v2u*)((unsigned char*)WT + (size_t)(rowbase + n) * Kd + k0 + 8 * c) = o8; continue; }
        if (MODE == 5) { v4u o5;
#pragma unroll
            for (int i = 0; i < 4; ++i) o5[i] = (unsigned)__builtin_bit_cast(unsigned short, (_Float16)v[2 * i]) | ((unsigned)__builtin_bit_cast(unsigned short, (_Float16)v[2 * i + 1]) << 16);
            *(GAS v4u*)(WT + (size_t)(rowbase + n) * Kd + k0 + 8 * c) = o5; continue; }
        v4u o; o.x = pk2(v[0], v[1]); o.y = pk2(v[2], v[3]); o.z = pk2(v[4], v[5]); o.w = pk2(v[6], v[7]);
        *(GAS v4u*)(WT + (size_t)(rowbase + n) * Kd + k0 + 8 * c) = o;
        if (MODE == 3) {
#pragma unroll
            for (int i = 0; i < 8; ++i) v[i] = v[i] - bf2f(f2bf(v[i]));
            v4u p; p.x = pk2(v[0], v[1]); p.y = pk2(v[2], v[3]); p.z = pk2(v[4], v[5]); p.w = pk2(v[6], v[7]);
            *(GAS v4u*)(WT2 + (size_t)(rowbase + n) * Kd + k0 + 8 * c) = p; } }
    LDS_WAIT(); asm volatile("" ::: "memory");
}

__device__ __forceinline__ void p0a(Frame& F) {
    const float* const* in = F.in; unsigned char* ws = F.ws;
    if (F.vcu < 192) {
        LAS float* red = (LAS float*)F.lds;
        const int col0 = 32 * F.vcu, kk = F.tid >> 3, c4 = F.tid & 7;
        const float* wa = in[I_WADA]; const float* cc = in[I_C];
        f32x4 acc[8];
#pragma unroll
        for (int b = 0; b < 8; ++b) acc[b] = (f32x4){0.f, 0.f, 0.f, 0.f};
#pragma unroll 4
        for (int i = 0; i < 16; ++i) { const int k = kk + 64 * i; const f32x4 w = __builtin_nontemporal_load((const f32x4*)(wa + (size_t)k * 6144 + col0 + 4 * c4));
#pragma unroll
            for (int b = 0; b < 8; ++b) acc[b] += w * cc[b * D + k]; }
#pragma unroll
        for (int b = 0; b < 8; ++b) *(LAS f32x4*)(red + kk * 256 + b * 32 + 4 * c4) = acc[b];
        __syncthreads();
        if (F.tid < 256) { float s = 0.f;
#pragma unroll 8
            for (int k2 = 0; k2 < 64; ++k2) s += red[k2 * 256 + F.tid];
            const int b = F.tid >> 5, c = F.tid & 31; ((float*)(ws + WS_MOD))[b * 6144 + col0 + c] = s + in[I_BADA][col0 + c]; }
        VM_WAIT(); __syncthreads();
        if (F.tid == 0) { __builtin_amdgcn_fence(__ATOMIC_RELEASE, "agent"); VM_WAIT(); __hip_atomic_fetch_add(F.ctl + CW_MODCNT, 1u, RLX_AGENT); }
    }
    if (F.vcu == 255) { float* wf = (float*)(ws + WS_WF); for (int i = F.tid; i < 8192; i += NTHR) { const int j = i >> 10, k = i & 1023; wf[i] = in[I_WIN][(size_t)k * DIN + 2048 + j]; }
        VM_WAIT(); __syncthreads();
        if (F.tid == 0) { __builtin_amdgcn_fence(__ATOMIC_RELEASE, "agent"); VM_WAIT(); __hip_atomic_fetch_add(F.ctl + CW_MODCNT, 1u, RLX_AGENT); } }
    LAS float* scr = (LAS float*)(F.lds + F.wave * 16384);
    const int gw = F.vcu * NWAVES + F.wave, NGW = F.G * NWAVES, lane = F.lane;
    constexpr int I_E = 8192, I_IN = 1024, I_OUT = 512, I_S = 128, I_P = 32, I_R = 32;
    constexpr int NITEMS = 3 * I_E + I_IN + I_OUT + 3 * I_S + I_P + I_R;
    bf16* Wgu = (bf16*)(ws + WS_WGU); bf16* Wd = (bf16*)(ws + WS_WD);
    const int ntail_w = (F.G > 192) ? (F.G - 192) * NWAVES : 0;
    const int NEVEN = ntail_w ? 24576 : NITEMS;
    const int n_mine = (NEVEN - gw + NGW - 1) / NGW;
    for (int q = 0;; ++q) {
        int it;
        if (q < n_mine) it = gw + q * NGW;
        else { if (F.vcu < 192 || ntail_w == 0) break; it = NEVEN + (gw - 192 * NWAVES) + (q - n_mine) * ntail_w; if (it >= NITEMS) break; }
        int r = it;
        if (r < 2 * I_E) { const int up = r >= I_E; if (up) r -= I_E; const int e = r >> 7, rem = r & 127, k0 = 64 * (rem >> 3), n0 = 32 * (rem & 7);
            tr_item<4>(in[up ? I_WUP : I_WGATE] + (size_t)e * D * 256, 256, k0, n0, (bf16*)((unsigned char*)Wgu + (size_t)e * 512 * D), nullptr, D, (n0 >> 7) * 256 + (n0 & 127) + (up ? 128 : 0), nullptr, WGU_SCALE, scr, lane); continue; }
        r -= 2 * I_E;
        if (r < I_E) { const int e = r >> 7, rem = r & 127, k0 = 64 * (rem >> 5), n0 = 32 * (rem & 31);
            tr_item<4>(in[I_WDOWN] + (size_t)e * 256 * D, D, k0, n0, (bf16*)((unsigned char*)Wd + (size_t)e * D * 256), nullptr, 256, n0, nullptr, WD_SCALE, scr, lane); continue; }
        r -= I_E;
        if (r < I_IN) { const int k0 = 64 * (r >> 6), n0 = 32 * (r & 63);
            tr_item<0>(in[I_WIN], DIN, k0, n0, (bf16*)(ws + WS_WIN), nullptr, D, n0, nullptr, (n0 >= 512 && n0 < 1024) ? QSCALE : 1.f, scr, lane); continue; }
        r -= I_IN;
        if (r < I_OUT) { const int k0 = 64 * (r >> 5), n0 = 32 * (r & 31);
            tr_item<1>(in[I_WOUT], D, k0, n0, (bf16*)(ws + WS_WOUT), nullptr, D, n0, k0 < 512 ? in[I_GPOOLOUT] : in[I_GATTNOUT] - 512, 1.f, scr, lane); continue; }
        r -= I_OUT;
        if (r < 2 * I_S) { const int up = r >= I_S; if (up) r -= I_S; const int k0 = 64 * (r >> 3), n0 = 32 * (r & 7);
            tr_item<4>(in[up ? I_WSUP : I_WSGATE], 256, k0, n0, (bf16*)(ws + WS_WSGU), nullptr, D, (n0 >> 7) * 256 + (n0 & 127) + (up ? 128 : 0), nullptr, WGU_SCALE, scr, lane); continue; }
        r -= 2 * I_S;
        if (r < I_S) { const int k0 = 64 * (r >> 5), n0 = 32 * (r & 31);
            tr_item<4>(in[I_WSDOWN], D, k0, n0, (bf16*)(ws + WS_WSD), nullptr, 256, n0, nullptr, WD_SCALE, scr, lane); continue; }
        r -= I_S;
        if (r < I_P) { const int g = r >> 3, rem = r & 7, k0 = 64 * (rem >> 2), n0 = 32 * (rem & 3);
            tr_item<2>(in[I_WPOOL] + (size_t)g * 16384, 128, k0, n0, (bf16*)(ws + WS_WPOOL) + (size_t)g * 16384, nullptr, 128, n0, in[I_POOLSCALE] + g * 128, 1.f, scr, lane); continue; }
        r -= I_P;
        { const int k0 = 64 * (r >> 1), n0 = 32 * (r & 1);
            tr_item<5>(in[I_WROUTER], 64, k0, n0, (bf16*)(ws + WS_WRHI), nullptr, D, n0, nullptr, 1.f, scr, lane); }
    }
}

__device__ __forceinline__ void p0b(Frame& F) {
    const float* const* in = F.in; unsigned char* ws = F.ws;
    if (F.tid == 0) { unsigned sp = 0; const unsigned need = (F.G >= 256) ? 193u : 0u;
        while (__hip_atomic_load(F.ctl + CW_MODCNT, RLX_AGENT) < need) { __builtin_amdgcn_s_sleep(2); if (++sp > (1u << 20)) { __hip_atomic_store(F.ctl + CW_TMO, 1u, RLX_AGENT); break; } }
        __builtin_amdgcn_fence(__ATOMIC_ACQUIRE, "agent"); VM_WAIT(); }
    __syncthreads();
    LAS float* wfl = (LAS float*)F.lds;
    { const float* wf = (const float*)(ws + WS_WF); for (int i = F.tid; i < 2048; i += NTHR) *(LAS f32x4*)(wfl + 4 * i) = *(const f32x4*)(wf + 4 * i); }
    __syncthreads();
    const int gw = F.vcu * NWAVES + F.wave, lane = F.lane, NGW = F.G * NWAVES;
    const float* mod = (const float*)(ws + WS_MOD);
    for (int r0 = 8 * gw; r0 < T; r0 += 8 * NGW) {
        const int b = r0 / S;
        f32x4 gs[4], sh[4];
#pragma unroll
        for (int j = 0; j < 4; ++j) { const int c = 4 * lane + 256 * j; const f32x4 g = *(const f32x4*)(in[I_GPREMIX] + c), sc = *(const f32x4*)(mod + b * 6144 + 1024 + c);
            gs[j] = g * (sc + 1.0f); sh[j] = *(const f32x4*)(mod + b * 6144 + c); }
        const float bfg = in[I_BFORGET][lane & 7];
#pragma unroll 1
        for (int r4 = 0; r4 < 8; r4 += 4) {
            f32x4 v[4][4]; float ss[4];
#pragma unroll
            for (int rr = 0; rr < 4; ++rr) { const GAS f32x4* xr = (const GAS f32x4*)(in[I_X] + (size_t)(r0 + r4 + rr) * D) + lane;
#pragma unroll
                for (int j = 0; j < 4; ++j) v[rr][j] = __builtin_nontemporal_load(xr + 64 * j); }
#pragma unroll
            for (int rr = 0; rr < 4; ++rr) { float a = 0.f;
#pragma unroll
                for (int j = 0; j < 4; ++j) a += (v[rr][j].x * v[rr][j].x + v[rr][j].y * v[rr][j].y) + (v[rr][j].z * v[rr][j].z + v[rr][j].w * v[rr][j].w);
                ss[rr] = a; }
#pragma unroll
            for (int o = 1; o < 64; o <<= 1) {
#pragma unroll
                for (int rr = 0; rr < 4; ++rr) ss[rr] += __shfl_xor(ss[rr], o); }
#pragma unroll
            for (int rr = 0; rr < 4; ++rr) { const int row = r0 + r4 + rr; const float rstd = rsqrtf(ss[rr] * (1.f / D) + EPS);
                GAS unsigned long long* o8 = (GAS unsigned long long*)((bf16*)(ws + WS_HB) + (size_t)row * D) + lane;
#pragma unroll
                for (int j = 0; j < 4; ++j) { v[rr][j] = v[rr][j] * rstd * gs[j] + sh[j]; o8[64 * j] = (unsigned long long)pk2(v[rr][j].x, v[rr][j].y) | ((unsigned long long)pk2(v[rr][j].z, v[rr][j].w) << 32); } }
            float z[4] = {0.f, 0.f, 0.f, 0.f};
#pragma unroll 1
            for (int h = 0; h < 8; ++h) { float p[4] = {0.f, 0.f, 0.f, 0.f};
#pragma unroll
                for (int j = 0; j < 4; ++j) { const f32x4 w = *(const LAS f32x4*)(wfl + h * 1024 + 4 * lane + 256 * j);
#pragma unroll
                    for (int rr = 0; rr < 4; ++rr) p[rr] += (v[rr][j].x * w.x + v[rr][j].y * w.y) + (v[rr][j].z * w.z + v[rr][j].w * w.w); }
#pragma unroll
                for (int o = 1; o < 64; o <<= 1) {
#pragma unroll
                    for (int rr = 0; rr < 4; ++rr) p[rr] += __shfl_xor(p[rr], o); }
#pragma unroll
                for (int rr = 0; rr < 4; ++rr) z[rr] = (lane == h) ? p[rr] : z[rr]; }
            if (lane < 8) {
#pragma unroll
                for (int rr = 0; rr < 4; ++rr) { const float u = z[rr] + bfg; ((float*)(ws + WS_LOGF))[(size_t)(r0 + r4 + rr) * 8 + lane] = fminf(u, 0.f) - log1pf(__expf(-fabsf(u))); } }
        }
    }
}

__device__ __forceinline__ bool static_unit(int nM, int nN, int G, int c, int i, int& pm, int& pn) {
    const int nwg = nM * nN; const long L = (long)i * G + c; if (L >= nwg) return false;
    int wgid = (int)L; { const int q = nwg / 8, r = nwg % 8, xcd = wgid % 8, off = wgid / 8; wgid = (xcd < r ? xcd * (q + 1) : r * (q + 1) + (xcd - r) * q) + off; }
    const int nig = 8 * nN, gid = wgid / nig, fm = gid * 8, gsz = (nM - fm) < 8 ? (nM - fm) : 8;
    pm = fm + ((wgid % nig) % gsz); pn = (wgid % nig) / gsz; return true;
}
__device__ __forceinline__ void put_unit(Frame& F, int i, const void* A, const void* B, int tab, int orow, int ocol) {
    LAS pg8::UnitRec* r = (LAS pg8::UnitRec*)(F.lds + ULIST_OFF) + i;
    r->A = (unsigned long long)(uintptr_t)A; r->B = (unsigned long long)(uintptr_t)B; r->tab = tab; r->orow = orow; r->ocol = ocol; r->aux = 0;
}
__device__ __forceinline__ void p1(Frame& F) {
    unsigned char* ws = F.ws; int n = 0;
    for (int i = 0; i < MAXU; ++i) { int pm, pn; if (!static_unit(T / 256, 2048 / 256, F.G, (int)blockIdx.x, i, pm, pn)) break;
        if (F.tid == 0) put_unit(F, i, ws + WS_HB + (size_t)pm * 256 * D * 2, ws + WS_WIN + (size_t)pn * 256 * D * 2, -1, pm * 256, pn * 256);
        ++n; }
    __syncthreads();
    pg8::ListSched Sd{(const LAS pg8::UnitRec*)(F.lds + ULIST_OFF), n};
    pg8::EpiBf16 E{(bf16*)(ws + WS_PROJ), 2048};
    pg8::gemm_phase<pg8::EpiBf16, pg8::ListSched, false, pg8::NoHook>(F.lds, D, Sd, E, pg8::NoHook{}, F.wave);
}
}
namespace attn_body {
using bf16=__hip_bfloat16;
using bf16x8=__attribute__((ext_vector_type(8)))short;
using s16x4=__attribute__((ext_vector_type(4)))short;
using f32x16=__attribute__((ext_vector_type(16)))float;
using u32x4=__attribute__((ext_vector_type(4)))unsigned;
constexpr int BATCH=8,NHEAD=8,SEQ=2048,D=64,DM=2048,PO=1024;
constexpr int NW=8,QBLK=32,QB=QBLK*NW,KVBLK=64,NQB=SEQ/QB;
__device__ __forceinline__ int crow(int r,int hi){return (r&3)+8*(r>>2)+4*hi;}
#define SBAR() __builtin_amdgcn_sched_barrier(0)
__device__ __forceinline__ void cmask(f32x16&p0,f32x16&p1,int jb,int qrel,int hi){
  const float NEG=-INFINITY; int kb=64*jb+4*hi;
  #pragma unroll
  for(int r=0;r<16;++r){int kv=kb+(r&3)+8*(r>>2); if(kv>qrel)p0[r]=NEG; if(kv+32>qrel)p1[r]=NEG;}
}

constexpr int NSLOT=3, SLOTB=8192;
constexpr int LDS_K=0, LDS_V=NSLOT*SLOTB, LDS_WS=2*NSLOT*SLOTB, LDS_OST=LDS_WS+NW*64*4, LDS_CUM=LDS_OST+NW*4096, LDS_KB=LDS_CUM+SEQ*4, LDS_BYTES=LDS_KB+SEQ*4;
__device__ __forceinline__ void glds16(const void*gsrc,unsigned lds_dst){unsigned keep;
  asm volatile("s_mov_b32 %0, m0\n\ts_mov_b32 m0, %2\n\ts_nop 0\n\tglobal_load_lds_dwordx4 %1, off\n\ts_mov_b32 m0, %0":"=&s"(keep):"v"(gsrc),"s"(lds_dst):"memory");}
__device__ __forceinline__ float max3f(float a,float b,float c){float r;asm("v_max3_f32 %0, %1, %2, %3":"=v"(r):"v"(a),"v"(b),"v"(c));return r;}
__device__ __forceinline__ float max2f(float a,float b){float r;asm("v_max_f32_e32 %0, %1, %2":"=v"(r):"v"(a),"v"(b));return r;}
__device__ __forceinline__ float fadd_s(float a,float b){float r;asm("v_add_f32_e32 %0, %1, %2":"=v"(r):"v"(a),"v"(b));return r;}
__device__ __forceinline__ float fsub_s(float a,float b){float r;asm("v_sub_f32_e32 %0, %1, %2":"=v"(r):"v"(a),"v"(b));return r;}
typedef float f32x2_t __attribute__((ext_vector_type(2))); typedef __bf16 bf16x2_t __attribute__((ext_vector_type(2)));
__device__ __forceinline__ unsigned cvtpk_s(float lo,float hi){f32x2_t v={lo,hi};bf16x2_t b=__builtin_convertvector(v,bf16x2_t);return __builtin_bit_cast(unsigned,b);}
#define WAIT_BAR(N) asm volatile("s_waitcnt vmcnt(" #N ") lgkmcnt(0)\n\ts_barrier":::"memory")

__device__ __forceinline__ void qkt(f32x16&p0,f32x16&p1,const char*Kslot,const bf16x8*qr,bf16x8 kb0,bf16x8 kb1,bf16x8 qb,int r32,int hi){
  const char*kb=Kslot+hi*1024+r32*16;
  p0=__builtin_amdgcn_mfma_f32_32x32x16_bf16(kb0,qb,f32x16{},0,0,0);p1=__builtin_amdgcn_mfma_f32_32x32x16_bf16(kb1,qb,f32x16{},0,0,0);
  #pragma unroll
  for(int d0=0;d0<4;++d0){
    const bf16x8 b0=*reinterpret_cast<const bf16x8*>(kb+d0*2048);
    const bf16x8 b1=*reinterpret_cast<const bf16x8*>(kb+d0*2048+512);
    p0=__builtin_amdgcn_mfma_f32_32x32x16_bf16(b0,qr[d0],p0,0,0,0);p1=__builtin_amdgcn_mfma_f32_32x32x16_bf16(b1,qr[d0],p1,0,0,0);}
}
typedef __attribute__((address_space(3))) const char* lds_cptr;
typedef short v4i16_t __attribute__((ext_vector_type(4)));
__device__ __forceinline__ void kload8(bf16x8*kf,lds_cptr kp){
  kf[0]=*(const __attribute__((address_space(3))) bf16x8*)(kp);      kf[1]=*(const __attribute__((address_space(3))) bf16x8*)(kp+512);
  kf[2]=*(const __attribute__((address_space(3))) bf16x8*)(kp+2048); kf[3]=*(const __attribute__((address_space(3))) bf16x8*)(kp+2560);
  kf[4]=*(const __attribute__((address_space(3))) bf16x8*)(kp+4096); kf[5]=*(const __attribute__((address_space(3))) bf16x8*)(kp+4608);
  kf[6]=*(const __attribute__((address_space(3))) bf16x8*)(kp+6144); kf[7]=*(const __attribute__((address_space(3))) bf16x8*)(kp+6656);
}
__device__ __forceinline__ void kload2(bf16x8*kf,lds_cptr kp,int j){ kf[2*j]=*(const __attribute__((address_space(3))) bf16x8*)(kp+j*2048); kf[2*j+1]=*(const __attribute__((address_space(3))) bf16x8*)(kp+j*2048+512); }
__device__ __forceinline__ s16x4 vtr(lds_cptr p){ return __builtin_bit_cast(s16x4,__builtin_amdgcn_ds_read_tr16_b64_v4i16((__attribute__((address_space(3))) v4i16_t*)p)); }
__device__ __forceinline__ float rowmax(const f32x16&p0,const f32x16&p1){
  float a=max3f(p0[0],p0[1],p1[0]),b=max3f(p0[2],p0[3],p1[1]);a=max3f(a,p1[2],p1[3]);
  #pragma unroll
  for(int r=4;r<16;r+=4){a=max3f(a,p0[r],p0[r+1]);b=max3f(b,p0[r+2],p0[r+3]);a=max3f(a,p1[r],p1[r+1]);b=max3f(b,p1[r+2],p1[r+3]);}
  const float m=max2f(a,b);
  auto rr=__builtin_amdgcn_permlane32_swap(__float_as_uint(m),__float_as_uint(m),false,false);
  return max2f(__uint_as_float(rr[0]),__uint_as_float(rr[1]));
}
__device__ __forceinline__ void pv(f32x16*o,int vb,bf16x8 pa0,bf16x8 pa1,bf16x8 pa2,bf16x8 pa3){
  #pragma unroll
  for(int d0=0;d0<2;++d0){s16x4 lo[4],hi[4];
    #pragma unroll
    for(int ks=0;ks<4;++ks){
      asm volatile("ds_read_b64_tr_b16 %0,%1 offset:%c2":"=&v"(lo[ks]):"v"(vb),"i"(d0*4096+ks*1024):"memory");
      asm volatile("ds_read_b64_tr_b16 %0,%1 offset:%c2":"=&v"(hi[ks]):"v"(vb),"i"(d0*4096+ks*1024+512):"memory");}
    asm volatile("s_waitcnt lgkmcnt(0)":::"memory");SBAR();
    #define PK(k) (bf16x8){lo[k][0],lo[k][1],lo[k][2],lo[k][3],hi[k][0],hi[k][1],hi[k][2],hi[k][3]}
    o[d0]=__builtin_amdgcn_mfma_f32_32x32x16_bf16(pa0,PK(0),o[d0],0,0,0);
    o[d0]=__builtin_amdgcn_mfma_f32_32x32x16_bf16(pa1,PK(1),o[d0],0,0,0);
    o[d0]=__builtin_amdgcn_mfma_f32_32x32x16_bf16(pa2,PK(2),o[d0],0,0,0);
    o[d0]=__builtin_amdgcn_mfma_f32_32x32x16_bf16(pa3,PK(3),o[d0],0,0,0);
    #undef PK
  }
}

#ifndef ATTN_STORE16
#define ATTN_STORE16(p,v) do { if (MK_WT & 2) pg8::st16_wt((void*)(p), (v)); else *(u32x4*)(p)=(v); } while (0)
#endif
template<int THRL> __device__ __forceinline__ void attn_unit(int b,int h,int qb,const bf16*Q,const bf16*__restrict__ K,const bf16*__restrict__ V,bf16*O,float*ssq,char*shm,const int wid){
  int lane; asm volatile("v_mbcnt_lo_u32_b32 %0, -1, 0\n\tv_mbcnt_hi_u32_b32 %0, -1, %0" : "=v"(lane));
  const int tid=wid*64+lane, r32=lane&31,hi=lane>>5;
  const long rowbase=(long)b*SEQ; const int q0=qb*QB;
  const bf16*Qw=Q+(rowbase+q0+wid*QBLK)*DM+h*D;
  const bf16*Kh=K+rowbase*DM+h*D,*Vh=V+rowbase*DM+h*D;
  const unsigned lds0=(unsigned)(uintptr_t)shm;
  float*wsf=(float*)(shm+LDS_WS)+wid*64;
  const bf16*ksrc=Kh+(long)lane*DM+wid*8;
  const bf16*vsrc=Vh+(long)(16*(wid&3)+(lane>>2))*DM+(wid>>2)*32+(lane&3)*8;
  const unsigned kdst=lds0+LDS_K+wid*1024, vdst=lds0+LDS_V+wid*1024;
  #define DMA_K(t,slot) glds16(ksrc+(long)(t)*KVBLK*DM,(unsigned)__builtin_amdgcn_readfirstlane(kdst+(slot)))
  #define DMA_V(t,slot) glds16(vsrc+(long)(t)*KVBLK*DM,(unsigned)__builtin_amdgcn_readfirstlane(vdst+(slot)))
  const int vb0=(int)(lds0+LDS_V)+((lane>>4)&1)*32+(lane&3)*8+(4*hi+((lane&15)>>2))*64;
  const char*Kbase=shm+LDS_K; bf16x8 kf[8];
  const lds_cptr shm3=(lds_cptr)shm; const lds_cptr kp0=shm3+LDS_K+hi*1024+r32*16; const lds_cptr vp0=shm3+LDS_V+((lane>>4)&1)*32+(lane&3)*8+(4*hi+((lane&15)>>2))*64;
  const int NT=(q0+QB)/KVBLK;
  { const float*cum=(const float*)(shm+LDS_CUM); unsigned*kbt_=(unsigned*)(shm+LDS_KB); const float ref=cum[q0+QB-1];
    for(int k=tid;k<NT*KVBLK;k+=NW*64){ const float v=(ref-cum[k])*1.4426950408889634f; const unsigned hb=mk::f2bf(v); kbt_[k]=hb|(mk::f2bf(v-mk::bf2f(hb))<<16); }
    __syncthreads(); }
  const __attribute__((address_space(3))) unsigned* kbt=(const __attribute__((address_space(3))) unsigned*)((lds_cptr)shm+LDS_KB);
  const unsigned kone1=hi?0u:0x3F803F80u;
  #define KBF(pk) __builtin_bit_cast(bf16x8,(u32x4){(pk),kone1,kone1,0u})
  unsigned kbr0,kbr1;
  #define KBRD(G,tt) do{ if(G){ const unsigned a_=kbt[(tt)*KVBLK+r32], b_=kbt[(tt)*KVBLK+32+r32]; kbr0=a_; kbr1=b_; } }while(0)
  bf16x8 qb_=__builtin_bit_cast(bf16x8,(u32x4){kone1,0u,0u,0u});
  #define SETREF() do{ const float nm_=-mhat; const unsigned h0_=__float_as_uint(nm_)&0xFFFF0000u; const float r1_=nm_-__uint_as_float(h0_); const unsigned h1_=__float_as_uint(r1_)&0xFFFF0000u; \
      const float r2_=r1_-__uint_as_float(h1_); const unsigned h2_=__float_as_uint(r2_)&0xFFFF0000u; \
      qb_=__builtin_bit_cast(bf16x8,(u32x4){kone1, hi?0u:((h0_>>16)|h1_), hi?0u:(h2_>>16), 0u}); }while(0)
  DMA_K(0,0);DMA_V(0,0);DMA_K(1,SLOTB);
  bf16x8 qr[4];
  #pragma unroll
  for(int d0=0;d0<4;++d0)qr[d0]=*reinterpret_cast<const bf16x8*>(&Qw[(long)r32*DM+d0*16+hi*8]);
  const lds_cptr qp0=shm3+LDS_OST+wid*4096+hi*512+r32*16;
  #pragma unroll
  for(int d0=0;d0<4;++d0)*(__attribute__((address_space(3))) bf16x8*)((__attribute__((address_space(3))) char*)(qp0+d0*1024))=qr[d0];
  #define QF(d0) (*(const __attribute__((address_space(3))) bf16x8*)(qp0+(d0)*1024))
  float mhat=0.f,l_reg=0.f;f32x16 o[2];o[0]=f32x16{};o[1]=f32x16{};
  const int qrel=wid*QBLK+r32;
  #define CMASK(P0,P1,t) do{int jb_=(t)-(NT-4); if(jb_>=0)cmask(P0,P1,jb_,qrel,hi);}while(0)
  bool resc=false;
  #define START(P0,P1) do{ const float rm=rowmax(P0,P1); resc=false; \
    { const float dl=rm; mhat=fadd_s(mhat,dl); \
      _Pragma("unroll") for(int r=0;r<16;++r){P0[r]=fsub_s(P0[r],dl);P1[r]=fsub_s(P1[r],dl);} \
      SETREF(); } \
    _Pragma("unroll") for(int r=0;r<16;++r)P0[r]=__builtin_amdgcn_exp2f(P0[r]); }while(0)
  #define RESC() do{ if(resc){ asm volatile("s_waitcnt lgkmcnt(0)":::"memory"); \
      _Pragma("unroll") for(int d_=0;d_<2;++d_) _Pragma("unroll") for(int r=0;r<16;++r)o[d_][r]*=wsf[crow(r,hi)]; } }while(0)
  f32x16 pA0,pA1,pB0,pB1;
  int sl_prev=0,sl_cur=0,sl_next=SLOTB;
  #define ROT() do{sl_prev=sl_cur;sl_cur=sl_next;sl_next=(sl_next==(NSLOT-1)*SLOTB)?0:sl_next+SLOTB;}while(0)
  DMA_K(2,2*SLOTB);
  WAIT_BAR(3);
  KBRD(true,0);
  qkt(pA0,pA1,Kbase,qr,KBF(kbr0),KBF(kbr1),qb_,r32,hi);asm volatile("s_nop 15\n\ts_nop 7":"+v"(pA0),"+v"(pA1));CMASK(pA0,pA1,0);
  START(pA0,pA1);
  _Pragma("unroll") for(int r=0;r<16;++r)pA1[r]=__builtin_amdgcn_exp2f(pA1[r]);
  WAIT_BAR(0);
  DMA_K(3,0);DMA_V(1,SLOTB);
  ROT();
  kload8(kf,kp0+sl_cur);
  KBRD(true,1);
  WAIT_BAR(2);
  s16x4 vlo[8],vhi[8]; u32x4 pw0,pw1,pw2,pw3;
  #define PKW(P,B) cvtpk_s(P[B],P[B+1])
  #define PAF(k) __builtin_bit_cast(bf16x8,pw##k)
  #define VFR(i) (bf16x8){vlo[i][0],vlo[i][1],vlo[i][2],vlo[i][3],vhi[i][0],vhi[i][1],vhi[i][2],vhi[i][3]}
  #define PIN(x) asm volatile("":"+v"(x))
  #define MX3(a,b,c) __builtin_fmaxf(__builtin_fmaxf((a),(b)),(c))
  #define GAPA(MF,A0,A1,A2,A3,W0,W1,PW) do{ MF; sacc+=A0; sacc+=A1; sacc+=A2; sacc+=A3; PIN(sacc); W0; W1; PIN(PW); SBAR(); }while(0)
  #define EX(v) __builtin_amdgcn_exp2f(v)
  #define GAPB(MF,X,B) do{ MF; X[B]=EX(X[B]); X[B+1]=EX(X[B+1]); X[B+2]=EX(X[B+2]); X[B+3]=EX(X[B+3]); PIN(X); SBAR(); }while(0)
  #define VRD(i) do{ vlo[i]=vtr(vp_+(((i)>>2)*4096+((i)&3)*1024)); vhi[i]=vtr(vp_+(((i)>>2)*4096+((i)&3)*1024+512)); }while(0)
  #define KRD(G,j) do{ if(G){ kload2(kf,kp0+sl_next,j); SBAR(); } }while(0)
  #define STEP(C0,C1,P0,P1,t,GK,GV,GL) do{ SBAR(); \
    const lds_cptr vp_=vp0+sl_prev; \
    C0=__builtin_amdgcn_mfma_f32_32x32x16_bf16(KBF(kbr0),qb_,f32x16{},0,0,0); C1=__builtin_amdgcn_mfma_f32_32x32x16_bf16(KBF(kbr1),qb_,f32x16{},0,0,0); SBAR(); \
    VRD(0); SBAR(); float sacc=(P0[0]+P0[1]); \
    bf16x8 qa_=QF(0), qc_=QF(1); \
    GAPA(C0=__builtin_amdgcn_mfma_f32_32x32x16_bf16(kf[0],qa_,C0,0,0,0), P0[2],P0[3],P0[4],P0[5],     pw0[0]=PKW(P0,0), pw0[1]=PKW(P0,2), pw0); \
    VRD(4); SBAR(); GAPA(C1=__builtin_amdgcn_mfma_f32_32x32x16_bf16(kf[1],qa_,C1,0,0,0), P0[6],P0[7],P0[8],P0[9],     pw0[2]=PKW(P0,4), pw0[3]=PKW(P0,6), pw0); \
    qa_=QF(2); VRD(1); SBAR(); GAPA(C0=__builtin_amdgcn_mfma_f32_32x32x16_bf16(kf[2],qc_,C0,0,0,0),   P0[10],P0[11],P0[12],P0[13], pw1[0]=PKW(P0,8), pw1[1]=PKW(P0,10), pw1); \
    VRD(5); SBAR(); GAPA(C1=__builtin_amdgcn_mfma_f32_32x32x16_bf16(kf[3],qc_,C1,0,0,0),   P0[14],P0[15],P1[0],P1[1],   pw1[2]=PKW(P0,12),pw1[3]=PKW(P0,14), pw1); \
    qc_=QF(3); VRD(2); SBAR(); GAPA(C0=__builtin_amdgcn_mfma_f32_32x32x16_bf16(kf[4],qa_,C0,0,0,0),   P1[2],P1[3],P1[4],P1[5],     pw2[0]=PKW(P1,0), pw2[1]=PKW(P1,2), pw2); \
    VRD(6); SBAR(); GAPA(C1=__builtin_amdgcn_mfma_f32_32x32x16_bf16(kf[5],qa_,C1,0,0,0),   P1[6],P1[7],P1[8],P1[9],     pw2[2]=PKW(P1,4), pw2[3]=PKW(P1,6), pw2); \
    VRD(3); SBAR(); GAPA(C0=__builtin_amdgcn_mfma_f32_32x32x16_bf16(kf[6],qc_,C0,0,0,0),   P1[10],P1[11],P1[12],P1[13], pw3[0]=PKW(P1,8), pw3[1]=PKW(P1,10), pw3); \
    VRD(7); SBAR(); GAPA(C1=__builtin_amdgcn_mfma_f32_32x32x16_bf16(kf[7],qc_,C1,0,0,0),   P1[14],P1[15],0.f,0.f,       pw3[2]=PKW(P1,12),pw3[3]=PKW(P1,14), pw3); \
    l_reg+=sacc; \
    if(GK){DMA_K((t)+3,sl_cur);} if(GV){DMA_V((t)+1,sl_next);} \
    CMASK(C0,C1,t); \
    { float a=MX3(C0[0],C0[1],C1[0]),b=MX3(C0[2],C0[3],C1[1]); a=MX3(a,C1[2],C1[3]); \
      _Pragma("unroll") for(int r=4;r<16;r+=4){a=MX3(a,C0[r],C0[r+1]);b=MX3(b,C0[r+2],C0[r+3]);a=MX3(a,C1[r],C1[r+1]);b=MX3(b,C1[r+2],C1[r+3]);} \
      float rm=__builtin_fmaxf(a,b); { auto rr=__builtin_amdgcn_permlane32_swap(__float_as_uint(rm),__float_as_uint(rm),false,false); rm=__builtin_fmaxf(__uint_as_float(rr[0]),__uint_as_float(rr[1])); } \
      resc=false; \
      if(__builtin_expect(__any(rm>(float)THRL),0)){ const float dl=__builtin_fmaxf(rm,0.f); mhat+=dl; \
        _Pragma("unroll") for(int r=0;r<16;++r){C0[r]-=dl;C1[r]-=dl;} \
        SETREF(); \
        const float f=__builtin_amdgcn_exp2f(-dl); l_reg*=f; if(hi==0)wsf[r32]=f; resc=true; } } \
    SBAR(); \
    GAPB(o[0]=__builtin_amdgcn_mfma_f32_32x32x16_bf16(PAF(0),VFR(0),o[0],0,0,0), C0,0); \
    GAPB(o[1]=__builtin_amdgcn_mfma_f32_32x32x16_bf16(PAF(0),VFR(4),o[1],0,0,0), C0,4); \
    KRD(GL,0); GAPB(o[0]=__builtin_amdgcn_mfma_f32_32x32x16_bf16(PAF(1),VFR(1),o[0],0,0,0), C0,8); \
    KRD(GL,1); GAPB(o[1]=__builtin_amdgcn_mfma_f32_32x32x16_bf16(PAF(1),VFR(5),o[1],0,0,0), C0,12); \
    KRD(GL,2); GAPB(o[0]=__builtin_amdgcn_mfma_f32_32x32x16_bf16(PAF(2),VFR(2),o[0],0,0,0), C1,0); \
    KRD(GL,3); GAPB(o[1]=__builtin_amdgcn_mfma_f32_32x32x16_bf16(PAF(2),VFR(6),o[1],0,0,0), C1,4); \
    KBRD(GL,(t)+1); \
    GAPB(o[0]=__builtin_amdgcn_mfma_f32_32x32x16_bf16(PAF(3),VFR(3),o[0],0,0,0), C1,8); \
    GAPB(o[1]=__builtin_amdgcn_mfma_f32_32x32x16_bf16(PAF(3),VFR(7),o[1],0,0,0), C1,12); \
    }while(0)
  int t=1;
  #undef CMASK
  #define CMASK(P0,P1,t) do{}while(0)
  for(;t+5<NT;t+=2){
    STEP(pB0,pB1,pA0,pA1,t,true,true,true);     WAIT_BAR(2); RESC(); ROT();
    STEP(pA0,pA1,pB0,pB1,t+1,true,true,true);   WAIT_BAR(2); RESC(); ROT();
  }
  #undef CMASK
  #define CMASK(P0,P1,t) do{int jb_=(t)-(NT-4); if(jb_>=0)cmask(P0,P1,jb_,qrel,hi);}while(0)
  #define ENDW(tt) do{ if((tt)+3<NT){WAIT_BAR(2);} else if((tt)+2<NT){WAIT_BAR(1);} else {WAIT_BAR(0);} }while(0)
  for(;t+1<NT;t+=2){
    STEP(pB0,pB1,pA0,pA1,t,(t+3<NT),(t+1<NT),(t+1<NT));       ENDW(t);   RESC(); ROT();
    STEP(pA0,pA1,pB0,pB1,t+1,(t+4<NT),(t+2<NT),(t+2<NT));     ENDW(t+1); RESC(); ROT();
  }
  STEP(pB0,pB1,pA0,pA1,NT-1,false,false,false); RESC();
  { float sacc=pB0[0]+pB0[1]; _Pragma("unroll") for(int r=2;r<16;++r)sacc+=pB0[r]; _Pragma("unroll") for(int r=0;r<16;++r)sacc+=pB1[r]; l_reg+=sacc;
    pw0=(u32x4){PKW(pB0,0),PKW(pB0,2),PKW(pB0,4),PKW(pB0,6)};pw1=(u32x4){PKW(pB0,8),PKW(pB0,10),PKW(pB0,12),PKW(pB0,14)};pw2=(u32x4){PKW(pB1,0),PKW(pB1,2),PKW(pB1,4),PKW(pB1,6)};pw3=(u32x4){PKW(pB1,8),PKW(pB1,10),PKW(pB1,12),PKW(pB1,14)};
    SBAR(); pv(o,vb0+sl_cur,PAF(0),PAF(1),PAF(2),PAF(3)); }
  #undef PKW
  #undef PAF
  #undef VFR
  #undef PIN
  #undef MX3
  #undef GAPA
  #undef GAPB
  #undef EX
  #undef VRD
  #undef KRD
  #undef STEP
  #undef ENDW
  {auto rr=__builtin_amdgcn_permlane32_swap(__float_as_uint(l_reg),__float_as_uint(l_reg),false,false);l_reg=__uint_as_float(rr[0])+__uint_as_float(rr[1]);}
  if(hi==0)wsf[32+r32]=l_reg;asm volatile("s_waitcnt lgkmcnt(0)":::"memory");
  float rli[16];
  #pragma unroll
  for(int r=0;r<16;++r)rli[r]=__builtin_amdgcn_rcpf(wsf[32+crow(r,hi)]);
  bf16*Ow=O+(rowbase+q0+wid*QBLK)*PO+h*D; float*sq=ssq+(rowbase+q0+wid*QBLK)*8+h;
  { bf16*stg=(bf16*)(shm+LDS_OST)+wid*2048;
    #pragma unroll
    for(int r=0;r<16;++r){const int orow=crow(r,hi);
      #pragma unroll
      for(int d0=0;d0<2;++d0)stg[orow*64+d0*32+r32]=__float2bfloat16(o[d0][r]*rli[r]);}
    asm volatile("s_waitcnt lgkmcnt(0)":::"memory");
    #pragma unroll
    for(int i=0;i<4;++i){const int row=i*8+(lane>>3),ch=lane&7; const u32x4 v=*(const u32x4*)(stg+row*64+ch*8); ATTN_STORE16(Ow+(long)row*PO+ch*8,v);
      float ss=0.f;
      #pragma unroll
      for(int j=0;j<4;++j){ const float a_=__uint_as_float(v[j]<<16), b_=__uint_as_float(v[j]&0xFFFF0000u); ss+=a_*a_+b_*b_; }
      ss+=__shfl_xor(ss,1); ss+=__shfl_xor(ss,2); ss+=__shfl_xor(ss,4); if(ch==0) sq[(long)row*8]=ss; } }
  asm volatile("s_waitcnt lgkmcnt(0)\n\ts_barrier":::"memory");
  #undef DMA_K
  #undef DMA_V
  #undef CMASK
  #undef START
  #undef RESC
  #undef ROT
  #undef KBF
  #undef QF
  #undef KBRD
  #undef SETREF
}
constexpr int ATTN_LDS_BYTES=LDS_BYTES;
#undef SBAR
#undef WAIT_BAR
}

namespace mk {
template <int G>
__device__ __forceinline__ void pool_item(Frame& F, int panel) {
    unsigned char* ws = F.ws; constexpr int US = 272, WSTR = 272, WOFF = 75776, WG = 2 << G;
    const int t0 = panel * 256, tl0 = t0 % S;
    const bf16* proj = (const bf16*)(ws + WS_PROJ); const bf16* wp = (const bf16*)(ws + WS_WPOOL) + (size_t)G * 16384;
    { v4u v[9], wv[4];
#pragma unroll
      for (int i = 0; i < 9; ++i) { const int c = F.tid + i * NTHR, rr = c >> 4, ch = c & 15; v[i] = (v4u){0u, 0u, 0u, 0u};
          if (c < 271 * 16 && tl0 + rr - 15 >= 0) v[i] = *(const GAS v4u*)(proj + (size_t)(t0 - 15 + rr) * 2048 + G * 128 + ch * 8); }
#pragma unroll
      for (int i = 0; i < 4; ++i) { const int c = F.tid + i * NTHR; wv[i] = *(const GAS v4u*)(wp + (size_t)c * 8); }
#pragma unroll
      for (int i = 0; i < 9; ++i) { const int c = F.tid + i * NTHR, rr = c >> 4, ch = c & 15; if (c < 271 * 16) *(LAS v4u*)(F.lds + rr * US + ch * 16) = v[i]; }
#pragma unroll
      for (int i = 0; i < 4; ++i) { const int c = F.tid + i * NTHR; *(LAS v4u*)(F.lds + WOFF + (c >> 4) * WSTR + (c & 15) * 16) = wv[i]; } }
    __syncthreads();
    const int r = F.lane & 15, kq = F.lane >> 4;
    bf16* ycat = (bf16*)(ws + WS_YCAT); float* ssqp = (float*)(ws + WS_SSQP);
    const LAS unsigned char* wl = F.lds + WOFF + r * WSTR + kq * 16;
#pragma unroll 1
    for (int mi = 0; mi < 2; ++mi) {
        asm volatile("" ::: "memory");
        const int tr = (F.wave * 2 + mi) * 16 + r, tl = tl0 + tr;
        const int n = (tl + 1 < WG) ? tl + 1 : WG; const float inv = 1.0f / (float)n;
        f32x4 acc[8];
#pragma unroll
        for (int nb = 0; nb < 8; ++nb) acc[nb] = (f32x4){0.f, 0.f, 0.f, 0.f};
#pragma unroll
        for (int ks = 0; ks < 4; ++ks) {
            float sum[8];
#pragma unroll
            for (int j = 0; j < 8; ++j) sum[j] = 0.f;
            v4u cur = (v4u){0u, 0u, 0u, 0u};
#pragma unroll
            for (int i = 0; i < WG; ++i) { const v4u v = *(const LAS v4u*)(F.lds + (tr + 15 - i) * US + ks * 64 + kq * 16); if (i == 0) cur = v;
#pragma unroll
                for (int j = 0; j < 4; ++j) { sum[2 * j] += __uint_as_float(v[j] << 16); sum[2 * j + 1] += __uint_as_float(v[j] & 0xFFFF0000u); } }
            v4u pa;
#pragma unroll
            for (int j = 0; j < 4; ++j) pa[j] = pk2(sum[2 * j] * inv - __uint_as_float(cur[j] << 16), sum[2 * j + 1] * inv - __uint_as_float(cur[j] & 0xFFFF0000u));
            const bf16x8 af = __builtin_bit_cast(bf16x8, pa);
#pragma unroll
            for (int nb = 0; nb < 8; ++nb) { const bf16x8 bfr = *(const LAS bf16x8*)(wl + nb * 16 * WSTR + ks * 64);
                acc[nb] = __builtin_amdgcn_mfma_f32_16x16x32_bf16(bfr, af, acc[nb], 0, 0, 0); }
        }
        const size_t token = (size_t)t0 + tr; float ss = 0.f;
#pragma unroll
        for (int nb = 0; nb < 8; ++nb) { const f32x4 v = acc[nb]; ss += (v[0] * v[0] + v[1] * v[1]) + (v[2] * v[2] + v[3] * v[3]);
            v2u o; o.x = pk2(v[0], v[1]); o.y = pk2(v[2], v[3]);
            *(GAS v2u*)(ycat + token * D + G * 128 + nb * 16 + 4 * kq) = o; }
        ss += __shfl_xor(ss, 16); ss += __shfl_xor(ss, 32);
        if (kq == 0) { ssqp[token * 8 + G * 2] = ss; ssqp[token * 8 + G * 2 + 1] = 0.f; }
    }
    __syncthreads();
}

__device__ __forceinline__ void p2(Frame& F) {
    unsigned char* ws = F.ws; char* shm = (char*)(uintptr_t)0;
    (void)shm;
    const attn_body::bf16* proj = (const attn_body::bf16*)(ws + WS_PROJ);
    attn_body::bf16* ycat = (attn_body::bf16*)(ws + WS_YCAT);
    const float* logf = (const float*)(ws + WS_LOGF); float* ssqa = (float*)(ws + WS_SSQA);
    char* lds = (char*)F.lds;
    for (int p = F.vcu; p < 256; p += F.G) {
        const int bh = p >> 2, s = p & 3, b = bh >> 3, h = bh & 7;
        { const float* lf = logf + (size_t)b * S * 8 + h; const int k0 = 4 * F.tid;
          const float l0 = lf[(size_t)(k0 + 0) * 8], l1 = lf[(size_t)(k0 + 1) * 8], l2 = lf[(size_t)(k0 + 2) * 8], l3 = lf[(size_t)(k0 + 3) * 8];
          const float c0 = l0, c1 = c0 + l1, c2 = c1 + l2, c3 = c2 + l3; float x = c3;
#pragma unroll
          for (int o = 1; o < 64; o <<= 1) { const float y = __shfl_up(x, o); if (F.lane >= o) x += y; }
          LAS float* wt = (LAS float*)(F.lds + attn_body::LDS_WS);
          if (F.lane == 63) wt[F.wave] = x;
          __syncthreads();
          float base = x - c3; for (int w = 0; w < F.wave; ++w) base += wt[w];
          LAS float* cum = (LAS float*)(F.lds + attn_body::LDS_CUM);
          *(LAS f32x4*)(cum + k0) = (f32x4){base + c0, base + c1, base + c2, base + c3};
          __syncthreads(); }
        SUBSTAMP(F, 0);
#pragma nounroll
        for (int u = 0; u < 2; ++u) { attn_body::attn_unit<64>(b, h, u ? 7 - s : s, proj + 512, proj + 1024, proj + 1536, ycat + 512, ssqa, lds, F.wave); SUBSTAMP(F, 1 + u); }
    }
    __syncthreads();
    for (int it = F.vcu; it < 256; it += F.G) { const int panel = it >> 2;
        switch (it & 3) { case 0: pool_item<0>(F, panel); break; case 1: pool_item<1>(F, panel); break; case 2: pool_item<2>(F, panel); break; default: pool_item<3>(F, panel); break; } }
    SUBSTAMP(F, 3);
}
}
namespace mk {
struct MidScaleHook {
    const LAS float* ratio;
    __device__ __forceinline__ void at(int t, pg8::f32x4 (&acc)[2][2][4][2], int wr, int fr, int) const {
        if (t == 8) {
#pragma unroll
            for (int ai = 0; ai < 2; ++ai)
#pragma unroll
                for (int m = 0; m < 4; ++m) { const float s = ratio[ai * 128 + wr * 64 + m * 16 + fr];
#pragma unroll
                    for (int bj = 0; bj < 2; ++bj)
#pragma unroll
                        for (int n = 0; n < 2; ++n) acc[ai][bj][m][n] *= s; }
        }
    }
};
__device__ __forceinline__ void p3(Frame& F) {
    unsigned char* ws = F.ws;
    LAS float* ratio = (LAS float*)(F.lds + RS_OFF); LAS float* rs = ratio + 256;
    const float* ssqp = (const float*)(ws + WS_SSQP); const float* ssqa = (const float*)(ws + WS_SSQA);
    for (int i = 0; i < 64; ++i) { int pm, pn; if (!static_unit(T / 256, D / 256, F.G, (int)blockIdx.x, i, pm, pn)) break;
        __syncthreads();
        if (F.tid < 256) { const size_t tok = (size_t)pm * 256 + F.tid; float sp = 0.f, sa = 0.f;
#pragma unroll
            for (int j = 0; j < 8; ++j) { sp += ssqp[tok * 8 + j]; sa += ssqa[tok * 8 + j]; }
            const float rp = rsqrtf(sp * (1.f / 512.f) + EPS), ra = rsqrtf(sa * (1.f / 512.f) + EPS);
            ratio[F.tid] = rp / ra; rs[F.tid] = ra; }
        if (F.tid == 0) put_unit(F, 0, ws + WS_YCAT + (size_t)pm * 256 * D * 2, ws + WS_WOUT + (size_t)pn * 256 * D * 2, -1, pm * 256, pn * 256);
        __syncthreads();
        pg8::ListSched Sd{(const LAS pg8::UnitRec*)(F.lds + ULIST_OFF), 1};
        pg8::EpiRowScaleBf16 E{(bf16*)(ws + WS_MIXED), D, rs};
        pg8::gemm_phase<pg8::EpiRowScaleBf16, pg8::ListSched, false, MidScaleHook>(F.lds, D, Sd, E, MidScaleHook{ratio}, F.wave);
    }
}
}
namespace mk {
typedef _Float16 f16x8 __attribute__((ext_vector_type(8)));
__device__ __forceinline__ int p4_swz(int row, int chunk) { return row * 2048 + ((chunk ^ (row & 15)) << 4); }
__device__ __forceinline__ unsigned pkh2(float a, float b) { return (unsigned)__builtin_bit_cast(unsigned short, (_Float16)a) | ((unsigned)__builtin_bit_cast(unsigned short, (_Float16)b) << 16); }
template <bool DRY> __device__ __forceinline__ void p4(Frame& F) {
    const bool live = !DRY || (__hip_atomic_load(F.ctl + 3, RLX_AGENT) == 0xdeadbeefu);
    const float* const* in = F.in; unsigned char* ws = F.ws;
    const float* mod = (const float*)(ws + WS_MOD);
    const bf16* mixed = (const bf16*)(ws + WS_MIXED); unsigned char* h2g = ws + WS_H2;
    const _Float16* wr16 = (const _Float16*)(ws + WS_WRHI);
    LAS unsigned char* th = F.lds;
    const int lane = F.lane;
    for (int tile = F.vcu; tile < T / 64; tile += F.G) {
        const int b = (tile * 64) / S;
#pragma unroll 1
        for (int r4 = 0; r4 < 8; r4 += 4) {
            const int row0 = F.wave * 8 + r4; const size_t tok0 = (size_t)tile * 64 + row0;
            v2u mu[4][4]; f32x4 xv[4][4];
#pragma unroll
            for (int rr = 0; rr < 4; ++rr)
#pragma unroll
                for (int j = 0; j < 4; ++j) mu[rr][j] = __builtin_nontemporal_load((const GAS v2u*)(mixed + (tok0 + rr) * D + 4 * lane + 256 * j));
#pragma unroll
            for (int rr = 0; rr < 4; ++rr)
#pragma unroll
                for (int j = 0; j < 4; ++j) xv[rr][j] = __builtin_nontemporal_load((const GAS f32x4*)(in[I_X] + (tok0 + rr) * D + 4 * lane + 256 * j));
            f32x4 g1[4];
#pragma unroll
            for (int j = 0; j < 4; ++j) { const int c = 4 * lane + 256 * j; g1[j] = *(const f32x4*)(mod + b * 6144 + 2048 + c) * *(const f32x4*)(in[I_GPOSTMIX] + c); }
            float ss[4];
#pragma unroll
            for (int rr = 0; rr < 4; ++rr) { float a = 0.f;
#pragma unroll
                for (int j = 0; j < 4; ++j) { const float m0 = __uint_as_float(mu[rr][j].x << 16), m1 = __uint_as_float(mu[rr][j].x & 0xFFFF0000u), m2 = __uint_as_float(mu[rr][j].y << 16), m3 = __uint_as_float(mu[rr][j].y & 0xFFFF0000u);
                    a += (m0 * m0 + m1 * m1) + (m2 * m2 + m3 * m3); }
                ss[rr] = a; }
#pragma unroll
            for (int o = 1; o < 64; o <<= 1) {
#pragma unroll
                for (int rr = 0; rr < 4; ++rr) ss[rr] += __shfl_xor(ss[rr], o); }
#pragma unroll
            for (int rr = 0; rr < 4; ++rr) { const float rm = rsqrtf(ss[rr] * (1.f / D) + EPS); float a = 0.f;
#pragma unroll
                for (int j = 0; j < 4; ++j) { const f32x4 m = (f32x4){__uint_as_float(mu[rr][j].x << 16), __uint_as_float(mu[rr][j].x & 0xFFFF0000u), __uint_as_float(mu[rr][j].y << 16), __uint_as_float(mu[rr][j].y & 0xFFFF0000u)};
                    const f32x4 x1 = xv[rr][j] + g1[j] * (m * rm); xv[rr][j] = x1;
                    if (live) { v2u xb; xb.x = pk2(x1.x, x1.y); xb.y = pk2(x1.z, x1.w); *(GAS v2u*)((bf16*)(F.out + (tok0 + rr) * D) + 4 * lane + 256 * j) = xb; }
                    a += (x1.x * x1.x + x1.y * x1.y) + (x1.z * x1.z + x1.w * x1.w); }
                ss[rr] = a; }
#pragma unroll
            for (int o = 1; o < 64; o <<= 1) {
#pragma unroll
                for (int rr = 0; rr < 4; ++rr) ss[rr] += __shfl_xor(ss[rr], o); }
#pragma unroll
            for (int j = 0; j < 4; ++j) { const int c = 4 * lane + 256 * j;
                const f32x4 gs = *(const f32x4*)(in[I_GPREFFN] + c) * (*(const f32x4*)(mod + b * 6144 + 4096 + c) + 1.0f), sh = *(const f32x4*)(mod + b * 6144 + 3072 + c);
#pragma unroll
                for (int rr = 0; rr < 4; ++rr) { const float r1 = rsqrtf(ss[rr] * (1.f / D) + EPS);
                    const f32x4 h = xv[rr][j] * r1 * gs + sh;
                    v2u hv; hv.x = pkh2(h.x, h.y); hv.y = pkh2(h.z, h.w);
                    int p8 = __builtin_amdgcn_cvt_pk_fp8_f32(h.x * H2_SCALE, h.y * H2_SCALE, 0, false); p8 = __builtin_amdgcn_cvt_pk_fp8_f32(h.z * H2_SCALE, h.w * H2_SCALE, p8, true);
                    if (live) *(GAS unsigned*)(h2g + (tok0 + rr) * D + c) = (unsigned)p8;
                    *(LAS v2u*)(th + p4_swz(row0 + rr, (lane >> 1) + 32 * j) + (lane & 1) * 8) = hv; } }
        }
        __syncthreads();
        float lgv[8];
        {   const int r = lane & 15, kq = lane >> 4;
            f32x4 acc[4][4];
#pragma unroll
            for (int mb = 0; mb < 4; ++mb)
#pragma unroll
                for (int nb = 0; nb < 4; ++nb) acc[mb][nb] = (f32x4){0.f, 0.f, 0.f, 0.f};
#pragma unroll 2
            for (int kk = 0; kk < 4; ++kk) { const int ks = F.wave * 4 + kk;
                f16x8 af[4], bfr[4];
#pragma unroll
                for (int nb = 0; nb < 4; ++nb) bfr[nb] = *(const f16x8*)(wr16 + (size_t)(nb * 16 + r) * D + ks * 32 + kq * 8);
#pragma unroll
                for (int mb = 0; mb < 4; ++mb) af[mb] = *(const LAS f16x8*)(th + p4_swz(mb * 16 + r, ks * 4 + kq));
#pragma unroll
                for (int nb = 0; nb < 4; ++nb)
#pragma unroll
                    for (int mb = 0; mb < 4; ++mb) acc[mb][nb] = __builtin_amdgcn_mfma_f32_16x16x32_f16(af[mb], bfr[nb], acc[mb][nb], 0, 0, 0); }
            LAS float* part = (LAS float*)F.lds + F.wave * 2112;
#pragma unroll
            for (int hh = 0; hh < 2; ++hh) {
                __syncthreads();
#pragma unroll
                for (int m2 = 0; m2 < 2; ++m2)
#pragma unroll
                    for (int nb = 0; nb < 4; ++nb)
#pragma unroll
                        for (int i = 0; i < 4; ++i) part[(m2 * 16 + kq * 4 + i) * 66 + nb * 16 + r] = acc[2 * hh + m2][nb][i];
                if (hh == 0 && F.tid < 64) ((LAS unsigned*)(F.lds + 69632))[F.tid] = 0u;
                __syncthreads();
                if ((F.tid >> 8) == hh) { const LAS float* p0 = (const LAS float*)F.lds + ((F.tid & 255) >> 3) * 66 + (F.tid & 7) * 8;
#pragma unroll
                    for (int j = 0; j < 8; ++j) { float a = 0.f;
#pragma unroll
                        for (int w = 0; w < 8; ++w) a += p0[w * 2112 + j];
                        lgv[j] = a; } }
            }
        }
        int my_e = 0; float my_w = 0.f; unsigned my_pos = 0u;
        const int tk = F.tid >> 3, gl = F.tid & 7; const size_t rtoken = (size_t)tile * 64 + tk;
        LAS unsigned* hist = (LAS unsigned*)(F.lds + 69632); LAS unsigned* basev = hist + 64;
        {
            const int lb = lane & ~7;
            float sc[8], sl[8];
#pragma unroll
            for (int j = 0; j < 8; ++j) { const float x = lgv[j]; const float s = 1.0f / (1.0f + __expf(-x)); sc[j] = s; sl[j] = s + in[I_RBIAS][gl * 8 + j]; }
            float a = -INFINITY, b2 = -INFINITY;
#pragma unroll
            for (int j = 0; j < 8; ++j) { const float v = sl[j]; if (v > a) { b2 = a; a = v; } else if (v > b2) b2 = v; }
            const float gs = a + b2; int rank = 0;
#pragma unroll
            for (int i = 0; i < 8; ++i) { const float og = __shfl(gs, lb + i); rank += (og > gs || (og == gs && i < gl)) ? 1 : 0; }
            if (rank >= 4) {
#pragma unroll
                for (int j = 0; j < 8; ++j) sl[j] = -INFINITY; }
            float wsum = 0.f, my_s = 0.f;
#pragma unroll
            for (int rd = 0; rd < 8; ++rd) {
                float bv = sl[0]; int be = gl * 8;
#pragma unroll
                for (int j = 1; j < 8; ++j) if (sl[j] > bv) { bv = sl[j]; be = gl * 8 + j; }
#pragma unroll
                for (int msk = 1; msk < 8; msk <<= 1) { const float ov = __shfl_xor(bv, msk); const int oe = __shfl_xor(be, msk); if (ov > bv || (ov == bv && oe < be)) { bv = ov; be = oe; } }
                float ws_ = 0.f;
#pragma unroll
                for (int j = 0; j < 8; ++j) if (be == gl * 8 + j) { ws_ = sc[j]; sl[j] = -INFINITY; }
                const float wsc = __shfl(ws_, lb + (be >> 3));
                wsum += wsc; if (gl == rd) { my_e = be; my_s = wsc; }
            }
            my_w = my_s / wsum * 2.5f;
            my_pos = __hip_atomic_fetch_add(hist + my_e, 1u, __ATOMIC_RELAXED, __HIP_MEMORY_SCOPE_WORKGROUP);
        }
        __syncthreads();
        if (F.tid < 64) { const unsigned c = hist[F.tid]; basev[F.tid] = (c && live) ? __hip_atomic_fetch_add(F.ctl + CW_CNT + 64 * F.tid, c, __ATOMIC_RELAXED, __HIP_MEMORY_SCOPE_AGENT) : 0u; }
        __syncthreads();
        if (live) { const unsigned slot = basev[my_e] + my_pos; const unsigned v = (unsigned)my_e;
            ((unsigned*)(ws + WS_LISTS))[(size_t)v * LIST_CAP + slot] = (unsigned)rtoken;
            ((unsigned*)(ws + WS_TOKMAP))[rtoken * 8 + gl] = (v << 16) | slot;
            ((float*)(ws + WS_WTS))[rtoken * 8 + gl] = my_w; }
        __syncthreads();
    }
}
}
namespace mk {
__device__ __forceinline__ void moe_prefix(Frame& F) {
    LAS int* pre = (LAS int*)(F.lds + PRE_OFF);
    __syncthreads();
    if (F.tid < 64) {
        const int c0 = (int)__hip_atomic_load(F.ctl + CW_CNT + 64 * F.tid, RLX_AGENT);
        const int t0 = (c0 + 255) >> 8; int x = t0;
#pragma unroll
        for (int o = 1; o < 64; o <<= 1) { const int y = __shfl_up(x, o); if (F.lane >= o) x += y; }
        pre[F.tid] = x - t0; if (F.tid == 63) pre[64] = x; pre[68 + F.tid] = c0;
    }
    __syncthreads();
}
__device__ __forceinline__ int moe_find_list(const LAS int* pre, int tile) {
    int lo = 0, hi = 64;
    while (hi - lo > 1) { const int mid = (lo + hi) >> 1; if (pre[mid] <= tile) lo = mid; else hi = mid; }
    return lo;
}
__device__ __forceinline__ int moe_tiles(int NTr) { int nt = NTr + T / 256; const long cap = (long)((WS_END - WS_H) / (256 * (256 + 1024))); return nt > cap ? (int)cap : nt; }
__device__ __forceinline__ unsigned char* y_base(Frame& F, int ntl) { return F.ws + WS_H + (size_t)ntl * 256 * 256; }

struct MoeMap { int NTr, ntl; bool chain; };
__device__ __forceinline__ MoeMap moe_map(Frame& F, const LAS int* pre) { MoeMap M; M.NTr = pre[64]; M.ntl = moe_tiles(M.NTr); M.chain = (F.G == 256) && (M.ntl == M.NTr + T / 256); return M; }
__device__ __forceinline__ bool p5_unit(const MoeMap& M, int G, int v, int i, int& tile, int& pn) {
    if (!M.chain) { const int L = i * G + v; if (L >= 2 * M.ntl) return false; tile = L >> 1; pn = L & 1; return true; }
    int r;
    if (v >= 192) { if (i < 2) { tile = M.NTr + (v - 192); pn = i; return true; } r = 576 + (i - 2) * 256 + v; }
    else r = (i < 3) ? i * 192 + v : 576 + (i - 3) * 256 + v;
    if (r >= 2 * M.NTr) return false;
    tile = r >> 1; pn = r & 1; return true;
}
__device__ __forceinline__ bool p6_unit(const MoeMap& M, int G, int v, int i, int& tile, int& pn) {
    const int L = i * G + v;
    if (!M.chain) { if (L >= 4 * M.ntl) return false; tile = L >> 2; pn = L & 3; return true; }
    if (L < 4 * M.NTr) { tile = L >> 2; pn = L & 3; return true; }
    const int sx = L - 4 * M.NTr; if (sx >= 2 * (T / 256)) return false;
    tile = M.NTr + (sx >> 1); pn = 2 + (sx & 1); return true;
}
__device__ __forceinline__ int y_row0(const MoeMap& M, int tile) { return tile < M.NTr ? tile * 256 : (int)((long)(WS_YS - WS_H - (size_t)M.ntl * 256 * 256) / D) + (tile - M.NTr) * 256; }
__device__ __forceinline__ const void* p6_bt(Frame& F, const MoeMap& M, const LAS int* pre, int tile, int pn) {
    if (tile < M.NTr) { const int e = moe_find_list(pre, tile); return F.ws + WS_WD + ((size_t)e * D + (size_t)pn * 256) * 256; }
    return F.ws + WS_WSD + (size_t)pn * 256 * 256;
}

__device__ __forceinline__ void p5(Frame& F) {
    unsigned char* ws = F.ws;
    moe_prefix(F);
    const LAS int* pre = (const LAS int*)(F.lds + PRE_OFF);
    const MoeMap M = moe_map(F, pre); const int NTr = M.NTr;
    const unsigned* lists = (const unsigned*)(ws + WS_LISTS);
    int n = 0;
#pragma unroll
    for (int i = 0; i < MAXU; ++i) { int t_, p_; n += p5_unit(M, F.G, F.vcu, i, t_, p_) ? 1 : 0; }
    unsigned val[MAXU / 2];
#pragma unroll
    for (int sx = 0; sx < MAXU / 2; ++sx) { const int i = 2 * sx + (F.tid >> 8); val[sx] = 0u; int tile, pn;
        if (i < n && p5_unit(M, F.G, F.vcu, i, tile, pn)) {
            if (tile < NTr) { const int e = moe_find_list(pre, tile), r = (tile - pre[e]) * 256 + (F.tid & 255); val[sx] = lists[(size_t)e * LIST_CAP + (r < pre[68 + e] ? r : 0)]; }
            else val[sx] = (unsigned)((tile - NTr) * 256 + (F.tid & 255)); } }
#pragma unroll
    for (int sx = 0; sx < MAXU / 2; ++sx) { const int i = 2 * sx + (F.tid >> 8); if (i < n) ((LAS unsigned*)(F.lds + TAB_OFF + i * 1024))[F.tid & 255] = val[sx]; }
    if (F.tid < n) { const int i = F.tid; int tile, pn; (void)p5_unit(M, F.G, F.vcu, i, tile, pn); const void* Bp;
        if (tile < NTr) { const int e = moe_find_list(pre, tile); Bp = ws + WS_WGU + ((size_t)e * 512 + (size_t)pn * 256) * D; } else Bp = ws + WS_WSGU + (size_t)pn * 256 * D;
        put_unit(F, i, ws + WS_H2, Bp, TAB_OFF + i * 1024, tile * 256, pn * 128); }
    __syncthreads();
    {   pg8::ListSched Sd{(const LAS pg8::UnitRec*)(F.lds + ULIST_OFF), n};
        pg8::EpiSwiglu E{ws + WS_H, 256, 1.0f / (H2_SCALE * WGU_SCALE), HH_SCALE};
        pg8::gemm_phase<pg8::EpiSwiglu, pg8::ListSched, true, pg8::NoHook, true>(F.lds, D / 2, Sd, E, pg8::NoHook{}, F.wave); }
    if (M.chain && F.vcu >= 192) {
        const int tile = NTr + (F.vcu - 192);
        if (F.tid < 2) put_unit(F, F.tid, ws + WS_H + (size_t)tile * 256 * 256, ws + WS_WSD + (size_t)F.tid * 256 * 256, -1, y_row0(M, tile), F.tid * 256);
        __syncthreads();
        pg8::ListSched Sd{(const LAS pg8::UnitRec*)(F.lds + ULIST_OFF), 2};
        pg8::EpiFp8 E{y_base(F, M.ntl), D, true, 16.0f / (HH_SCALE * WD_SCALE)};
        pg8::gemm_phase<pg8::EpiFp8, pg8::ListSched, false, pg8::NoHook, true>(F.lds, 128, Sd, E, pg8::NoHook{}, F.wave); }
    SUBSTAMP(F, 4);
}

template <bool DRY> __device__ __forceinline__ void p6(Frame& F) {
    const bool live = !DRY || (__hip_atomic_load(F.ctl + 3, RLX_AGENT) == 0xdeadbeefu);
    unsigned char* ws = F.ws;
    moe_prefix(F);
    const LAS int* pre = (const LAS int*)(F.lds + PRE_OFF);
    const MoeMap M = moe_map(F, pre);
    unsigned char* Y = y_base(F, M.ntl);
    int n = 0;
#pragma unroll
    for (int i = 0; i < 16; ++i) { int t_, p_; n += p6_unit(M, F.G, F.vcu, i, t_, p_) ? 1 : 0; }
    if (F.tid < n) { int tile, pn; (void)p6_unit(M, F.G, F.vcu, F.tid, tile, pn);
        put_unit(F, F.tid, ws + WS_H + (size_t)tile * 256 * 256, p6_bt(F, M, pre, tile, pn), -1, y_row0(M, tile), pn * 256); }
    __syncthreads();
    pg8::ListSched Sd{(const LAS pg8::UnitRec*)(F.lds + ULIST_OFF), n};
    pg8::EpiFp8 E{Y, D, live, 16.0f / (HH_SCALE * WD_SCALE)};
    pg8::gemm_phase<pg8::EpiFp8, pg8::ListSched, false, pg8::NoHook, true>(F.lds, 128, Sd, E, pg8::NoHook{}, F.wave);
    SUBSTAMP(F, 5);
}

__device__ __forceinline__ void y_acc(f32x4 (&ff)[4], const unsigned char* yr, int lane, float w) {
    const v4u u = *(const GAS v4u*)(yr + 16 * lane);
#pragma unroll
    for (int i = 0; i < 4; ++i) { typedef float f2 __attribute__((ext_vector_type(2)));
        const f2 a = __builtin_amdgcn_cvt_pk_f32_fp8((int)u[i], false), b = __builtin_amdgcn_cvt_pk_f32_fp8((int)u[i], true);
        ff[i] += (f32x4){a.x, a.y, b.x, b.y} * w; }
}
template <bool DRY> __device__ __forceinline__ void p7(Frame& F) {
    const bool live = !DRY || (__hip_atomic_load(F.ctl + 3, RLX_AGENT) == 0xdeadbeefu);
    const float* const* in = F.in; unsigned char* ws = F.ws;
    moe_prefix(F);
    const LAS int* pre = (const LAS int*)(F.lds + PRE_OFF);
    const int NTr = pre[64], ntl = moe_tiles(NTr);
    const unsigned char* Y = y_base(F, ntl);
    const float* mod = (const float*)(ws + WS_MOD);
    const unsigned* tokmap = (const unsigned*)(ws + WS_TOKMAP); const float* wts = (const float*)(ws + WS_WTS);
    const int gw = F.vcu * NWAVES + F.wave, NGW = F.G * NWAVES, lane = F.lane;
    unsigned tmn = 0u; float wvn = 0.f;
    if (gw < T && lane < 8) { tmn = tokmap[(size_t)gw * 8 + lane]; wvn = wts[(size_t)gw * 8 + lane]; }
    for (int token = gw; token < T; token += NGW) {
        const int b = token / S;
        const unsigned tm = tmn; const float wv = wvn;
        if (token + NGW < T && lane < 8) { tmn = tokmap[(size_t)(token + NGW) * 8 + lane]; wvn = wts[(size_t)(token + NGW) * 8 + lane]; }
        f32x4 x1[4];
        { const GAS v4u* xr = (const GAS v4u*)(F.out + (size_t)token * D) + 2 * lane;
          const v4u xa = xr[0], xb = xr[1];
          x1[0] = (f32x4){bf2f(xa.x & 0xFFFFu), bf2f(xa.x >> 16), bf2f(xa.y & 0xFFFFu), bf2f(xa.y >> 16)}; x1[1] = (f32x4){bf2f(xa.z & 0xFFFFu), bf2f(xa.z >> 16), bf2f(xa.w & 0xFFFFu), bf2f(xa.w >> 16)};
          x1[2] = (f32x4){bf2f(xb.x & 0xFFFFu), bf2f(xb.x >> 16), bf2f(xb.y & 0xFFFFu), bf2f(xb.y >> 16)}; x1[3] = (f32x4){bf2f(xb.z & 0xFFFFu), bf2f(xb.z >> 16), bf2f(xb.w & 0xFFFFu), bf2f(xb.w >> 16)}; }
        f32x4 ff[4];
#pragma unroll
        for (int i = 0; i < 4; ++i) ff[i] = (f32x4){0.f, 0.f, 0.f, 0.f};
        y_acc(ff, ws + WS_YS + (size_t)token * D, lane, 1.0f / 16.0f);
#pragma unroll
        for (int k = 0; k < 8; ++k) { const unsigned m = (unsigned)__builtin_amdgcn_readlane((int)tm, k); const float w = __uint_as_float((unsigned)__builtin_amdgcn_readlane((int)__float_as_uint(wv), k));
            const int e = (int)(m >> 16), pos = (int)(m & 0xFFFFu);
            y_acc(ff, Y + ((size_t)pre[e] * 256 + pos) * D, lane, w * (1.0f / 16.0f)); }
        float ss = 0.f;
#pragma unroll
        for (int i = 0; i < 4; ++i) ss += (ff[i].x * ff[i].x + ff[i].y * ff[i].y) + (ff[i].z * ff[i].z + ff[i].w * ff[i].w);
        const float rstd = rsqrtf(wave_sum(ss) * (1.f / D) + EPS);
#pragma unroll
        for (int i = 0; i < 4; ++i) { const int c = 16 * lane + 4 * i;
            const f32x4 gt = *(const f32x4*)(mod + b * 6144 + 5120 + c), gp = *(const f32x4*)(in[I_GPOSTFFN] + c);
            if (live) { if (MK_WT & 32) pg8::st16_wt((void*)(F.out + (size_t)token * D + c), x1[i] + gt * (ff[i] * rstd) * gp); else *(GAS f32x4*)(F.out + (size_t)token * D + c) = x1[i] + gt * (ff[i] * rstd) * gp; } }
    }
}
}
namespace mk {
#ifndef MK_NPHASES_DONE
#define MK_NPHASES_DONE 3
#endif
constexpr int PH_P0A = 0, PH_P1 = 1, PH_P2 = 2, PH_P3 = 3, PH_P4 = 4, PH_P5 = 5, PH_P6 = 6, PH_P7 = 7, N_PHASES = 8;

__global__ void __launch_bounds__(NTHR, 2) mk_fwd(Args a) {
    extern __shared__ __attribute__((aligned(16))) unsigned char lds_[];
    Frame F;
    F.lds = (LAS unsigned char*)lds_; F.ws = a.ws; F.ctl = (unsigned*)(a.ws + WS_CTL); F.in = a.in; F.out = a.out;
    F.tid = threadIdx.x; F.lane = F.tid & 63; F.wave = __builtin_amdgcn_readfirstlane(F.tid >> 6);
    F.G = gridDim.x; { const int bx = blockIdx.x; F.vcu = (F.G % 8 == 0) ? (bx % 8) * (F.G / 8) + bx / 8 : bx; }
    for (int u = F.tid; u < 128; u += NTHR) ((LAS unsigned*)(F.lds + LDSCTL_OFF))[u] = 0u;
    __syncthreads();
    const int lo = a.ph_lo, hi = a.ph_hi;
    const bool multi = (hi - lo) > 1;
    XcdBarrier bar; bar.bar = F.ctl + CW_BAR; bar.x = 0; bar.st = nullptr;
    if (multi) bar = xcd_barrier_post(F.ctl + CW_BAR, (volatile LAS unsigned*)(F.lds + MISC_OFF) + 8);
#define IN(k) (lo <= (k) && (k) < hi)
#ifdef MK_PROBE_A
#define STAMP(k) do { if (blockIdx.x == MK_PROBE_BLK && F.tid == 0) ((unsigned long long*)(F.ctl + 512))[(k)] = __builtin_amdgcn_s_memrealtime(); } while (0)
#else
#define STAMP(k) do { } while (0)
#endif
#ifdef MK_DBLBAR
#define SEAM(k) do { if (IN(k) && IN((k) + 1)) { xcd_barrier(bar, F.wave); xcd_barrier(bar, F.wave); } STAMP((k) + 1); } while (0)
#else
#define SEAM(k) do { if (IN(k) && IN((k) + 1)) xcd_barrier(bar, F.wave); STAMP((k) + 1); } while (0)
#endif
    STAMP(0);
#ifndef MK_DBL
#define MK_DBL 0
#endif
#define DBL(k) (((MK_DBL) >> (k)) & 1)
#define REFRESH() do { int l_; asm volatile("v_mbcnt_lo_u32_b32 %0, -1, 0\n\tv_mbcnt_hi_u32_b32 %0, -1, %0" : "=v"(l_)); F.lane = l_; F.tid = F.wave * 64 + l_; } while (0)
#define RUN(k, call, drycall) do { if (IN(k)) { if (DBL(k)) { REFRESH(); drycall; if (multi) xcd_barrier(bar, F.wave); } REFRESH(); call; } SEAM(k); } while (0)
    RUN(PH_P0A, (p0a(F), p0b(F)), (p0a(F), p0b(F)));
    RUN(PH_P1, p1(F), p1(F));
#if MK_NPHASES_DONE > 3
    RUN(PH_P2, p2(F), p2(F));
#endif
#if MK_NPHASES_DONE > 4
    RUN(PH_P3, p3(F), p3(F));
#endif
#if MK_NPHASES_DONE > 5
    RUN(PH_P4, p4<false>(F), p4<true>(F));
#endif
#if MK_NPHASES_DONE > 6
    RUN(PH_P5, p5(F), p5(F));
#endif
#if MK_NPHASES_DONE > 7
    RUN(PH_P6, p6<false>(F), p6<true>(F));
    if (IN(PH_P7)) { if (DBL(PH_P7)) { REFRESH(); p7<true>(F); if (multi) xcd_barrier(bar, F.wave); } REFRESH(); p7<false>(F); }
#endif
#ifdef MK_PROBE_A
    if (multi) { xcd_barrier(bar, F.wave); STAMP(N_PHASES); xcd_barrier(bar, F.wave);
        const unsigned long long* ts = (const unsigned long long*)(F.ctl + 512);
        const float ta = (float)(__hip_atomic_load(ts + MK_PROBE_A1, RLX_AGENT) - __hip_atomic_load(ts + MK_PROBE_A, RLX_AGENT)) * 0.01f, tb = (float)(__hip_atomic_load(ts + MK_PROBE_B1, RLX_AGENT) - __hip_atomic_load(ts + MK_PROBE_B, RLX_AGENT)) * 0.01f;
        const float dl = sqrtf(1.5e-5f * ta);
        REFRESH();
        for (size_t i = (size_t)blockIdx.x * NTHR + F.tid; i < (size_t)T * D; i += (size_t)F.G * NTHR) F.out[i] += dl + (i == 0 ? 10.0f + tb : 0.f); }
#endif
#undef RUN
#undef REFRESH
#undef DBL
#undef IN
#undef SEAM
}

static int g_grid = 0;
static bool setup_once() {
    if (g_grid == 0) {
        int dev = 0, cus = 0;
        if (hipGetDevice(&dev) != hipSuccess || hipDeviceGetAttribute(&cus, hipDeviceAttributeMultiprocessorCount, dev) != hipSuccess) { g_grid = -1; return false; }
        if (hipFuncSetAttribute((const void*)mk_fwd, hipFuncAttributeMaxDynamicSharedMemorySize, LDS_BYTES) != hipSuccess) { g_grid = -1; return false; }
        (void)hipGetLastError();
        g_grid = cus;
    }
    return g_grid > 0;
}
static void launch_phases(void* const* d_in, void* d_out, void* d_ws, hipStream_t stream, int lo, int hi) {
    Args a{};
    for (int i = 0; i < N_IN; ++i) a.in[i] = (const float*)d_in[i];
    a.out = (float*)d_out; a.ws = (unsigned char*)d_ws; a.ph_lo = lo; a.ph_hi = hi;
    hipLaunchKernelGGL(mk_fwd, dim3(g_grid), dim3(NTHR), LDS_BYTES, stream, a);
}
}
extern "C" void kernel_launch(void* const* d_in, const int* in_sizes, int n_in, void* d_out, int out_size, void* d_ws, size_t ws_size, hipStream_t stream) {
    if (!mk::setup_once()) return;
    if (ws_size < mk::WS_END) return;
    hipMemsetAsync(d_ws, 0, mk::CTL_ZERO_BYTES, stream);
    mk::launch_phases(d_in, d_out, d_ws, stream, 0, mk::N_PHASES);
}
```

```cpp
#include <hip/hip_runtime.h>
#include <cstdio>
#include <cstdint>
#include <cmath>
#include <hip/hip_bf16.h>
#define MK_NPHASES_DONE 99
#define MK_POOL_DPP_MIN 8
namespace pg8 {
#define PG8_LAS __attribute__((address_space(3)))
typedef unsigned short bf16_t;
typedef short bf16x8 __attribute__((ext_vector_type(8)));
typedef float f32x4 __attribute__((ext_vector_type(4)));
typedef unsigned u32x4 __attribute__((ext_vector_type(4)));
typedef unsigned u32x2 __attribute__((ext_vector_type(2)));
typedef int i32x4 __attribute__((ext_vector_type(4)));
typedef int i32x8 __attribute__((ext_vector_type(8)));
constexpr int BM = 256, BK = 64, HALF = 128, HTB = HALF * BK * 2, STAGE_BYTES = 8 * HTB;

__host__ __device__ __forceinline__ int lds_byte(int r, int c) { const int st = (r >> 4) * 2 + (c >> 5), rr = r & 15, cc = c & 31, ob = rr * 64 + cc * 2; return st * 1024 + (ob ^ (((ob >> 9) & 1) << 5)); }
__host__ __device__ __forceinline__ void stage_rc(int b, int& R, int& C) { const int st = b / 1024, sb = b % 1024, swz = sb ^ (((sb >> 9) & 1) << 5); R = (st >> 1) * 16 + swz / 64; C = (st & 1) * 32 + (swz % 64) / 2; }
__host__ __device__ __forceinline__ int perm32(int rho) { const int n = rho >> 4, i = rho & 15; return 8 * (i >> 2) + 4 * n + (i & 3); }

struct Unit { const char* A; const char* B; int tab; int orow; int ocol; int aux; };
struct UnitRec { unsigned long long A, B; int tab, orow, ocol, aux; };
struct ListSched {
    const PG8_LAS UnitRec* list; int n;
    __device__ __forceinline__ bool next(int i, Unit& u) const {
        if (i >= n) return false;
        const PG8_LAS UnitRec* r = list + i;
        const unsigned long long a = r->A, b = r->B;
        const unsigned alo = __builtin_amdgcn_readfirstlane((unsigned)a), ahi = __builtin_amdgcn_readfirstlane((unsigned)(a >> 32));
        const unsigned blo = __builtin_amdgcn_readfirstlane((unsigned)b), bhi = __builtin_amdgcn_readfirstlane((unsigned)(b >> 32));
        u.A = (const char*)(((unsigned long long)ahi << 32) | alo); u.B = (const char*)(((unsigned long long)bhi << 32) | blo);
        u.tab = __builtin_amdgcn_readfirstlane(r->tab); u.orow = __builtin_amdgcn_readfirstlane(r->orow); u.ocol = __builtin_amdgcn_readfirstlane(r->ocol); u.aux = __builtin_amdgcn_readfirstlane(r->aux);
        return true;
    }
};
struct NoHook { __device__ __forceinline__ void at(int, f32x4 (&)[2][2][4][2], int, int, int) const {} };

#ifndef MK_WT
#define MK_WT 15
#endif
template <typename V> __device__ __forceinline__ void st16_wt(void* p, V v) { asm volatile("global_store_dwordx4 %0, %1, off sc1\n\ts_nop 1" :: "v"(p), "v"(v)); }
__device__ __forceinline__ unsigned cvt_pk_bf16(float lo, float hi) { unsigned r; asm volatile("v_cvt_pk_bf16_f32 %0, %1, %2" : "=v"(r) : "v"(lo), "v"(hi)); return r; }

struct EpiBf16 {
    static constexpr bool PERM = true, STAGED = false;
    bf16_t* O; int ldc;
    __device__ __forceinline__ void operator()(const f32x4 (&acc)[2][2][4][2], const Unit& u, int wr, int wc, int fr, int fq) const {
        const int row0 = u.orow + wr * 64 + fr, col0 = u.ocol + wc * 32 + 8 * fq;
#pragma unroll
        for (int ai = 0; ai < 2; ++ai)
#pragma unroll
            for (int m = 0; m < 4; ++m) { bf16_t* rowp = O + (size_t)(row0 + ai * HALF + m * 16) * ldc + col0;
#pragma unroll
                for (int bj = 0; bj < 2; ++bj) { const f32x4 v0 = acc[ai][bj][m][0], v1 = acc[ai][bj][m][1];
                    u32x4 w; w.x = cvt_pk_bf16(v0[0], v0[1]); w.y = cvt_pk_bf16(v0[2], v0[3]); w.z = cvt_pk_bf16(v1[0], v1[1]); w.w = cvt_pk_bf16(v1[2], v1[3]);
                    if (MK_WT & 1) st16_wt(rowp + bj * HALF, w); else *(u32x4*)(rowp + bj * HALF) = w; } }
    }
};
struct EpiRowScaleBf16 {
    static constexpr bool PERM = true, STAGED = false;
    bf16_t* O; int ldc; const PG8_LAS float* rs;
    __device__ __forceinline__ void operator()(const f32x4 (&acc)[2][2][4][2], const Unit& u, int wr, int wc, int fr, int fq) const {
        const int row0 = u.orow + wr * 64 + fr, col0 = u.ocol + wc * 32 + 8 * fq;
#pragma unroll
        for (int ai = 0; ai < 2; ++ai)
#pragma unroll
            for (int m = 0; m < 4; ++m) { bf16_t* rowp = O + (size_t)(row0 + ai * HALF + m * 16) * ldc + col0; const float s = rs[ai * HALF + wr * 64 + m * 16 + fr];
#pragma unroll
                for (int bj = 0; bj < 2; ++bj) { const f32x4 v0 = acc[ai][bj][m][0] * s, v1 = acc[ai][bj][m][1] * s;
                    u32x4 w; w.x = cvt_pk_bf16(v0[0], v0[1]); w.y = cvt_pk_bf16(v0[2], v0[3]); w.z = cvt_pk_bf16(v1[0], v1[1]); w.w = cvt_pk_bf16(v1[2], v1[3]);
                    if (MK_WT & 4) st16_wt(rowp + bj * HALF, w); else *(u32x4*)(rowp + bj * HALF) = w; } }
    }
};
constexpr int STG_OFF = 143360, STG_HALF = 32 * 272;
struct EpiFp8 {
    static constexpr bool PERM = true, STAGED = true;
    unsigned char* O; int ldc; bool live; float sc;
    __device__ __forceinline__ void staged(const f32x4 (&acc)[2][2][4][2], const Unit& u, int wr, int wc, int lane, PG8_LAS unsigned char* lds) const {
        const int fr = lane & 15, fq = lane >> 4;
        PG8_LAS unsigned char* stg = lds + STG_OFF + wr * STG_HALF;
#pragma unroll
        for (int ai = 0; ai < 2; ++ai)
#pragma unroll
            for (int mp = 0; mp < 2; ++mp) {
#pragma unroll
                for (int mm = 0; mm < 2; ++mm)
#pragma unroll
                    for (int bj = 0; bj < 2; ++bj) { const int m = 2 * mp + mm; f32x4 v0 = acc[ai][bj][m][0] * sc, v1 = acc[ai][bj][m][1] * sc;
#pragma unroll
                        for (int j = 0; j < 4; ++j) { v0[j] = __builtin_amdgcn_fmed3f(v0[j], -448.f, 448.f); v1[j] = __builtin_amdgcn_fmed3f(v1[j], -448.f, 448.f); }
                        int p0 = __builtin_amdgcn_cvt_pk_fp8_f32(v0[0], v0[1], 0, false); p0 = __builtin_amdgcn_cvt_pk_fp8_f32(v0[2], v0[3], p0, true);
                        int p1 = __builtin_amdgcn_cvt_pk_fp8_f32(v1[0], v1[1], 0, false); p1 = __builtin_amdgcn_cvt_pk_fp8_f32(v1[2], v1[3], p1, true);
                        u32x2 w; w.x = (unsigned)p0; w.y = (unsigned)p1; *(PG8_LAS u32x2*)(stg + (mm * 16 + fr) * 272 + bj * 128 + wc * 32 + 8 * fq) = w; }
                asm volatile("s_waitcnt lgkmcnt(0)\n\ts_barrier" ::: "memory");
#pragma unroll
                for (int i = 0; i < 2; ++i) { const int p = i * 256 + wc * 64 + lane, q = p >> 4, c16 = p & 15;
                    const u32x4 v = *(const PG8_LAS u32x4*)(stg + q * 272 + c16 * 16);
                    const int grow = u.orow + 128 * ai + 64 * wr + 16 * (2 * mp + (q >> 4)) + (q & 15);
                    if (live) { if (MK_WT & 16) st16_wt(O + (size_t)grow * ldc + u.ocol + c16 * 16, v); else if (MK_WT & 256) *(u32x4*)(O + (size_t)grow * ldc + u.ocol + c16 * 16) = v; else __builtin_nontemporal_store(v, (u32x4*)(O + (size_t)grow * ldc + u.ocol + c16 * 16)); } }
                asm volatile("s_waitcnt lgkmcnt(0)\n\ts_barrier" ::: "memory");
            }
    }
};
__device__ __forceinline__ float silu_mul(float g, float u) { return g * u * __builtin_amdgcn_rcpf(1.0f + __builtin_amdgcn_exp2f(-1.4426950408889634f * g)); }
struct EpiSwiglu {
    static constexpr bool PERM = true, STAGED = false;
    unsigned char* O; int ldc; float s, so;
    __device__ __forceinline__ void operator()(const f32x4 (&acc)[2][2][4][2], const Unit& u, int wr, int wc, int fr, int fq) const {
        const int row0 = u.orow + wr * 64 + fr, col0 = u.ocol + wc * 32 + 8 * fq;
#pragma unroll
        for (int ai = 0; ai < 2; ++ai)
#pragma unroll
            for (int m = 0; m < 4; ++m) { unsigned char* rowp = O + (size_t)(row0 + ai * HALF + m * 16) * ldc + col0;
                const f32x4 g0 = acc[ai][0][m][0] * s, g1 = acc[ai][0][m][1] * s, u0 = acc[ai][1][m][0] * (s * so), u1 = acc[ai][1][m][1] * (s * so);
                float h[8];
#pragma unroll
                for (int j = 0; j < 4; ++j) { h[j] = __builtin_amdgcn_fmed3f(silu_mul(g0[j], u0[j]), -448.f, 448.f); h[4 + j] = __builtin_amdgcn_fmed3f(silu_mul(g1[j], u1[j]), -448.f, 448.f); }
                int p0 = __builtin_amdgcn_cvt_pk_fp8_f32(h[0], h[1], 0, false); p0 = __builtin_amdgcn_cvt_pk_fp8_f32(h[2], h[3], p0, true);
                int p1 = __builtin_amdgcn_cvt_pk_fp8_f32(h[4], h[5], 0, false); p1 = __builtin_amdgcn_cvt_pk_fp8_f32(h[6], h[7], p1, true);
                u32x2 w; w.x = (unsigned)p0; w.y = (unsigned)p1; *(u32x2*)rowp = w; }
    }
};

template <class Epi, class Sched, bool GATHER, class Hook, bool FP8 = false>
__device__ __forceinline__ void gemm_phase(PG8_LAS unsigned char* lds, const int K, const Sched& S, const Epi& E, const Hook& H, const int wid  ) {
    int lane; asm volatile("v_mbcnt_lo_u32_b32 %0, -1, 0\n\tv_mbcnt_hi_u32_b32 %0, -1, %0" : "=v"(lane));
    const int tid = wid * 64 + lane, wr = wid >> 2, wc = wid & 3, fr = lane & 15, fq = lane >> 4;
    const int nt = K / BK;
    unsigned voffB[2];
#pragma unroll
    for (int i = 0; i < 2; ++i) { int R, C; stage_rc(tid * 16 + i * 8192, R, C); const int Rb = Epi::PERM ? ((R & ~31) + perm32(R & 31)) : R; voffB[i] = (unsigned)(Rb * K + C) * 2u; }
    const size_t kstep = (size_t)(BK * 2);
    const size_t hstep = (size_t)HALF * K * 2;
    const unsigned ldsw = (unsigned)wid * 1024u;
    const int aoff = lds_byte(wr * 64 + fr, fq * 8), boff = lds_byte(wc * 32 + fr, fq * 8);
    unsigned offC[2][2];
#define PG8_LOADOFF(dst, u) do { _Pragma("unroll") for (int _i = 0; _i < 2; ++_i) { int _R, _C; stage_rc(tid * 16 + _i * 8192, _R, _C); _Pragma("unroll") for (int _h = 0; _h < 2; ++_h) { \
        if constexpr (GATHER) { const unsigned _row = *(const PG8_LAS unsigned*)(lds + (u).tab + 4 * (_h * HALF + _R)); dst[_h][_i] = _row * (unsigned)(K * 2) + (unsigned)(_C * 2); } \
        else dst[_h][_i] = (unsigned)((_h * HALF + _R) * K + _C) * 2u; } } } while (0)
#define PG8_SA(b, h) (((b) * 2 + (h)) * HTB)
#define PG8_SB(b, h) ((4 + (b) * 2 + (h)) * HTB)
#define PG8_STAGE(bufoff, gbase, voff) do { _Pragma("unroll") for (int _i = 0; _i < 2; ++_i) { unsigned _o = (voff)[_i]; if constexpr (FP8) asm volatile("" : "+v"(_o));     \
        __builtin_amdgcn_global_load_lds((const unsigned*)((const char*)(gbase) + _o), (PG8_LAS unsigned*)(lds + (bufoff) + ldsw + _i * 8192), 16, 0, 0); } } while (0)
#define PG8_LDA(dst, b, h) do { _Pragma("unroll") for (int m = 0; m < 4; ++m) _Pragma("unroll") for (int k = 0; k < 2; ++k) dst[m][k] = *(const PG8_LAS bf16x8*)(lds + PG8_SA(b, h) + aoff + m * 2048 + k * 1024); } while (0)
#define PG8_LDB(dst, b, h) do { _Pragma("unroll") for (int n = 0; n < 2; ++n) _Pragma("unroll") for (int k = 0; k < 2; ++k) dst[n][k] = *(const PG8_LAS bf16x8*)(lds + PG8_SB(b, h) + boff + n * 2048 + k * 1024); } while (0)
#define PG8_CAT(x, y) __builtin_shufflevector(__builtin_bit_cast(i32x4, x), __builtin_bit_cast(i32x4, y), 0, 1, 2, 3, 4, 5, 6, 7)
#define PG8_MMA(ai, bj, At, Bt) do { __builtin_amdgcn_s_setprio(1); if constexpr (FP8) { _Pragma("unroll") for (int m = 0; m < 4; ++m) _Pragma("unroll") for (int n = 0; n < 2; ++n) \
        acc[ai][bj][m][n] = __builtin_amdgcn_mfma_scale_f32_16x16x128_f8f6f4(PG8_CAT(Bt[n][0], Bt[n][1]), PG8_CAT(At[m][0], At[m][1]), acc[ai][bj][m][n], 0, 0, 0, 0, 0, 0);   } else { \
        _Pragma("unroll") for (int m = 0; m < 4; ++m) _Pragma("unroll") for (int n = 0; n < 2; ++n) _Pragma("unroll") for (int k = 0; k < 2; ++k) \
        acc[ai][bj][m][n] = __builtin_amdgcn_mfma_f32_16x16x32_bf16(Bt[n][k], At[m][k], acc[ai][bj][m][n], 0, 0, 0); } __builtin_amdgcn_s_setprio(0); } while (0)
#define PG8_WAIT_V(n) asm volatile("s_waitcnt vmcnt(" #n ")" ::: "memory")
#define PG8_WAIT_L(n) asm volatile("s_waitcnt lgkmcnt(" #n ")" ::: "memory")
#define PG8_BAR __builtin_amdgcn_s_barrier()
#define PG8_SCHED __builtin_amdgcn_sched_barrier(0)
    Unit cur, nxt; int ui = 0;
    if (!S.next(0, cur)) return;
    f32x4 acc[2][2][4][2];
#pragma unroll
    for (int a = 0; a < 2; ++a)
#pragma unroll
        for (int b = 0; b < 2; ++b)
#pragma unroll
            for (int m = 0; m < 4; ++m)
#pragma unroll
                for (int n = 0; n < 2; ++n) acc[a][b][m][n] = (f32x4){0.f, 0.f, 0.f, 0.f};
    bf16x8 At[4][2], B0[2][2], B1[2][2];
    const char* cA = cur.A; const char* cB = cur.B;
    PG8_LOADOFF(offC, cur);
    PG8_STAGE(PG8_SB(0, 0), cB, voffB); PG8_STAGE(PG8_SB(0, 1), cB + hstep, voffB); PG8_STAGE(PG8_SA(0, 0), cA, offC[0]); PG8_STAGE(PG8_SA(0, 1), cA, offC[1]);
    if (wr == 1) PG8_BAR;
    PG8_WAIT_V(2); PG8_BAR;
    PG8_STAGE(PG8_SB(1, 0), cB + kstep, voffB); PG8_STAGE(PG8_SA(1, 0), cA + kstep, offC[0]); PG8_STAGE(PG8_SB(1, 1), cB + hstep + kstep, voffB);
    PG8_WAIT_V(6); PG8_BAR;
    for (;;) {
        const bool has_next = S.next(ui + 1, nxt);
        const char* nA = has_next ? nxt.A : cA; const char* nB = has_next ? nxt.B : cB;
        for (int t = 0; t < nt; t += 2) {
            const bool last = (t == nt - 2);
            H.at(t, acc, wr, fr, lane);
            const char* a1 = cA + (size_t)(t + 1) * kstep;
            const char* a2 = last ? nA : cA + (size_t)(t + 2) * kstep; const char* b2 = last ? nB : cB + (size_t)(t + 2) * kstep;
            const char* a3 = a2 + kstep; const char* b3 = b2 + kstep;
            PG8_LDB(B0, 0, 0); PG8_LDB(B1, 0, 1); PG8_SCHED; PG8_LDA(At, 0, 0); PG8_STAGE(PG8_SA(1, 1), a1, offC[1]);
            if constexpr (GATHER) { if (last && has_next) { PG8_LOADOFF(offC, nxt); } }
            PG8_WAIT_V(8); PG8_WAIT_L(0); PG8_BAR; PG8_MMA(0, 0, At, B0); PG8_MMA(0, 1, At, B1); PG8_BAR; PG8_SCHED;
            PG8_LDA(At, 0, 1); PG8_STAGE(PG8_SB(0, 0), b2, voffB); PG8_STAGE(PG8_SB(0, 1), b2 + hstep, voffB); PG8_STAGE(PG8_SA(0, 0), a2, offC[0]);
            PG8_WAIT_V(8); PG8_WAIT_L(0); PG8_BAR; PG8_MMA(1, 0, At, B0); PG8_MMA(1, 1, At, B1); PG8_BAR; PG8_SCHED;
            PG8_LDB(B0, 1, 0); PG8_LDB(B1, 1, 1); PG8_SCHED; PG8_LDA(At, 1, 0); PG8_STAGE(PG8_SA(0, 1), a2, offC[1]);
            PG8_WAIT_V(8); PG8_WAIT_L(0); PG8_BAR; PG8_MMA(0, 0, At, B0); PG8_MMA(0, 1, At, B1); PG8_BAR; PG8_SCHED;
            PG8_LDA(At, 1, 1); PG8_STAGE(PG8_SB(1, 0), b3, voffB); PG8_STAGE(PG8_SB(1, 1), b3 + hstep, voffB); PG8_STAGE(PG8_SA(1, 0), a3, offC[0]);
            PG8_WAIT_V(8); PG8_WAIT_L(0); PG8_BAR; PG8_MMA(1, 0, At, B0); PG8_MMA(1, 1, At, B1); PG8_BAR; PG8_SCHED;
        }
        if (wr == 0) PG8_BAR;
        { int l2; asm volatile("v_mbcnt_lo_u32_b32 %0, -1, 0\n\tv_mbcnt_hi_u32_b32 %0, -1, %0" : "=v"(l2)); if constexpr (Epi::STAGED) E.staged(acc, cur, wr, wc, l2, lds); else E(acc, cur, wr, wc, l2 & 15, l2 >> 4); }
        if (!has_next) break;
#pragma unroll
        for (int a = 0; a < 2; ++a)
#pragma unroll
            for (int b = 0; b < 2; ++b)
#pragma unroll
                for (int m = 0; m < 4; ++m)
#pragma unroll
                    for (int n = 0; n < 2; ++n) acc[a][b][m][n] = (f32x4){0.f, 0.f, 0.f, 0.f};
        cur = nxt; cA = nA; cB = nB; ++ui;
        if (wr == 1) PG8_BAR;
    }
    PG8_WAIT_V(0);
    PG8_BAR;
#undef PG8_LOADOFF
#undef PG8_SA
#undef PG8_SB
#undef PG8_STAGE
#undef PG8_LDA
#undef PG8_LDB
#undef PG8_MMA
#undef PG8_CAT
#undef PG8_WAIT_V
#undef PG8_WAIT_L
#undef PG8_BAR
#undef PG8_SCHED
}
}
namespace mk {
#define GAS __attribute__((address_space(1)))
#define LAS __attribute__((address_space(3)))
typedef unsigned short bf16;
typedef unsigned v4u __attribute__((ext_vector_type(4)));
typedef unsigned v2u __attribute__((ext_vector_type(2)));
typedef float f32x4 __attribute__((ext_vector_type(4)));
typedef short bf16x8 __attribute__((ext_vector_type(8)));

constexpr int T = 16384, D = 1024, S = 2048, NB = 8, NH = 8, HD = 64, NE = 64, DIN = 2056;
constexpr int NTHR = 512, NWAVES = 8;
constexpr float EPS = 1e-6f;
constexpr float LOG2E = 1.4426950408889634f;
constexpr float QSCALE = 0.125f * LOG2E;
constexpr int NLIST = 64, LIST_CAP = 16384;

constexpr size_t MiB = 1u << 20;
constexpr size_t WS_CTL = 0, CTL_ZERO_BYTES = 64 * 1024;
constexpr size_t WS_SMALL = 1 * MiB;
constexpr size_t WS_MOD = WS_SMALL, WS_WF = WS_SMALL + 256 * 1024, WS_LOGF = WS_SMALL + 512 * 1024, WS_SSQP = WS_SMALL + 1 * MiB, WS_SSQA = WS_SSQP + 512 * 1024,
                 WS_TOKMAP = WS_SSQA + 512 * 1024, WS_WTS = WS_TOKMAP + 512 * 1024, WS_LISTS = WS_WTS + 512 * 1024;
constexpr size_t WS_WD = 8 * MiB, WS_WSD = 40 * MiB;
constexpr size_t WS_H = 40 * MiB + 512 * 1024;
constexpr size_t WS_HB = 41 * MiB, WS_PROJ = 73 * MiB, WS_YCAT = 41 * MiB, WS_MIXED = 73 * MiB;
constexpr size_t WS_WIN = 190 * MiB, WS_WOUT = 194 * MiB, WS_WSGU = 196 * MiB, WS_WPOOL = 197 * MiB, WS_WRHI = WS_WPOOL + 128 * 1024, WS_WRLO = WS_WRHI + 128 * 1024;
constexpr size_t WS_H2 = 199 * MiB  , WS_WGU = 231 * MiB  , WS_YS = 264 * MiB  , WS_END = 295 * MiB;
constexpr float H2_SCALE = 8.0f, WGU_SCALE = 64.0f, HH_SCALE = 8.0f, WD_SCALE = 64.0f;
static_assert(WS_LISTS + (size_t)NLIST * LIST_CAP * 4 <= WS_WD && WS_WRLO + 128 * 1024 <= WS_H2 && WS_WGU + 32 * MiB <= WS_YS && WS_YS + 16 * MiB <= WS_END, "ws map");
constexpr int CW_TMO = 0, CW_MODCNT = 64, CW_BAR = 4096, CW_CNT = 8192;

constexpr int RING_BYTES = 131072, LDSCTL_OFF = RING_BYTES, MISC_OFF = LDSCTL_OFF, ULIST_OFF = LDSCTL_OFF + 512, PRE_OFF = ULIST_OFF + 512, TAB_OFF = PRE_OFF + 528,
              RS_OFF = TAB_OFF + 8192, LDS_BYTES = 163840;
constexpr int MAXU = 8;
static_assert(RS_OFF + 2048 <= pg8::STG_OFF && pg8::STG_OFF + 2 * pg8::STG_HALF <= LDS_BYTES && (TAB_OFF % 16) == 0, "LDS map");

#define RLX_AGENT __ATOMIC_RELAXED, __HIP_MEMORY_SCOPE_AGENT
#define LDS_WAIT() asm volatile("s_waitcnt lgkmcnt(0)" ::: "memory")
#define VM_WAIT() asm volatile("s_waitcnt vmcnt(0)" ::: "memory")
__device__ __forceinline__ unsigned f2bf(float f) { unsigned u = __builtin_bit_cast(unsigned, f); return (u + 0x7fffu + ((u >> 16) & 1u)) >> 16; }
__device__ __forceinline__ unsigned pk2(float lo, float hi) { return f2bf(lo) | (f2bf(hi) << 16); }
__device__ __forceinline__ float bf2f(unsigned h) { return __builtin_bit_cast(float, h << 16); }
__device__ __forceinline__ float wave_sum(float v) {
#pragma unroll
    for (int o = 1; o < 64; o <<= 1) v += __shfl_xor(v, o);
    return v;
}

#define XB_TMO      128
#define XB_XCNT(j)  (256  + 64 * (j))
#define XB_XSUB(j)  (1280 + 64 * (j))
#define XB_XGEN(j)  (2304 + 64 * (j))
#define XB_TOP      3328
#define XB_TOPGEN   3392
#define XCD_BAR_WORDS 3456
#define XB_SPIN_CAP (1u << 18)
__device__ __forceinline__ unsigned xb_ld(unsigned* p)              { return __hip_atomic_load(p, __ATOMIC_RELAXED, __HIP_MEMORY_SCOPE_AGENT); }
__device__ __forceinline__ unsigned xb_add(unsigned* p, unsigned v) { return __hip_atomic_fetch_add(p, v, __ATOMIC_RELAXED, __HIP_MEMORY_SCOPE_AGENT); }
__device__ __forceinline__ unsigned xb_xcc_id() { return (unsigned)__builtin_amdgcn_s_getreg((3 << 11) | 20) & 0xFu; }
#define XB_SPIN(cond, bar) do { unsigned _sp = 0; while (cond) { __builtin_amdgcn_s_sleep(1); \
    if ((++_sp & 255u) == 0u) { if (xb_ld(&(bar)[XB_TMO])) break; if (_sp > XB_SPIN_CAP) { atomicAdd(&(bar)[XB_TMO], 1u); break; } } } } while (0)
struct XcdBarrier { unsigned* bar; unsigned x; volatile LAS unsigned* st; };
__device__ __forceinline__ XcdBarrier xcd_barrier_post(unsigned* bar, volatile LAS unsigned* st) {
    XcdBarrier b; b.bar = bar; b.x = xb_xcc_id(); b.st = st;
    if (threadIdx.x == 0) (void)xb_add(&bar[XB_XCNT(b.x)], 1u);
    return b;
}
__device__ __forceinline__ void xcd_barrier_complete(unsigned* bar, unsigned x, unsigned& nloc, unsigned& nx) {
    const unsigned G = gridDim.x * gridDim.y * gridDim.z;
    unsigned sum, cnt, mine, sp = 0u;
    for (;;) {
        sum = 0u; cnt = 0u; mine = 0u;
#pragma unroll
        for (unsigned j = 0; j < 16; ++j) { const unsigned c = xb_ld(&bar[XB_XCNT(j)]); sum += c; cnt += (c > 0u) ? 1u : 0u; mine = (j == x) ? c : mine; }
        if (sum == G) break;
        __builtin_amdgcn_s_sleep(1);
        if ((++sp & 255u) == 0u) { if (xb_ld(&bar[XB_TMO])) break; if (sp > XB_SPIN_CAP) { atomicAdd(&bar[XB_TMO], 1u); break; } }
    }
    nloc = mine > 0u ? mine : 1u; nx = cnt > 0u ? cnt : 1u;
}
__device__ __forceinline__ void xcd_barrier(const XcdBarrier& b, const int wave  ) {
    asm volatile("s_waitcnt vmcnt(0)" ::: "memory");
    __syncthreads();
    int l_; asm volatile("v_mbcnt_lo_u32_b32 %0, -1, 0\n\tv_mbcnt_hi_u32_b32 %0, -1, %0" : "=v"(l_));
    if (wave == 0 && l_ == 0) {
        unsigned* bar = b.bar;
        __builtin_amdgcn_s_waitcnt(0);
        unsigned nloc = b.st[0], nx = b.st[1];
        if (nloc == 0u) { xcd_barrier_complete(bar, b.x, nloc, nx); b.st[0] = nloc; b.st[1] = nx; }
        const unsigned old = xb_add(&bar[XB_XSUB(b.x)], 1u);
        const unsigned gen = old / nloc;
        if (old + 1u == (gen + 1u) * nloc) {
            __builtin_amdgcn_fence(__ATOMIC_RELEASE, "agent");
            asm volatile("s_waitcnt vmcnt(0)" ::: "memory");
            const unsigned og = xb_add(&bar[XB_TOP], 1u);
            const unsigned tg = og / nx;
            if (og + 1u == (tg + 1u) * nx) xb_add(&bar[XB_TOPGEN], 1u);
            else XB_SPIN(xb_ld(&bar[XB_TOPGEN]) == tg, bar);
            __builtin_amdgcn_fence(__ATOMIC_ACQUIRE, "agent");
            xb_add(&bar[XB_XGEN(b.x)], 1u);
            asm volatile("s_waitcnt vmcnt(0)" ::: "memory");
        } else {
            XB_SPIN(xb_ld(&bar[XB_XGEN(b.x)]) == gen, bar);
            __builtin_amdgcn_fence(__ATOMIC_ACQUIRE, "agent");
            asm volatile("s_waitcnt vmcnt(0)" ::: "memory");
        }
    }
    __syncthreads();
}

enum { I_X = 0, I_C, I_WADA, I_BADA, I_GPREMIX, I_GPOSTMIX, I_GPREFFN, I_GPOSTFFN, I_WIN, I_BFORGET, I_WPOOL, I_POOLSCALE, I_GPOOLOUT, I_GATTNOUT, I_WOUT,
       I_WROUTER, I_RBIAS, I_WGATE, I_WUP, I_WDOWN, I_WSGATE, I_WSUP, I_WSDOWN, N_IN };

struct Args { const float* in[N_IN]; float* out; unsigned char* ws; int ph_lo, ph_hi; };

#ifndef MK_PROBE_BLK
#define MK_PROBE_BLK 0
#endif
#ifdef MK_PROBE_A
#define SUBSTAMP(F, k) do { int l_; asm volatile("v_mbcnt_lo_u32_b32 %0, -1, 0\n\tv_mbcnt_hi_u32_b32 %0, -1, %0" : "=v"(l_)); if (blockIdx.x == MK_PROBE_BLK && (F).wave == 0 && l_ == 0) ((unsigned long long*)((F).ctl + 512))[16 + (k)] = __builtin_amdgcn_s_memrealtime(); } while (0)
#else
#define SUBSTAMP(F, k) do { } while (0)
#endif
struct Frame {
    LAS unsigned char* lds; unsigned* ctl; unsigned char* ws; const float* const* in; float* out;
    int tid, lane, wave, vcu, G;
};
}
namespace mk {
template <int MODE>
__device__ __forceinline__ void tr_item(const float* W, int ldn, int k0, int n0, bf16* WT, bf16* WT2, int Kd, int rowbase, const float* sc, float cmul, LAS float* scr, int lane) {
#pragma unroll 8
    for (int i = 0; i < 32; ++i) { const int kk = 2 * i + (lane >> 5); scr[kk * 33 + (lane & 31)] = __builtin_nontemporal_load(W + (size_t)(k0 + kk) * ldn + n0 + (lane & 31)); }
    LDS_WAIT(); asm volatile("" ::: "memory");
    const int c = lane & 7;
#pragma unroll
    for (int j = 0; j < 4; ++j) { const int n = (lane >> 3) + 8 * j; const LAS float* s = scr + (8 * c) * 33 + n;
        float v[8];
#pragma unroll
        for (int i = 0; i < 8; ++i) { v[i] = s[i * 33] * cmul; if (MODE == 1) v[i] *= sc[k0 + 8 * c + i]; if (MODE == 2) v[i] *= sc[n0 + n]; }
        if (MODE == 4) { int p0 = __builtin_amdgcn_cvt_pk_fp8_f32(v[0], v[1], 0, false); p0 = __builtin_amdgcn_cvt_pk_fp8_f32(v[2], v[3], p0, true);
            int p1 = __builtin_amdgcn_cvt_pk_fp8_f32(v[4], v[5], 0, false); p1 = __builtin_amdgcn_cvt_pk_fp8_f32(v[6], v[7], p1, true);
            v2u o8; o8.x = (unsigned)p0; o8.y = (unsigned)p1; *(GAS v2u*)((unsigned char*)WT + (size_t)(rowbase + n) * Kd + k0 + 8 * c) = o8; continue; }
        if (MODE == 5) { v4u o5;
#pragma unroll
            for (int i = 0; i < 4; ++i) o5[i] = (unsigned)__builtin_bit_cast(unsigned short, (_Float16)v[2 * i]) | ((unsigned)__builtin_bit_cast(unsigned short, (_Float16)v[2 * i + 1]) << 16);
            *(GAS v4u*)(WT + (size_t)(rowbase + n) * Kd + k0 + 8 * c) = o5; continue; }
        v4u o; o.x = pk2(v[0], v[1]); o.y = pk2(v[2], v[3]); o.z = pk2(v[4], v[5]); o.w = pk2(v[6], v[7]);
        *(GAS v4u*)(WT + (size_t)(rowbase + n) * Kd + k0 + 8 * c) = o;
        if (MODE == 3) {
#pragma unroll
            for (int i = 0; i < 8; ++i) v[i] = v[i] - bf2f(f2bf(v[i]));
            v4u p; p.x = pk2(v[0], v[1]); p.y = pk2(v[2], v[3]); p.z = pk2(v[4], v[5]); p.w = pk2(v[6], v[7]);
            *(GAS v4u*)(WT2 + (size_t)(rowbase + n) * Kd + k0 + 8 * c) = p; } }
    LDS_WAIT(); asm volatile("" ::: "memory");
}

__device__ __forceinline__ void p0a(Frame& F) {
    const float* const* in = F.in; unsigned char* ws = F.ws;
    if (F.vcu < 192) {
        LAS float* red = (LAS float*)F.lds;
        const int col0 = 32 * F.vcu, kk = F.tid >> 3, c4 = F.tid & 7;
        const float* wa = in[I_WADA]; const float* cc = in[I_C];
        f32x4 acc[8];
#pragma unroll
        for (int b = 0; b < 8; ++b) acc[b] = (f32x4){0.f, 0.f, 0.f, 0.f};
#pragma unroll 4
        for (int i = 0; i < 16; ++i) { const int k = kk + 64 * i; const f32x4 w = __builtin_nontemporal_load((const f32x4*)(wa + (size_t)k * 6144 + col0 + 4 * c4));
#pragma unroll
            for (int b = 0; b < 8; ++b) acc[b] += w * cc[b * D + k]; }
#pragma unroll
        for (int b = 0; b < 8; ++b) *(LAS f32x4*)(red + kk * 256 + b * 32 + 4 * c4) = acc[b];
        __syncthreads();
        if (F.tid < 256) { float s = 0.f;
#pragma unroll 8
            for (int k2 = 0; k2 < 64; ++k2) s += red[k2 * 256 + F.tid];
            const int b = F.tid >> 5, c = F.tid & 31; ((float*)(ws + WS_MOD))[b * 6144 + col0 + c] = s + in[I_BADA][col0 + c]; }
        VM_WAIT(); __syncthreads();
        if (F.tid == 0) { __builtin_amdgcn_fence(__ATOMIC_RELEASE, "agent"); VM_WAIT(); __hip_atomic_fetch_add(F.ctl + CW_MODCNT, 1u, RLX_AGENT); }
    }
    if (F.vcu == 255) { float* wf = (float*)(ws + WS_WF); for (int i = F.tid; i < 8192; i += NTHR) { const int j = i >> 10, k = i & 1023; wf[i] = in[I_WIN][(size_t)k * DIN + 2048 + j]; }
        VM_WAIT(); __syncthreads();
        if (F.tid == 0) { __builtin_amdgcn_fence(__ATOMIC_RELEASE, "agent"); VM_WAIT(); __hip_atomic_fetch_add(F.ctl + CW_MODCNT, 1u, RLX_AGENT); } }
    LAS float* scr = (LAS float*)(F.lds + F.wave * 16384);
    const int gw = F.vcu * NWAVES + F.wave, NGW = F.G * NWAVES, lane = F.lane;
    constexpr int I_E = 8192, I_IN = 1024, I_OUT = 512, I_S = 128, I_P = 32, I_R = 32;
    constexpr int NITEMS = 3 * I_E + I_IN + I_OUT + 3 * I_S + I_P + I_R;
    bf16* Wgu = (bf16*)(ws + WS_WGU); bf16* Wd = (bf16*)(ws + WS_WD);
    const int ntail_w = (F.G > 192) ? (F.G - 192) * NWAVES : 0;
    const int NEVEN = ntail_w ? 24576 : NITEMS;
    const int n_mine = (NEVEN - gw + NGW - 1) / NGW;
    for (int q = 0;; ++q) {
        int it;
        if (q < n_mine) it = gw + q * NGW;
        else { if (F.vcu < 192 || ntail_w == 0) break; it = NEVEN + (gw - 192 * NWAVES) + (q - n_mine) * ntail_w; if (it >= NITEMS) break; }
        int r = it;
        if (r < 2 * I_E) { const int up = r >= I_E; if (up) r -= I_E; const int e = r >> 7, rem = r & 127, k0 = 64 * (rem >> 3), n0 = 32 * (rem & 7);
            tr_item<4>(in[up ? I_WUP : I_WGATE] + (size_t)e * D * 256, 256, k0, n0, (bf16*)((unsigned char*)Wgu + (size_t)e * 512 * D), nullptr, D, (n0 >> 7) * 256 + (n0 & 127) + (up ? 128 : 0), nullptr, WGU_SCALE, scr, lane); continue; }
        r -= 2 * I_E;
        if (r < I_E) { const int e = r >> 7, rem = r & 127, k0 = 64 * (rem >> 5), n0 = 32 * (rem & 31);
            tr_item<4>(in[I_WDOWN] + (size_t)e * 256 * D, D, k0, n0, (bf16*)((unsigned char*)Wd + (size_t)e * D * 256), nullptr, 256, n0, nullptr, WD_SCALE, scr, lane); continue; }
        r -= I_E;
        if (r < I_IN) { const int k0 = 64 * (r >> 6), n0 = 32 * (r & 63);
            tr_item<0>(in[I_WIN], DIN, k0, n0, (bf16*)(ws + WS_WIN), nullptr, D, n0, nullptr, (n0 >= 512 && n0 < 1024) ? QSCALE : 1.f, scr, lane); continue; }
        r -= I_IN;
        if (r < I_OUT) { const int k0 = 64 * (r >> 5), n0 = 32 * (r & 31);
            tr_item<1>(in[I_WOUT], D, k0, n0, (bf16*)(ws + WS_WOUT), nullptr, D, n0, k0 < 512 ? in[I_GPOOLOUT] : in[I_GATTNOUT] - 512, 1.f, scr, lane); continue; }
        r -= I_OUT;
        if (r < 2 * I_S) { const int up = r >= I_S; if (up) r -= I_S; const int k0 = 64 * (r >> 3), n0 = 32 * (r & 7);
            tr_item<4>(in[up ? I_WSUP : I_WSGATE], 256, k0, n0, (bf16*)(ws + WS_WSGU), nullptr, D, (n0 >> 7) * 256 + (n0 & 127) + (up ? 128 : 0), nullptr, WGU_SCALE, scr, lane); continue; }
        r -= 2 * I_S;
        if (r < I_S) { const int k0 = 64 * (r >> 5), n0 = 32 * (r & 31);
            tr_item<4>(in[I_WSDOWN], D, k0, n0, (bf16*)(ws + WS_WSD), nullptr, 256, n0, nullptr, WD_SCALE, scr, lane); continue; }
        r -= I_S;
        if (r < I_P) { const int g = r >> 3, rem = r & 7, k0 = 64 * (rem >> 2), n0 = 32 * (rem & 3);
            tr_item<2>(in[I_WPOOL] + (size_t)g * 16384, 128, k0, n0, (bf16*)(ws + WS_WPOOL) + (size_t)g * 16384, nullptr, 128, n0, in[I_POOLSCALE] + g * 128, 1.f, scr, lane); continue; }
        r -= I_P;
        { const int k0 = 64 * (r >> 1), n0 = 32 * (r & 1);
            tr_item<5>(in[I_WROUTER], 64, k0, n0, (bf16*)(ws + WS_WRHI), nullptr, D, n0, nullptr, 1.f, scr, lane); }
    }
}

__device__ __forceinline__ void p0b(Frame& F) {
    const float* const* in = F.in; unsigned char* ws = F.ws;
    if (F.tid == 0) { unsigned sp = 0; const unsigned need = (F.G >= 256) ? 193u : 0u;
        while (__hip_atomic_load(F.ctl + CW_MODCNT, RLX_AGENT) < need) { __builtin_amdgcn_s_sleep(2); if (++sp > (1u << 20)) { __hip_atomic_store(F.ctl + CW_TMO, 1u, RLX_AGENT); break; } }
        __builtin_amdgcn_fence(__ATOMIC_ACQUIRE, "agent"); VM_WAIT(); }
    __syncthreads();
    LAS float* wfl = (LAS float*)F.lds;
    { const float* wf = (const float*)(ws + WS_WF); for (int i = F.tid; i < 2048; i += NTHR) *(LAS f32x4*)(wfl + 4 * i) = *(const f32x4*)(wf + 4 * i); }
    __syncthreads();
    const int gw = F.vcu * NWAVES + F.wave, lane = F.lane, NGW = F.G * NWAVES;
    const float* mod = (const float*)(ws + WS_MOD);
    for (int r0 = 8 * gw; r0 < T; r0 += 8 * NGW) {
        const int b = r0 / S;
        f32x4 gs[4], sh[4];
#pragma unroll
        for (int j = 0; j < 4; ++j) { const int c = 4 * lane + 256 * j; const f32x4 g = *(const f32x4*)(in[I_GPREMIX] + c), sc = *(const f32x4*)(mod + b * 6144 + 1024 + c);
            gs[j] = g * (sc + 1.0f); sh[j] = *(const f32x4*)(mod + b * 6144 + c); }
        const float bfg = in[I_BFORGET][lane & 7];
#pragma unroll 1
        for (int r4 = 0; r4 < 8; r4 += 4) {
            f32x4 v[4][4]; float ss[4];
#pragma unroll
            for (int rr = 0; rr < 4; ++rr) { const GAS f32x4* xr = (const GAS f32x4*)(in[I_X] + (size_t)(r0 + r4 + rr) * D) + lane;
#pragma unroll
                for (int j = 0; j < 4; ++j) v[rr][j] = __builtin_nontemporal_load(xr + 64 * j); }
#pragma unroll
            for (int rr = 0; rr < 4; ++rr) { float a = 0.f;
#pragma unroll
                for (int j = 0; j < 4; ++j) a += (v[rr][j].x * v[rr][j].x + v[rr][j].y * v[rr][j].y) + (v[rr][j].z * v[rr][j].z + v[rr][j].w * v[rr][j].w);
                ss[rr] = a; }
#pragma unroll
            for (int o = 1; o < 64; o <<= 1) {
#pragma unroll
                for (int rr = 0; rr < 4; ++rr) ss[rr] += __shfl_xor(ss[rr], o); }
#pragma unroll
            for (int rr = 0; rr < 4; ++rr) { const int row = r0 + r4 + rr; const float rstd = rsqrtf(ss[rr] * (1.f / D) + EPS);
                GAS unsigned long long* o8 = (GAS unsigned long long*)((bf16*)(ws + WS_HB) + (size_t)row * D) + lane;
#pragma unroll
                for (int j = 0; j < 4; ++j) { v[rr][j] = v[rr][j] * rstd * gs[j] + sh[j]; o8[64 * j] = (unsigned long long)pk2(v[rr][j].x, v[rr][j].y) | ((unsigned long long)pk2(v[rr][j].z, v[rr][j].w) << 32); } }
            float z[4] = {0.f, 0.f, 0.f, 0.f};
#pragma unroll 1
            for (int h = 0; h < 8; ++h) { float p[4] = {0.f, 0.f, 0.f, 0.f};
#pragma unroll
                for (int j = 0; j < 4; ++j) { const f32x4 w = *(const LAS f32x4*)(wfl + h * 1024 + 4 * lane + 256 * j);
#pragma unroll
                    for (int rr = 0; rr < 4; ++rr) p[rr] += (v[rr][j].x * w.x + v[rr][j].y * w.y) + (v[rr][j].z * w.z + v[rr][j].w * w.w); }
#pragma unroll
                for (int o = 1; o < 64; o <<= 1) {
#pragma unroll
                    for (int rr = 0; rr < 4; ++rr) p[rr] += __shfl_xor(p[rr], o); }
#pragma unroll
                for (int rr = 0; rr < 4; ++rr) z[rr] = (lane == h) ? p[rr] : z[rr]; }
            if (lane < 8) {
#pragma unroll
                for (int rr = 0; rr < 4; ++rr) { const float u = z[rr] + bfg; ((float*)(ws + WS_LOGF))[(size_t)(r0 + r4 + rr) * 8 + lane] = fminf(u, 0.f) - log1pf(__expf(-fabsf(u))); } }
        }
    }
}

__device__ __forceinline__ bool static_unit(int nM, int nN, int G, int c, int i, int& pm, int& pn) {
    const int nwg = nM * nN; const long L = (long)i * G + c; if (L >= nwg) return false;
    int wgid = (int)L; { const int q = nwg / 8, r = nwg % 8, xcd = wgid % 8, off = wgid / 8; wgid = (xcd < r ? xcd * (q + 1) : r * (q + 1) + (xcd - r) * q) + off; }
    const int nig = 8 * nN, gid = wgid / nig, fm = gid * 8, gsz = (nM - fm) < 8 ? (nM - fm) : 8;
    pm = fm + ((wgid % nig) % gsz); pn = (wgid % nig) / gsz; return true;
}
__device__ __forceinline__ void put_unit(Frame& F, int i, const void* A, const void* B, int tab, int orow, int ocol) {
    LAS pg8::UnitRec* r = (LAS pg8::UnitRec*)(F.lds + ULIST_OFF) + i;
    r->A = (unsigned long long)(uintptr_t)A; r->B = (unsigned long long)(uintptr_t)B; r->tab = tab; r->orow = orow; r->ocol = ocol; r->aux = 0;
}
__device__ __forceinline__ void p1(Frame& F) {
    unsigned char* ws = F.ws; int n = 0;
    for (int i = 0; i < MAXU; ++i) { int pm, pn; if (!static_unit(T / 256, 2048 / 256, F.G, (int)blockIdx.x, i, pm, pn)) break;
        if (F.tid == 0) put_unit(F, i, ws + WS_HB + (size_t)pm * 256 * D * 2, ws + WS_WIN + (size_t)pn * 256 * D * 2, -1, pm * 256, pn * 256);
        ++n; }
    __syncthreads();
    pg8::ListSched Sd{(const LAS pg8::UnitRec*)(F.lds + ULIST_OFF), n};
    pg8::EpiBf16 E{(bf16*)(ws + WS_PROJ), 2048};
    pg8::gemm_phase<pg8::EpiBf16, pg8::ListSched, false, pg8::NoHook>(F.lds, D, Sd, E, pg8::NoHook{}, F.wave);
}
}
namespace attn_body {
using bf16=__hip_bfloat16;
using bf16x8=__attribute__((ext_vector_type(8)))short;
using s16x4=__attribute__((ext_vector_type(4)))short;
using f32x16=__attribute__((ext_vector_type(16)))float;
using u32x4=__attribute__((ext_vector_type(4)))unsigned;
constexpr int BATCH=8,NHEAD=8,SEQ=2048,D=64,DM=2048,PO=1024;
constexpr int NW=8,QBLK=32,QB=QBLK*NW,KVBLK=64,NQB=SEQ/QB;
__device__ __forceinline__ int crow(int r,int hi){return (r&3)+8*(r>>2)+4*hi;}
#define SBAR() __builtin_amdgcn_sched_barrier(0)
__device__ __forceinline__ void cmask(f32x16&p0,f32x16&p1,int jb,int qrel,int hi){
  const float NEG=-INFINITY; int kb=64*jb+4*hi;
  #pragma unroll
  for(int r=0;r<16;++r){int kv=kb+(r&3)+8*(r>>2); if(kv>qrel)p0[r]=NEG; if(kv+32>qrel)p1[r]=NEG;}
}

constexpr int NSLOT=3, SLOTB=8192;
constexpr int LDS_K=0, LDS_V=NSLOT*SLOTB, LDS_WS=2*NSLOT*SLOTB, LDS_OST=LDS_WS+NW*64*4, LDS_CUM=LDS_OST+NW*4096, LDS_KB=LDS_CUM+SEQ*4, LDS_BYTES=LDS_KB+SEQ*4;
__device__ __forceinline__ void glds16(const void*gsrc,unsigned lds_dst){unsigned keep;
  asm volatile("s_mov_b32 %0, m0\n\ts_mov_b32 m0, %2\n\ts_nop 0\n\tglobal_load_lds_dwordx4 %1, off\n\ts_mov_b32 m0, %0":"=&s"(keep):"v"(gsrc),"s"(lds_dst):"memory");}
__device__ __forceinline__ float max3f(float a,float b,float c){float r;asm("v_max3_f32 %0, %1, %2, %3":"=v"(r):"v"(a),"v"(b),"v"(c));return r;}
__device__ __forceinline__ float max2f(float a,float b){float r;asm("v_max_f32_e32 %0, %1, %2":"=v"(r):"v"(a),"v"(b));return r;}
__device__ __forceinline__ float fadd_s(float a,float b){float r;asm("v_add_f32_e32 %0, %1, %2":"=v"(r):"v"(a),"v"(b));return r;}
__device__ __forceinline__ float fsub_s(float a,float b){float r;asm("v_sub_f32_e32 %0, %1, %2":"=v"(r):"v"(a),"v"(b));return r;}
typedef float f32x2_t __attribute__((ext_vector_type(2))); typedef __bf16 bf16x2_t __attribute__((ext_vector_type(2)));
__device__ __forceinline__ unsigned cvtpk_s(float lo,float hi){f32x2_t v={lo,hi};bf16x2_t b=__builtin_convertvector(v,bf16x2_t);return __builtin_bit_cast(unsigned,b);}
#define WAIT_BAR(N) asm volatile("s_waitcnt vmcnt(" #N ") lgkmcnt(0)\n\ts_barrier":::"memory")

__device__ __forceinline__ void qkt(f32x16&p0,f32x16&p1,const char*Kslot,const bf16x8*qr,bf16x8 kb0,bf16x8 kb1,bf16x8 qb,int r32,int hi){
  const char*kb=Kslot+hi*1024+r32*16;
  p0=__builtin_amdgcn_mfma_f32_32x32x16_bf16(kb0,qb,f32x16{},0,0,0);p1=__builtin_amdgcn_mfma_f32_32x32x16_bf16(kb1,qb,f32x16{},0,0,0);
  #pragma unroll
  for(int d0=0;d0<4;++d0){
    const bf16x8 b0=*reinterpret_cast<const bf16x8*>(kb+d0*2048);
    const bf16x8 b1=*reinterpret_cast<const bf16x8*>(kb+d0*2048+512);
    p0=__builtin_amdgcn_mfma_f32_32x32x16_bf16(b0,qr[d0],p0,0,0,0);p1=__builtin_amdgcn_mfma_f32_32x32x16_bf16(b1,qr[d0],p1,0,0,0);}
}
typedef __attribute__((address_space(3))) const char* lds_cptr;
typedef short v4i16_t __attribute__((ext_vector_type(4)));
__device__ __forceinline__ void kload8(bf16x8*kf,lds_cptr kp){
  kf[0]=*(const __attribute__((address_space(3))) bf16x8*)(kp);      kf[1]=*(const __attribute__((address_space(3))) bf16x8*)(kp+512);
  kf[2]=*(const __attribute__((address_space(3))) bf16x8*)(kp+2048); kf[3]=*(const __attribute__((address_space(3))) bf16x8*)(kp+2560);
  kf[4]=*(const __attribute__((address_space(3))) bf16x8*)(kp+4096); kf[5]=*(const __attribute__((address_space(3))) bf16x8*)(kp+4608);
  kf[6]=*(const __attribute__((address_space(3))) bf16x8*)(kp+6144); kf[7]=*(const __attribute__((address_space(3))) bf16x8*)(kp+6656);
}
__device__ __forceinline__ void kload2(bf16x8*kf,lds_cptr kp,int j){ kf[2*j]=*(const __attribute__((address_space(3))) bf16x8*)(kp+j*2048); kf[2*j+1]=*(const __attribute__((address_space(3))) bf16x8*)(kp+j*2048+512); }
__device__ __forceinline__ s16x4 vtr(lds_cptr p){ return __builtin_bit_cast(s16x4,__builtin_amdgcn_ds_read_tr16_b64_v4i16((__attribute__((address_space(3))) v4i16_t*)p)); }
__device__ __forceinline__ float rowmax(const f32x16&p0,const f32x16&p1){
  float a=max3f(p0[0],p0[1],p1[0]),b=max3f(p0[2],p0[3],p1[1]);a=max3f(a,p1[2],p1[3]);
  #pragma unroll
  for(int r=4;r<16;r+=4){a=max3f(a,p0[r],p0[r+1]);b=max3f(b,p0[r+2],p0[r+3]);a=max3f(a,p1[r],p1[r+1]);b=max3f(b,p1[r+2],p1[r+3]);}
  const float m=max2f(a,b);
  auto rr=__builtin_amdgcn_permlane32_swap(__float_as_uint(m),__float_as_uint(m),false,false);
  return max2f(__uint_as_float(rr[0]),__uint_as_float(rr[1]));
}
__device__ __forceinline__ void pv(f32x16*o,int vb,bf16x8 pa0,bf16x8 pa1,bf16x8 pa2,bf16x8 pa3){
  #pragma unroll
  for(int d0=0;d0<2;++d0){s16x4 lo[4],hi[4];
    #pragma unroll
    for(int ks=0;ks<4;++ks){
      asm volatile("ds_read_b64_tr_b16 %0,%1 offset:%c2":"=&v"(lo[ks]):"v"(vb),"i"(d0*4096+ks*1024):"memory");
      asm volatile("ds_read_b64_tr_b16 %0,%1 offset:%c2":"=&v"(hi[ks]):"v"(vb),"i"(d0*4096+ks*1024+512):"memory");}
    asm volatile("s_waitcnt lgkmcnt(0)":::"memory");SBAR();
    #define PK(k) (bf16x8){lo[k][0],lo[k][1],lo[k][2],lo[k][3],hi[k][0],hi[k][1],hi[k][2],hi[k][3]}
    o[d0]=__builtin_amdgcn_mfma_f32_32x32x16_bf16(pa0,PK(0),o[d0],0,0,0);
    o[d0]=__builtin_amdgcn_mfma_f32_32x32x16_bf16(pa1,PK(1),o[d0],0,0,0);
    o[d0]=__builtin_amdgcn_mfma_f32_32x32x16_bf16(pa2,PK(2),o[d0],0,0,0);
    o[d0]=__builtin_amdgcn_mfma_f32_32x32x16_bf16(pa3,PK(3),o[d0],0,0,0);
    #undef PK
  }
}

#ifndef ATTN_STORE16
#define ATTN_STORE16(p,v) do { if (MK_WT & 2) pg8::st16_wt((void*)(p), (v)); else *(u32x4*)(p)=(v); } while (0)
#endif
template<int THRL> __device__ __forceinline__ void attn_unit(int b,int h,int qb,const bf16*Q,const bf16*__restrict__ K,const bf16*__restrict__ V,bf16*O,float*ssq,char*shm,const int wid){
  int lane; asm volatile("v_mbcnt_lo_u32_b32 %0, -1, 0\n\tv_mbcnt_hi_u32_b32 %0, -1, %0" : "=v"(lane));
  const int tid=wid*64+lane, r32=lane&31,hi=lane>>5;
  const long rowbase=(long)b*SEQ; const int q0=qb*QB;
  const bf16*Qw=Q+(rowbase+q0+wid*QBLK)*DM+h*D;
  const bf16*Kh=K+rowbase*DM+h*D,*Vh=V+rowbase*DM+h*D;
  const unsigned lds0=(unsigned)(uintptr_t)shm;
  float*wsf=(float*)(shm+LDS_WS)+wid*64;
  const bf16*ksrc=Kh+(long)lane*DM+wid*8;
  const bf16*vsrc=Vh+(long)(16*(wid&3)+(lane>>2))*DM+(wid>>2)*32+(lane&3)*8;
  const unsigned kdst=lds0+LDS_K+wid*1024, vdst=lds0+LDS_V+wid*1024;
  #define DMA_K(t,slot) glds16(ksrc+(long)(t)*KVBLK*DM,(unsigned)__builtin_amdgcn_readfirstlane(kdst+(slot)))
  #define DMA_V(t,slot) glds16(vsrc+(long)(t)*KVBLK*DM,(unsigned)__builtin_amdgcn_readfirstlane(vdst+(slot)))
  const int vb0=(int)(lds0+LDS_V)+((lane>>4)&1)*32+(lane&3)*8+(4*hi+((lane&15)>>2))*64;
  const char*Kbase=shm+LDS_K; bf16x8 kf[8];
  const lds_cptr shm3=(lds_cptr)shm; const lds_cptr kp0=shm3+LDS_K+hi*1024+r32*16; const lds_cptr vp0=shm3+LDS_V+((lane>>4)&1)*32+(lane&3)*8+(4*hi+((lane&15)>>2))*64;
  const int NT=(q0+QB)/KVBLK;
  { const float*cum=(const float*)(shm+LDS_CUM); unsigned*kbt_=(unsigned*)(shm+LDS_KB); const float ref=cum[q0+QB-1];
    for(int k=tid;k<NT*KVBLK;k+=NW*64){ const float v=(ref-cum[k])*1.4426950408889634f; const unsigned hb=mk::f2bf(v); kbt_[k]=hb|(mk::f2bf(v-mk::bf2f(hb))<<16); }
    __syncthreads(); }
  const __attribute__((address_space(3))) unsigned* kbt=(const __attribute__((address_space(3))) unsigned*)((lds_cptr)shm+LDS_KB);
  const unsigned kone1=hi?0u:0x3F803F80u;
  #define KBF(pk) __builtin_bit_cast(bf16x8,(u32x4){(pk),kone1,kone1,0u})
  unsigned kbr0,kbr1;
  #define KBRD(G,tt) do{ if(G){ const unsigned a_=kbt[(tt)*KVBLK+r32], b_=kbt[(tt)*KVBLK+32+r32]; kbr0=a_; kbr1=b_; } }while(0)
  bf16x8 qb_=__builtin_bit_cast(bf16x8,(u32x4){kone1,0u,0u,0u});
  #define SETREF() do{ const float nm_=-mhat; const unsigned h0_=__float_as_uint(nm_)&0xFFFF0000u; const float r1_=nm_-__uint_as_float(h0_); const unsigned h1_=__float_as_uint(r1_)&0xFFFF0000u; \
      const float r2_=r1_-__uint_as_float(h1_); const unsigned h2_=__float_as_uint(r2_)&0xFFFF0000u; \
      qb_=__builtin_bit_cast(bf16x8,(u32x4){kone1, hi?0u:((h0_>>16)|h1_), hi?0u:(h2_>>16), 0u}); }while(0)
  DMA_K(0,0);DMA_V(0,0);DMA_K(1,SLOTB);
  bf16x8 qr[4];
  #pragma unroll
  for(int d0=0;d0<4;++d0)qr[d0]=*reinterpret_cast<const bf16x8*>(&Qw[(long)r32*DM+d0*16+hi*8]);
  const lds_cptr qp0=shm3+LDS_OST+wid*4096+hi*512+r32*16;
  #pragma unroll
  for(int d0=0;d0<4;++d0)*(__attribute__((address_space(3))) bf16x8*)((__attribute__((address_space(3))) char*)(qp0+d0*1024))=qr[d0];
  #define QF(d0) (*(const __attribute__((address_space(3))) bf16x8*)(qp0+(d0)*1024))
  float mhat=0.f,l_reg=0.f;f32x16 o[2];o[0]=f32x16{};o[1]=f32x16{};
  const int qrel=wid*QBLK+r32;
  #define CMASK(P0,P1,t) do{int jb_=(t)-(NT-4); if(jb_>=0)cmask(P0,P1,jb_,qrel,hi);}while(0)
  bool resc=false;
  #define START(P0,P1) do{ const float rm=rowmax(P0,P1); resc=false; \
    { const float dl=rm; mhat=fadd_s(mhat,dl); \
      _Pragma("unroll") for(int r=0;r<16;++r){P0[r]=fsub_s(P0[r],dl);P1[r]=fsub_s(P1[r],dl);} \
      SETREF(); } \
    _Pragma("unroll") for(int r=0;r<16;++r)P0[r]=__builtin_amdgcn_exp2f(P0[r]); }while(0)
  #define RESC() do{ if(resc){ asm volatile("s_waitcnt lgkmcnt(0)":::"memory"); \
      _Pragma("unroll") for(int d_=0;d_<2;++d_) _Pragma("unroll") for(int r=0;r<16;++r)o[d_][r]*=wsf[crow(r,hi)]; } }while(0)
  f32x16 pA0,pA1,pB0,pB1;
  int sl_prev=0,sl_cur=0,sl_next=SLOTB;
  #define ROT() do{sl_prev=sl_cur;sl_cur=sl_next;sl_next=(sl_next==(NSLOT-1)*SLOTB)?0:sl_next+SLOTB;}while(0)
  DMA_K(2,2*SLOTB);
  WAIT_BAR(3);
  KBRD(true,0);
  qkt(pA0,pA1,Kbase,qr,KBF(kbr0),KBF(kbr1),qb_,r32,hi);asm volatile("s_nop 15\n\ts_nop 7":"+v"(pA0),"+v"(pA1));CMASK(pA0,pA1,0);
  START(pA0,pA1);
  _Pragma("unroll") for(int r=0;r<16;++r)pA1[r]=__builtin_amdgcn_exp2f(pA1[r]);
  WAIT_BAR(0);
  DMA_K(3,0);DMA_V(1,SLOTB);
  ROT();
  kload8(kf,kp0+sl_cur);
  KBRD(true,1);
  WAIT_BAR(2);
  s16x4 vlo[8],vhi[8]; u32x4 pw0,pw1,pw2,pw3;
  #define PKW(P,B) cvtpk_s(P[B],P[B+1])
  #define PAF(k) __builtin_bit_cast(bf16x8,pw##k)
  #define VFR(i) (bf16x8){vlo[i][0],vlo[i][1],vlo[i][2],vlo[i][3],vhi[i][0],vhi[i][1],vhi[i][2],vhi[i][3]}
  #define PIN(x) asm volatile("":"+v"(x))
  #define MX3(a,b,c) __builtin_fmaxf(__builtin_fmaxf((a),(b)),(c))
  #define GAPA(MF,A0,A1,A2,A3,W0,W1,PW) do{ MF; sacc+=A0; sacc+=A1; sacc+=A2; sacc+=A3; PIN(sacc); W0; W1; PIN(PW); SBAR(); }while(0)
  #define EX(v) __builtin_amdgcn_exp2f(v)
  #define GAPB(MF,X,B) do{ MF; X[B]=EX(X[B]); X[B+1]=EX(X[B+1]); X[B+2]=EX(X[B+2]); X[B+3]=EX(X[B+3]); PIN(X); SBAR(); }while(0)
  #define VRD(i) do{ vlo[i]=vtr(vp_+(((i)>>2)*4096+((i)&3)*1024)); vhi[i]=vtr(vp_+(((i)>>2)*4096+((i)&3)*1024+512)); }while(0)
  #define KRD(G,j) do{ if(G){ kload2(kf,kp0+sl_next,j); SBAR(); } }while(0)
  #define STEP(C0,C1,P0,P1,t,GK,GV,GL) do{ SBAR(); \
    const lds_cptr vp_=vp0+sl_prev; \
    C0=__builtin_amdgcn_mfma_f32_32x32x16_bf16(KBF(kbr0),qb_,f32x16{},0,0,0); C1=__builtin_amdgcn_mfma_f32_32x32x16_bf16(KBF(kbr1),qb_,f32x16{},0,0,0); SBAR(); \
    VRD(0); SBAR(); float sacc=(P0[0]+P0[1]); \
    bf16x8 qa_=QF(0), qc_=QF(1); \
    GAPA(C0=__builtin_amdgcn_mfma_f32_32x32x16_bf16(kf[0],qa_,C0,0,0,0), P0[2],P0[3],P0[4],P0[5],     pw0[0]=PKW(P0,0), pw0[1]=PKW(P0,2), pw0); \
    VRD(4); SBAR(); GAPA(C1=__builtin_amdgcn_mfma_f32_32x32x16_bf16(kf[1],qa_,C1,0,0,0), P0[6],P0[7],P0[8],P0[9],     pw0[2]=PKW(P0,4), pw0[3]=PKW(P0,6), pw0); \
    qa_=QF(2); VRD(1); SBAR(); GAPA(C0=__builtin_amdgcn_mfma_f32_32x32x16_bf16(kf[2],qc_,C0,0,0,0),   P0[10],P0[11],P0[12],P0[13], pw1[0]=PKW(P0,8), pw1[1]=PKW(P0,10), pw1); \
    VRD(5); SBAR(); GAPA(C1=__builtin_amdgcn_mfma_f32_32x32x16_bf16(kf[3],qc_,C1,0,0,0),   P0[14],P0[15],P1[0],P1[1],   pw1[2]=PKW(P0,12),pw1[3]=PKW(P0,14), pw1); \
    qc_=QF(3); VRD(2); SBAR(); GAPA(C0=__builtin_amdgcn_mfma_f32_32x32x16_bf16(kf[4],qa_,C0,0,0,0),   P1[2],P1[3],P1[4],P1[5],     pw2[0]=PKW(P1,0), pw2[1]=PKW(P1,2), pw2); \
    VRD(6); SBAR(); GAPA(C1=__builtin_amdgcn_mfma_f32_32x32x16_bf16(kf[5],qa_,C1,0,0,0),   P1[6],P1[7],P1[8],P1[9],     pw2[2]=PKW(P1,4), pw2[3]=PKW(P1,6), pw2); \
    VRD(3); SBAR(); GAPA(C0=__builtin_amdgcn_mfma_f32_32x32x16_bf16(kf[6],qc_,C0,0,0,0),   P1[10],P1[11],P1[12],P1[13], pw3[0]=PKW(P1,8), pw3[1]=PKW(P1,10), pw3); \
    VRD(7); SBAR(); GAPA(C1=__builtin_amdgcn_mfma_f32_32x32x16_bf16(kf[7],qc_,C1,0,0,0),   P1[14],P1[15],0.f,0.f,       pw3[2]=PKW(P1,12),pw3[3]=PKW(P1,14), pw3); \
    l_reg+=sacc; \
    if(GK){DMA_K((t)+3,sl_cur);} if(GV){DMA_V((t)+1,sl_next);} \
    CMASK(C0,C1,t); \
    { float a=MX3(C0[0],C0[1],C1[0]),b=MX3(C0[2],C0[3],C1[1]); a=MX3(a,C1[2],C1[3]); \
      _Pragma("unroll") for(int r=4;r<16;r+=4){a=MX3(a,C0[r],C0[r+1]);b=MX3(b,C0[r+2],C0[r+3]);a=MX3(a,C1[r],C1[r+1]);b=MX3(b,C1[r+2],C1[r+3]);} \
      float rm=__builtin_fmaxf(a,b); { auto rr=__builtin_amdgcn_permlane32_swap(__float_as_uint(rm),__float_as_uint(rm),false,false); rm=__builtin_fmaxf(__uint_as_float(rr[0]),__uint_as_float(rr[1])); } \
      resc=false; \
      if(__builtin_expect(__any(rm>(float)THRL),0)){ const float dl=__builtin_fmaxf(rm,0.f); mhat+=dl; \
        _Pragma("unroll") for(int r=0;r<16;++r){C0[r]-=dl;C1[r]-=dl;} \
        SETREF(); \
        const float f=__builtin_amdgcn_exp2f(-dl); l_reg*=f; if(hi==0)wsf[r32]=f; resc=true; } } \
    SBAR(); \
    GAPB(o[0]=__builtin_amdgcn_mfma_f32_32x32x16_bf16(PAF(0),VFR(0),o[0],0,0,0), C0,0); \
    GAPB(o[1]=__builtin_amdgcn_mfma_f32_32x32x16_bf16(PAF(0),VFR(4),o[1],0,0,0), C0,4); \
    KRD(GL,0); GAPB(o[0]=__builtin_amdgcn_mfma_f32_32x32x16_bf16(PAF(1),VFR(1),o[0],0,0,0), C0,8); \
    KRD(GL,1); GAPB(o[1]=__builtin_amdgcn_mfma_f32_32x32x16_bf16(PAF(1),VFR(5),o[1],0,0,0), C0,12); \
    KRD(GL,2); GAPB(o[0]=__builtin_amdgcn_mfma_f32_32x32x16_bf16(PAF(2),VFR(2),o[0],0,0,0), C1,0); \
    KRD(GL,3); GAPB(o[1]=__builtin_amdgcn_mfma_f32_32x32x16_bf16(PAF(2),VFR(6),o[1],0,0,0), C1,4); \
    KBRD(GL,(t)+1); \
    GAPB(o[0]=__builtin_amdgcn_mfma_f32_32x32x16_bf16(PAF(3),VFR(3),o[0],0,0,0), C1,8); \
    GAPB(o[1]=__builtin_amdgcn_mfma_f32_32x32x16_bf16(PAF(3),VFR(7),o[1],0,0,0), C1,12); \
    }while(0)
  int t=1;
  #undef CMASK
  #define CMASK(P0,P1,t) do{}while(0)
  for(;t+5<NT;t+=2){
    STEP(pB0,pB1,pA0,pA1,t,true,true,true);     WAIT_BAR(2); RESC(); ROT();
    STEP(pA0,pA1,pB0,pB1,t+1,true,true,true);   WAIT_BAR(2); RESC(); ROT();
  }
  #undef CMASK
  #define CMASK(P0,P1,t) do{int jb_=(t)-(NT-4); if(jb_>=0)cmask(P0,P1,jb_,qrel,hi);}while(0)
  #define ENDW(tt) do{ if((tt)+3<NT){WAIT_BAR(2);} else if((tt)+2<NT){WAIT_BAR(1);} else {WAIT_BAR(0);} }while(0)
  for(;t+1<NT;t+=2){
    STEP(pB0,pB1,pA0,pA1,t,(t+3<NT),(t+1<NT),(t+1<NT));       ENDW(t);   RESC(); ROT();
    STEP(pA0,pA1,pB0,pB1,t+1,(t+4<NT),(t+2<NT),(t+2<NT));     ENDW(t+1); RESC(); ROT();
  }
  STEP(pB0,pB1,pA0,pA1,NT-1,false,false,false); RESC();
  { float sacc=pB0[0]+pB0[1]; _Pragma("unroll") for(int r=2;r<16;++r)sacc+=pB0[r]; _Pragma("unroll") for(int r=0;r<16;++r)sacc+=pB1[r]; l_reg+=sacc;
    pw0=(u32x4){PKW(pB0,0),PKW(pB0,2),PKW(pB0,4),PKW(pB0,6)};pw1=(u32x4){PKW(pB0,8),PKW(pB0,10),PKW(pB0,12),PKW(pB0,14)};pw2=(u32x4){PKW(pB1,0),PKW(pB1,2),PKW(pB1,4),PKW(pB1,6)};pw3=(u32x4){PKW(pB1,8),PKW(pB1,10),PKW(pB1,12),PKW(pB1,14)};
    SBAR(); pv(o,vb0+sl_cur,PAF(0),PAF(1),PAF(2),PAF(3)); }
  #undef PKW
  #undef PAF
  #undef VFR
  #undef PIN
  #undef MX3
  #undef GAPA
  #undef GAPB
  #undef EX
  #undef VRD
  #undef KRD
  #undef STEP
  #undef ENDW
  {auto rr=__builtin_amdgcn_permlane32_swap(__float_as_uint(l_reg),__float_as_uint(l_reg),false,false);l_reg=__uint_as_float(rr[0])+__uint_as_float(rr[1]);}
  if(hi==0)wsf[32+r32]=l_reg;asm volatile("s_waitcnt lgkmcnt(0)":::"memory");
  float rli[16];
  #pragma unroll
  for(int r=0;r<16;++r)rli[r]=__builtin_amdgcn_rcpf(wsf[32+crow(r,hi)]);
  bf16*Ow=O+(rowbase+q0+wid*QBLK)*PO+h*D; float*sq=ssq+(rowbase+q0+wid*QBLK)*8+h;
  { bf16*stg=(bf16*)(shm+LDS_OST)+wid*2048;
    #pragma unroll
    for(int r=0;r<16;++r){const int orow=crow(r,hi);
      #pragma unroll
      for(int d0=0;d0<2;++d0)stg[orow*64+d0*32+r32]=__float2bfloat16(o[d0][r]*rli[r]);}
    asm volatile("s_waitcnt lgkmcnt(0)":::"memory");
    #pragma unroll
    for(int i=0;i<4;++i){const int row=i*8+(lane>>3),ch=lane&7; const u32x4 v=*(const u32x4*)(stg+row*64+ch*8); ATTN_STORE16(Ow+(long)row*PO+ch*8,v);
      float ss=0.f;
      #pragma unroll
      for(int j=0;j<4;++j){ const float a_=__uint_as_float(v[j]<<16), b_=__uint_as_float(v[j]&0xFFFF0000u); ss+=a_*a_+b_*b_; }
      ss+=__shfl_xor(ss,1); ss+=__shfl_xor(ss,2); ss+=__shfl_xor(ss,4); if(ch==0) sq[(long)row*8]=ss; } }
  asm volatile("s_waitcnt lgkmcnt(0)\n\ts_barrier":::"memory");
  #undef DMA_K
  #undef DMA_V
  #undef CMASK
  #undef START
  #undef RESC
  #undef ROT
  #undef KBF
  #undef QF
  #undef KBRD
  #undef SETREF
}
constexpr int ATTN_LDS_BYTES=LDS_BYTES;
#undef SBAR
#undef WAIT_BAR
}

namespace mk {
#ifndef MK_POOL_DPP_MIN
#define MK_POOL_DPP_MIN 1000
#endif
template <int CTRL> __device__ __forceinline__ float dppf(float x) { return __builtin_bit_cast(float, __builtin_amdgcn_update_dpp(0, __builtin_bit_cast(int, x), CTRL, 0xF, 0xF, true)); }
template <int G>
__device__ __forceinline__ void pool_item(Frame& F, int panel) {
    unsigned char* ws = F.ws; constexpr int US = 272, WSTR = 272, WOFF = 75776, WG = 2 << G;
    const int t0 = panel * 256, tl0 = t0 % S;
    const bf16* proj = (const bf16*)(ws + WS_PROJ); const bf16* wp = (const bf16*)(ws + WS_WPOOL) + (size_t)G * 16384;
    { v4u v[9], wv[4];
#pragma unroll
      for (int i = 0; i < 9; ++i) { const int c = F.tid + i * NTHR, rr = c >> 4, ch = c & 15; v[i] = (v4u){0u, 0u, 0u, 0u};
          if (c < 271 * 16 && tl0 + rr - 15 >= 0) v[i] = *(const GAS v4u*)(proj + (size_t)(t0 - 15 + rr) * 2048 + G * 128 + ch * 8); }
#pragma unroll
      for (int i = 0; i < 4; ++i) { const int c = F.tid + i * NTHR; wv[i] = *(const GAS v4u*)(wp + (size_t)c * 8); }
#pragma unroll
      for (int i = 0; i < 9; ++i) { const int c = F.tid + i * NTHR, rr = c >> 4, ch = c & 15; if (c < 271 * 16) *(LAS v4u*)(F.lds + rr * US + ch * 16) = v[i]; }
#pragma unroll
      for (int i = 0; i < 4; ++i) { const int c = F.tid + i * NTHR; *(LAS v4u*)(F.lds + WOFF + (c >> 4) * WSTR + (c & 15) * 16) = wv[i]; } }
    __syncthreads();
    const int r = F.lane & 15, kq = F.lane >> 4;
    bf16* ycat = (bf16*)(ws + WS_YCAT); float* ssqp = (float*)(ws + WS_SSQP);
    const LAS unsigned char* wl = F.lds + WOFF + r * WSTR + kq * 16;
#pragma unroll 1
    for (int mi = 0; mi < 2; ++mi) {
        asm volatile("" ::: "memory");
        const int tr = (F.wave * 2 + mi) * 16 + r, tl = tl0 + tr;
        const int n = (tl + 1 < WG) ? tl + 1 : WG; const float inv = 1.0f / (float)n;
        f32x4 acc[8];
#pragma unroll
        for (int nb = 0; nb < 8; ++nb) acc[nb] = (f32x4){0.f, 0.f, 0.f, 0.f};
#pragma unroll
        for (int ks = 0; ks < 4; ++ks) {
            float sum[8];
#pragma unroll
            for (int j = 0; j < 8; ++j) sum[j] = 0.f;
            v4u cur = (v4u){0u, 0u, 0u, 0u};
            if constexpr (WG >= MK_POOL_DPP_MIN) {
                cur = *(const LAS v4u*)(F.lds + (tr + 15) * US + ks * 64 + kq * 16);
                v4u prv = (v4u){0u, 0u, 0u, 0u}; if (tr > 0) prv = *(const LAS v4u*)(F.lds + (tr - 1) * US + ks * 64 + kq * 16);
#pragma unroll
                for (int j = 0; j < 8; ++j) { float P = (j & 1) ? __uint_as_float(cur[j >> 1] & 0xFFFF0000u) : __uint_as_float(cur[j >> 1] << 16), I = (j & 1) ? __uint_as_float(prv[j >> 1] & 0xFFFF0000u) : __uint_as_float(prv[j >> 1] << 16);
                    P += dppf<0x111>(P); P += dppf<0x112>(P); P += dppf<0x114>(P); P += dppf<0x118>(P);
                    I += dppf<0x101>(I); I += dppf<0x102>(I); I += dppf<0x104>(I); I += dppf<0x108>(I);
                    float sw = P + dppf<0x100 + (WG >= 2 ? 17 - WG : 1)>(I);
                    if constexpr (WG < 16) sw -= dppf<0x110 + (WG < 16 ? WG : 1)>(P);
                    sum[j] = sw; }
            } else {
#pragma unroll
            for (int i = 0; i < WG; ++i) { const v4u v = *(const LAS v4u*)(F.lds + (tr + 15 - i) * US + ks * 64 + kq * 16); if (i == 0) cur = v;
#pragma unroll
                for (int j = 0; j < 4; ++j) { sum[2 * j] += __uint_as_float(v[j] << 16); sum[2 * j + 1] += __uint_as_float(v[j] & 0xFFFF0000u); } } }
            v4u pa;
#pragma unroll
            for (int j = 0; j < 4; ++j) pa[j] = pk2(sum[2 * j] * inv - __uint_as_float(cur[j] << 16), sum[2 * j + 1] * inv - __uint_as_float(cur[j] & 0xFFFF0000u));
            const bf16x8 af = __builtin_bit_cast(bf16x8, pa);
#pragma unroll
            for (int nb = 0; nb < 8; ++nb) { const bf16x8 bfr = *(const LAS bf16x8*)(wl + nb * 16 * WSTR + ks * 64);
                acc[nb] = __builtin_amdgcn_mfma_f32_16x16x32_bf16(bfr, af, acc[nb], 0, 0, 0); }
        }
        const size_t token = (size_t)t0 + tr; float ss = 0.f;
#pragma unroll
        for (int nb = 0; nb < 8; ++nb) { const f32x4 v = acc[nb]; ss += (v[0] * v[0] + v[1] * v[1]) + (v[2] * v[2] + v[3] * v[3]);
            v2u o; o.x = pk2(v[0], v[1]); o.y = pk2(v[2], v[3]);
            *(GAS v2u*)(ycat + token * D + G * 128 + nb * 16 + 4 * kq) = o; }
        ss += __shfl_xor(ss, 16); ss += __shfl_xor(ss, 32);
        if (kq == 0) { ssqp[token * 8 + G * 2] = ss; ssqp[token * 8 + G * 2 + 1] = 0.f; }
    }
    __syncthreads();
}

__device__ __forceinline__ void p2(Frame& F) {
    unsigned char* ws = F.ws; char* shm = (char*)(uintptr_t)0;
    (void)shm;
    const attn_body::bf16* proj = (const attn_body::bf16*)(ws + WS_PROJ);
    attn_body::bf16* ycat = (attn_body::bf16*)(ws + WS_YCAT);
    const float* logf = (const float*)(ws + WS_LOGF); float* ssqa = (float*)(ws + WS_SSQA);
    char* lds = (char*)F.lds;
    for (int p = F.vcu; p < 256; p += F.G) {
        const int bh = p >> 2, s = p & 3, b = bh >> 3, h = bh & 7;
        { const float* lf = logf + (size_t)b * S * 8 + h; const int k0 = 4 * F.tid;
          const float l0 = lf[(size_t)(k0 + 0) * 8], l1 = lf[(size_t)(k0 + 1) * 8], l2 = lf[(size_t)(k0 + 2) * 8], l3 = lf[(size_t)(k0 + 3) * 8];
          const float c0 = l0, c1 = c0 + l1, c2 = c1 + l2, c3 = c2 + l3; float x = c3;
#pragma unroll
          for (int o = 1; o < 64; o <<= 1) { const float y = __shfl_up(x, o); if (F.lane >= o) x += y; }
          LAS float* wt = (LAS float*)(F.lds + attn_body::LDS_WS);
          if (F.lane == 63) wt[F.wave] = x;
          __syncthreads();
          float base = x - c3; for (int w = 0; w < F.wave; ++w) base += wt[w];
          LAS float* cum = (LAS float*)(F.lds + attn_body::LDS_CUM);
          *(LAS f32x4*)(cum + k0) = (f32x4){base + c0, base + c1, base + c2, base + c3};
          __syncthreads(); }
        SUBSTAMP(F, 0);
#pragma nounroll
        for (int u = 0; u < 2; ++u) { attn_body::attn_unit<64>(b, h, u ? 7 - s : s, proj + 512, proj + 1024, proj + 1536, ycat + 512, ssqa, lds, F.wave); SUBSTAMP(F, 1 + u); }
    }
    __syncthreads();
    for (int it = F.vcu; it < 256; it += F.G) { const int panel = it >> 2;
        switch (it & 3) { case 0: pool_item<0>(F, panel); break; case 1: pool_item<1>(F, panel); break; case 2: pool_item<2>(F, panel); break; default: pool_item<3>(F, panel); break; } }
    SUBSTAMP(F, 3);
}
}
namespace mk {
struct MidScaleHook {
    const LAS float* ratio;
    __device__ __forceinline__ void at(int t, pg8::f32x4 (&acc)[2][2][4][2], int wr, int fr, int) const {
        if (t == 8) {
#pragma unroll
            for (int ai = 0; ai < 2; ++ai)
#pragma unroll
                for (int m = 0; m < 4; ++m) { const float s = ratio[ai * 128 + wr * 64 + m * 16 + fr];
#pragma unroll
                    for (int bj = 0; bj < 2; ++bj)
#pragma unroll
                        for (int n = 0; n < 2; ++n) acc[ai][bj][m][n] *= s; }
        }
    }
};
__device__ __forceinline__ void p3(Frame& F) {
    unsigned char* ws = F.ws;
    LAS float* ratio = (LAS float*)(F.lds + RS_OFF); LAS float* rs = ratio + 256;
    const float* ssqp = (const float*)(ws + WS_SSQP); const float* ssqa = (const float*)(ws + WS_SSQA);
    for (int i = 0; i < 64; ++i) { int pm, pn; if (!static_unit(T / 256, D / 256, F.G, (int)blockIdx.x, i, pm, pn)) break;
        __syncthreads();
        if (F.tid < 256) { const size_t tok = (size_t)pm * 256 + F.tid; float sp = 0.f, sa = 0.f;
#pragma unroll
            for (int j = 0; j < 8; ++j) { sp += ssqp[tok * 8 + j]; sa += ssqa[tok * 8 + j]; }
            const float rp = rsqrtf(sp * (1.f / 512.f) + EPS), ra = rsqrtf(sa * (1.f / 512.f) + EPS);
            ratio[F.tid] = rp / ra; rs[F.tid] = ra; }
        if (F.tid == 0) put_unit(F, 0, ws + WS_YCAT + (size_t)pm * 256 * D * 2, ws + WS_WOUT + (size_t)pn * 256 * D * 2, -1, pm * 256, pn * 256);
        __syncthreads();
        pg8::ListSched Sd{(const LAS pg8::UnitRec*)(F.lds + ULIST_OFF), 1};
        pg8::EpiRowScaleBf16 E{(bf16*)(ws + WS_MIXED), D, rs};
        pg8::gemm_phase<pg8::EpiRowScaleBf16, pg8::ListSched, false, MidScaleHook>(F.lds, D, Sd, E, MidScaleHook{ratio}, F.wave);
    }
}
}
namespace mk {
typedef _Float16 f16x8 __attribute__((ext_vector_type(8)));
__device__ __forceinline__ int p4_swz(int row, int chunk) { return row * 2048 + ((chunk ^ (row & 15)) << 4); }
__device__ __forceinline__ unsigned pkh2(float a, float b) { return (unsigned)__builtin_bit_cast(unsigned short, (_Float16)a) | ((unsigned)__builtin_bit_cast(unsigned short, (_Float16)b) << 16); }
template <bool DRY> __device__ __forceinline__ void p4(Frame& F) {
    const bool live = !DRY || (__hip_atomic_load(F.ctl + 3, RLX_AGENT) == 0xdeadbeefu);
    const float* const* in = F.in; unsigned char* ws = F.ws;
    const float* mod = (const float*)(ws + WS_MOD);
    const bf16* mixed = (const bf16*)(ws + WS_MIXED); unsigned char* h2g = ws + WS_H2;
    const _Float16* wr16 = (const _Float16*)(ws + WS_WRHI);
    LAS unsigned char* th = F.lds;
    const int lane = F.lane;
    for (int tile = F.vcu; tile < T / 64; tile += F.G) {
        const int b = (tile * 64) / S;
#pragma unroll 1
        for (int r4 = 0; r4 < 8; r4 += 4) {
            const int row0 = F.wave * 8 + r4; const size_t tok0 = (size_t)tile * 64 + row0;
            v2u mu[4][4]; f32x4 xv[4][4];
#pragma unroll
            for (int rr = 0; rr < 4; ++rr)
#pragma unroll
                for (int j = 0; j < 4; ++j) mu[rr][j] = __builtin_nontemporal_load((const GAS v2u*)(mixed + (tok0 + rr) * D + 4 * lane + 256 * j));
#pragma unroll
            for (int rr = 0; rr < 4; ++rr)
#pragma unroll
                for (int j = 0; j < 4; ++j) xv[rr][j] = __builtin_nontemporal_load((const GAS f32x4*)(in[I_X] + (tok0 + rr) * D + 4 * lane + 256 * j));
            f32x4 g1[4];
#pragma unroll
            for (int j = 0; j < 4; ++j) { const int c = 4 * lane + 256 * j; g1[j] = *(const f32x4*)(mod + b * 6144 + 2048 + c) * *(const f32x4*)(in[I_GPOSTMIX] + c); }
            float ss[4];
#pragma unroll
            for (int rr = 0; rr < 4; ++rr) { float a = 0.f;
#pragma unroll
                for (int j = 0; j < 4; ++j) { const float m0 = __uint_as_float(mu[rr][j].x << 16), m1 = __uint_as_float(mu[rr][j].x & 0xFFFF0000u), m2 = __uint_as_float(mu[rr][j].y << 16), m3 = __uint_as_float(mu[rr][j].y & 0xFFFF0000u);
                    a += (m0 * m0 + m1 * m1) + (m2 * m2 + m3 * m3); }
                ss[rr] = a; }
#pragma unroll
            for (int o = 1; o < 64; o <<= 1) {
#pragma unroll
                for (int rr = 0; rr < 4; ++rr) ss[rr] += __shfl_xor(ss[rr], o); }
#pragma unroll
            for (int rr = 0; rr < 4; ++rr) { const float rm = rsqrtf(ss[rr] * (1.f / D) + EPS); float a = 0.f;
#pragma unroll
                for (int j = 0; j < 4; ++j) { const f32x4 m = (f32x4){__uint_as_float(mu[rr][j].x << 16), __uint_as_float(mu[rr][j].x & 0xFFFF0000u), __uint_as_float(mu[rr][j].y << 16), __uint_as_float(mu[rr][j].y & 0xFFFF0000u)};
                    const f32x4 x1 = xv[rr][j] + g1[j] * (m * rm); xv[rr][j] = x1;
                    if (live) { v2u xb; xb.x = pk2(x1.x, x1.y); xb.y = pk2(x1.z, x1.w); *(GAS v2u*)((bf16*)(F.out + (tok0 + rr) * D) + 4 * lane + 256 * j) = xb; }
                    a += (x1.x * x1.x + x1.y * x1.y) + (x1.z * x1.z + x1.w * x1.w); }
                ss[rr] = a; }
#pragma unroll
            for (int o = 1; o < 64; o <<= 1) {
#pragma unroll
                for (int rr = 0; rr < 4; ++rr) ss[rr] += __shfl_xor(ss[rr], o); }
#pragma unroll
            for (int j = 0; j < 4; ++j) { const int c = 4 * lane + 256 * j;
                const f32x4 gs = *(const f32x4*)(in[I_GPREFFN] + c) * (*(const f32x4*)(mod + b * 6144 + 4096 + c) + 1.0f), sh = *(const f32x4*)(mod + b * 6144 + 3072 + c);
#pragma unroll
                for (int rr = 0; rr < 4; ++rr) { const float r1 = rsqrtf(ss[rr] * (1.f / D) + EPS);
                    const f32x4 h = xv[rr][j] * r1 * gs + sh;
                    v2u hv; hv.x = pkh2(h.x, h.y); hv.y = pkh2(h.z, h.w);
                    int p8 = __builtin_amdgcn_cvt_pk_fp8_f32(h.x * H2_SCALE, h.y * H2_SCALE, 0, false); p8 = __builtin_amdgcn_cvt_pk_fp8_f32(h.z * H2_SCALE, h.w * H2_SCALE, p8, true);
                    if (live) *(GAS unsigned*)(h2g + (tok0 + rr) * D + c) = (unsigned)p8;
                    *(LAS v2u*)(th + p4_swz(row0 + rr, (lane >> 1) + 32 * j) + (lane & 1) * 8) = hv; } }
        }
        __syncthreads();
        float lgv[8];
        {   const int r = lane & 15, kq = lane >> 4;
            f32x4 acc[4][4];
#pragma unroll
            for (int mb = 0; mb < 4; ++mb)
#pragma unroll
                for (int nb = 0; nb < 4; ++nb) acc[mb][nb] = (f32x4){0.f, 0.f, 0.f, 0.f};
#pragma unroll 2
            for (int kk = 0; kk < 4; ++kk) { const int ks = F.wave * 4 + kk;
                f16x8 af[4], bfr[4];
#pragma unroll
                for (int nb = 0; nb < 4; ++nb) bfr[nb] = *(const f16x8*)(wr16 + (size_t)(nb * 16 + r) * D + ks * 32 + kq * 8);
#pragma unroll
                for (int mb = 0; mb < 4; ++mb) af[mb] = *(const LAS f16x8*)(th + p4_swz(mb * 16 + r, ks * 4 + kq));
#pragma unroll
                for (int nb = 0; nb < 4; ++nb)
#pragma unroll
                    for (int mb = 0; mb < 4; ++mb) acc[mb][nb] = __builtin_amdgcn_mfma_f32_16x16x32_f16(af[mb], bfr[nb], acc[mb][nb], 0, 0, 0); }
            LAS float* part = (LAS float*)F.lds + F.wave * 2112;
#pragma unroll
            for (int hh = 0; hh < 2; ++hh) {
                __syncthreads();
#pragma unroll
                for (int m2 = 0; m2 < 2; ++m2)
#pragma unroll
                    for (int nb = 0; nb < 4; ++nb)
#pragma unroll
                        for (int i = 0; i < 4; ++i) part[(m2 * 16 + kq * 4 + i) * 66 + nb * 16 + r] = acc[2 * hh + m2][nb][i];
                if (hh == 0 && F.tid < 64) ((LAS unsigned*)(F.lds + 69632))[F.tid] = 0u;
                __syncthreads();
                if ((F.tid >> 8) == hh) { const LAS float* p0 = (const LAS float*)F.lds + ((F.tid & 255) >> 3) * 66 + (F.tid & 7) * 8;
#pragma unroll
                    for (int j = 0; j < 8; ++j) { float a = 0.f;
#pragma unroll
                        for (int w = 0; w < 8; ++w) a += p0[w * 2112 + j];
                        lgv[j] = a; } }
            }
        }
        int my_e = 0; float my_w = 0.f; unsigned my_pos = 0u;
        const int tk = F.tid >> 3, gl = F.tid & 7; const size_t rtoken = (size_t)tile * 64 + tk;
        LAS unsigned* hist = (LAS unsigned*)(F.lds + 69632); LAS unsigned* basev = hist + 64;
        {
            const int lb = lane & ~7;
            float sc[8], sl[8];
#pragma unroll
            for (int j = 0; j < 8; ++j) { const float x = lgv[j]; const float s = 1.0f / (1.0f + __expf(-x)); sc[j] = s; sl[j] = s + in[I_RBIAS][gl * 8 + j]; }
            float a = -INFINITY, b2 = -INFINITY;
#pragma unroll
            for (int j = 0; j < 8; ++j) { const float v = sl[j]; if (v > a) { b2 = a; a = v; } else if (v > b2) b2 = v; }
            const float gs = a + b2; int rank = 0;
#pragma unroll
            for (int i = 0; i < 8; ++i) { const float og = __shfl(gs, lb + i); rank += (og > gs || (og == gs && i < gl)) ? 1 : 0; }
            if (rank >= 4) {
#pragma unroll
                for (int j = 0; j < 8; ++j) sl[j] = -INFINITY; }
            float wsum = 0.f, my_s = 0.f;
#pragma unroll
            for (int rd = 0; rd < 8; ++rd) {
                float bv = sl[0]; int be = gl * 8;
#pragma unroll
                for (int j = 1; j < 8; ++j) if (sl[j] > bv) { bv = sl[j]; be = gl * 8 + j; }
#pragma unroll
                for (int msk = 1; msk < 8; msk <<= 1) { const float ov = __shfl_xor(bv, msk); const int oe = __shfl_xor(be, msk); if (ov > bv || (ov == bv && oe < be)) { bv = ov; be = oe; } }
                float ws_ = 0.f;
#pragma unroll
                for (int j = 0; j < 8; ++j) if (be == gl * 8 + j) { ws_ = sc[j]; sl[j] = -INFINITY; }
                const float wsc = __shfl(ws_, lb + (be >> 3));
                wsum += wsc; if (gl == rd) { my_e = be; my_s = wsc; }
            }
            my_w = my_s / wsum * 2.5f;
            my_pos = __hip_atomic_fetch_add(hist + my_e, 1u, __ATOMIC_RELAXED, __HIP_MEMORY_SCOPE_WORKGROUP);
        }
        __syncthreads();
        if (F.tid < 64) { const unsigned c = hist[F.tid]; basev[F.tid] = (c && live) ? __hip_atomic_fetch_add(F.ctl + CW_CNT + 64 * F.tid, c, __ATOMIC_RELAXED, __HIP_MEMORY_SCOPE_AGENT) : 0u; }
        __syncthreads();
        if (live) { const unsigned slot = basev[my_e] + my_pos; const unsigned v = (unsigned)my_e;
            ((unsigned*)(ws + WS_LISTS))[(size_t)v * LIST_CAP + slot] = (unsigned)rtoken;
            ((unsigned*)(ws + WS_TOKMAP))[rtoken * 8 + gl] = (v << 16) | slot;
            ((float*)(ws + WS_WTS))[rtoken * 8 + gl] = my_w; }
        __syncthreads();
    }
}
}
namespace mk {
__device__ __forceinline__ void moe_prefix(Frame& F) {
    LAS int* pre = (LAS int*)(F.lds + PRE_OFF);
    __syncthreads();
    if (F.tid < 64) {
        const int c0 = (int)__hip_atomic_load(F.ctl + CW_CNT + 64 * F.tid, RLX_AGENT);
        const int t0 = (c0 + 255) >> 8; int x = t0;
#pragma unroll
        for (int o = 1; o < 64; o <<= 1) { const int y = __shfl_up(x, o); if (F.lane >= o) x += y; }
        pre[F.tid] = x - t0; if (F.tid == 63) pre[64] = x; pre[68 + F.tid] = c0;
    }
    __syncthreads();
}
__device__ __forceinline__ int moe_find_list(const LAS int* pre, int tile) {
    int lo = 0, hi = 64;
    while (hi - lo > 1) { const int mid = (lo + hi) >> 1; if (pre[mid] <= tile) lo = mid; else hi = mid; }
    return lo;
}
__device__ __forceinline__ int moe_tiles(int NTr) { int nt = NTr + T / 256; const long cap = (long)((WS_END - WS_H) / (256 * (256 + 1024))); return nt > cap ? (int)cap : nt; }
__device__ __forceinline__ unsigned char* y_base(Frame& F, int ntl) { return F.ws + WS_H + (size_t)ntl * 256 * 256; }

struct MoeMap { int NTr, ntl; bool chain; };
__device__ __forceinline__ MoeMap moe_map(Frame& F, const LAS int* pre) { MoeMap M; M.NTr = pre[64]; M.ntl = moe_tiles(M.NTr); M.chain = (F.G == 256) && (M.ntl == M.NTr + T / 256); return M; }
__device__ __forceinline__ bool p5_unit(const MoeMap& M, int G, int v, int i, int& tile, int& pn) {
    if (!M.chain) { const int L = i * G + v; if (L >= 2 * M.ntl) return false; tile = L >> 1; pn = L & 1; return true; }
    int r;
    if (v >= 192) { if (i < 2) { tile = M.NTr + (v - 192); pn = i; return true; } r = 576 + (i - 2) * 256 + v; }
    else r = (i < 3) ? i * 192 + v : 576 + (i - 3) * 256 + v;
    if (r >= 2 * M.NTr) return false;
    tile = r >> 1; pn = r & 1; return true;
}
__device__ __forceinline__ bool p6_unit(const MoeMap& M, int G, int v, int i, int& tile, int& pn) {
    const int L = i * G + v;
    if (!M.chain) { if (L >= 4 * M.ntl) return false; tile = L >> 2; pn = L & 3; return true; }
    if (L < 4 * M.NTr) { tile = L >> 2; pn = L & 3; return true; }
    const int sx = L - 4 * M.NTr; if (sx >= 2 * (T / 256)) return false;
    tile = M.NTr + (sx >> 1); pn = 2 + (sx & 1); return true;
}
__device__ __forceinline__ int y_row0(const MoeMap& M, int tile) { return tile < M.NTr ? tile * 256 : (int)((long)(WS_YS - WS_H - (size_t)M.ntl * 256 * 256) / D) + (tile - M.NTr) * 256; }
__device__ __forceinline__ const void* p6_bt(Frame& F, const MoeMap& M, const LAS int* pre, int tile, int pn) {
    if (tile < M.NTr) { const int e = moe_find_list(pre, tile); return F.ws + WS_WD + ((size_t)e * D + (size_t)pn * 256) * 256; }
    return F.ws + WS_WSD + (size_t)pn * 256 * 256;
}

__device__ __forceinline__ void p5(Frame& F) {
    unsigned char* ws = F.ws;
    moe_prefix(F);
    const LAS int* pre = (const LAS int*)(F.lds + PRE_OFF);
    const MoeMap M = moe_map(F, pre); const int NTr = M.NTr;
    const unsigned* lists = (const unsigned*)(ws + WS_LISTS);
    int n = 0;
#pragma unroll
    for (int i = 0; i < MAXU; ++i) { int t_, p_; n += p5_unit(M, F.G, F.vcu, i, t_, p_) ? 1 : 0; }
    unsigned val[MAXU / 2];
#pragma unroll
    for (int sx = 0; sx < MAXU / 2; ++sx) { const int i = 2 * sx + (F.tid >> 8); val[sx] = 0u; int tile, pn;
        if (i < n && p5_unit(M, F.G, F.vcu, i, tile, pn)) {
            if (tile < NTr) { const int e = moe_find_list(pre, tile), r = (tile - pre[e]) * 256 + (F.tid & 255); val[sx] = lists[(size_t)e * LIST_CAP + (r < pre[68 + e] ? r : 0)]; }
            else val[sx] = (unsigned)((tile - NTr) * 256 + (F.tid & 255)); } }
#pragma unroll
    for (int sx = 0; sx < MAXU / 2; ++sx) { const int i = 2 * sx + (F.tid >> 8); if (i < n) ((LAS unsigned*)(F.lds + TAB_OFF + i * 1024))[F.tid & 255] = val[sx]; }
    if (F.tid < n) { const int i = F.tid; int tile, pn; (void)p5_unit(M, F.G, F.vcu, i, tile, pn); const void* Bp;
        if (tile < NTr) { const int e = moe_find_list(pre, tile); Bp = ws + WS_WGU + ((size_t)e * 512 + (size_t)pn * 256) * D; } else Bp = ws + WS_WSGU + (size_t)pn * 256 * D;
        put_unit(F, i, ws + WS_H2, Bp, TAB_OFF + i * 1024, tile * 256, pn * 128); }
    __syncthreads();
    {   pg8::ListSched Sd{(const LAS pg8::UnitRec*)(F.lds + ULIST_OFF), n};
        pg8::EpiSwiglu E{ws + WS_H, 256, 1.0f / (H2_SCALE * WGU_SCALE), HH_SCALE};
        pg8::gemm_phase<pg8::EpiSwiglu, pg8::ListSched, true, pg8::NoHook, true>(F.lds, D / 2, Sd, E, pg8::NoHook{}, F.wave); }
    if (M.chain && F.vcu >= 192) {
        const int tile = NTr + (F.vcu - 192);
        if (F.tid < 2) put_unit(F, F.tid, ws + WS_H + (size_t)tile * 256 * 256, ws + WS_WSD + (size_t)F.tid * 256 * 256, -1, y_row0(M, tile), F.tid * 256);
        __syncthreads();
        pg8::ListSched Sd{(const LAS pg8::UnitRec*)(F.lds + ULIST_OFF), 2};
        pg8::EpiFp8 E{y_base(F, M.ntl), D, true, 16.0f / (HH_SCALE * WD_SCALE)};
        pg8::gemm_phase<pg8::EpiFp8, pg8::ListSched, false, pg8::NoHook, true>(F.lds, 128, Sd, E, pg8::NoHook{}, F.wave); }
    SUBSTAMP(F, 4);
}

template <bool DRY> __device__ __forceinline__ void p6(Frame& F) {
    const bool live = !DRY || (__hip_atomic_load(F.ctl + 3, RLX_AGENT) == 0xdeadbeefu);
    unsigned char* ws = F.ws;
    moe_prefix(F);
    const LAS int* pre = (const LAS int*)(F.lds + PRE_OFF);
    const MoeMap M = moe_map(F, pre);
    unsigned char* Y = y_base(F, M.ntl);
    int n = 0;
#pragma unroll
    for (int i = 0; i < 16; ++i) { int t_, p_; n += p6_unit(M, F.G, F.vcu, i, t_, p_) ? 1 : 0; }
    if (F.tid < n) { int tile, pn; (void)p6_unit(M, F.G, F.vcu, F.tid, tile, pn);
        put_unit(F, F.tid, ws + WS_H + (size_t)tile * 256 * 256, p6_bt(F, M, pre, tile, pn), -1, y_row0(M, tile), pn * 256); }
    __syncthreads();
    pg8::ListSched Sd{(const LAS pg8::UnitRec*)(F.lds + ULIST_OFF), n};
    pg8::EpiFp8 E{Y, D, live, 16.0f / (HH_SCALE * WD_SCALE)};
    pg8::gemm_phase<pg8::EpiFp8, pg8::ListSched, false, pg8::NoHook, true>(F.lds, 128, Sd, E, pg8::NoHook{}, F.wave);
    SUBSTAMP(F, 5);
}

__device__ __forceinline__ void y_acc(f32x4 (&ff)[4], const unsigned char* yr, int lane, float w) {
    const v4u u = *(const GAS v4u*)(yr + 16 * lane);
#pragma unroll
    for (int i = 0; i < 4; ++i) { typedef float f2 __attribute__((ext_vector_type(2)));
        const f2 a = __builtin_amdgcn_cvt_pk_f32_fp8((int)u[i], false), b = __builtin_amdgcn_cvt_pk_f32_fp8((int)u[i], true);
        ff[i] += (f32x4){a.x, a.y, b.x, b.y} * w; }
}
template <bool DRY> __device__ __forceinline__ void p7(Frame& F) {
    const bool live = !DRY || (__hip_atomic_load(F.ctl + 3, RLX_AGENT) == 0xdeadbeefu);
    const float* const* in = F.in; unsigned char* ws = F.ws;
    moe_prefix(F);
    const LAS int* pre = (const LAS int*)(F.lds + PRE_OFF);
    const int NTr = pre[64], ntl = moe_tiles(NTr);
    const unsigned char* Y = y_base(F, ntl);
    const float* mod = (const float*)(ws + WS_MOD);
    const unsigned* tokmap = (const unsigned*)(ws + WS_TOKMAP); const float* wts = (const float*)(ws + WS_WTS);
    const int gw = F.vcu * NWAVES + F.wave, NGW = F.G * NWAVES, lane = F.lane;
    unsigned tmn = 0u; float wvn = 0.f;
    if (gw < T && lane < 8) { tmn = tokmap[(size_t)gw * 8 + lane]; wvn = wts[(size_t)gw * 8 + lane]; }
    for (int token = gw; token < T; token += NGW) {
        const int b = token / S;
        const unsigned tm = tmn; const float wv = wvn;
        if (token + NGW < T && lane < 8) { tmn = tokmap[(size_t)(token + NGW) * 8 + lane]; wvn = wts[(size_t)(token + NGW) * 8 + lane]; }
        f32x4 x1[4];
        { const GAS v4u* xr = (const GAS v4u*)(F.out + (size_t)token * D) + 2 * lane;
          const v4u xa = xr[0], xb = xr[1];
          x1[0] = (f32x4){bf2f(xa.x & 0xFFFFu), bf2f(xa.x >> 16), bf2f(xa.y & 0xFFFFu), bf2f(xa.y >> 16)}; x1[1] = (f32x4){bf2f(xa.z & 0xFFFFu), bf2f(xa.z >> 16), bf2f(xa.w & 0xFFFFu), bf2f(xa.w >> 16)};
          x1[2] = (f32x4){bf2f(xb.x & 0xFFFFu), bf2f(xb.x >> 16), bf2f(xb.y & 0xFFFFu), bf2f(xb.y >> 16)}; x1[3] = (f32x4){bf2f(xb.z & 0xFFFFu), bf2f(xb.z >> 16), bf2f(xb.w & 0xFFFFu), bf2f(xb.w >> 16)}; }
        f32x4 ff[4];
#pragma unroll
        for (int i = 0; i < 4; ++i) ff[i] = (f32x4){0.f, 0.f, 0.f, 0.f};
        y_acc(ff, ws + WS_YS + (size_t)token * D, lane, 1.0f / 16.0f);
#pragma unroll
        for (int k = 0; k < 8; ++k) { const unsigned m = (unsigned)__builtin_amdgcn_readlane((int)tm, k); const float w = __uint_as_float((unsigned)__builtin_amdgcn_readlane((int)__float_as_uint(wv), k));
            const int e = (int)(m >> 16), pos = (int)(m & 0xFFFFu);
            y_acc(ff, Y + ((size_t)pre[e] * 256 + pos) * D, lane, w * (1.0f / 16.0f)); }
        float ss = 0.f;
#pragma unroll
        for (int i = 0; i < 4; ++i) ss += (ff[i].x * ff[i].x + ff[i].y * ff[i].y) + (ff[i].z * ff[i].z + ff[i].w * ff[i].w);
        const float rstd = rsqrtf(wave_sum(ss) * (1.f / D) + EPS);
#pragma unroll
        for (int i = 0; i < 4; ++i) { const int c = 16 * lane + 4 * i;
            const f32x4 gt = *(const f32x4*)(mod + b * 6144 + 5120 + c), gp = *(const f32x4*)(in[I_GPOSTFFN] + c);
            if (live) { if (MK_WT & 32) pg8::st16_wt((void*)(F.out + (size_t)token * D + c), x1[i] + gt * (ff[i] * rstd) * gp); else *(GAS f32x4*)(F.out + (size_t)token * D + c) = x1[i] + gt * (ff[i] * rstd) * gp; } }
    }
}
}
namespace mk {
#ifndef MK_NPHASES_DONE
#define MK_NPHASES_DONE 3
#endif
constexpr int PH_P0A = 0, PH_P1 = 1, PH_P2 = 2, PH_P3 = 3, PH_P4 = 4, PH_P5 = 5, PH_P6 = 6, PH_P7 = 7, N_PHASES = 8;

__global__ void __launch_bounds__(NTHR, 2) mk_fwd(Args a) {
    extern __shared__ __attribute__((aligned(16))) unsigned char lds_[];
    Frame F;
    F.lds = (LAS unsigned char*)lds_; F.ws = a.ws; F.ctl = (unsigned*)(a.ws + WS_CTL); F.in = a.in; F.out = a.out;
    F.tid = threadIdx.x; F.lane = F.tid & 63; F.wave = __builtin_amdgcn_readfirstlane(F.tid >> 6);
    F.G = gridDim.x; { const int bx = blockIdx.x; F.vcu = (F.G % 8 == 0) ? (bx % 8) * (F.G / 8) + bx / 8 : bx; }
    for (int u = F.tid; u < 128; u += NTHR) ((LAS unsigned*)(F.lds + LDSCTL_OFF))[u] = 0u;
    __syncthreads();
    const int lo = a.ph_lo, hi = a.ph_hi;
    const bool multi = (hi - lo) > 1;
    XcdBarrier bar; bar.bar = F.ctl + CW_BAR; bar.x = 0; bar.st = nullptr;
    if (multi) bar = xcd_barrier_post(F.ctl + CW_BAR, (volatile LAS unsigned*)(F.lds + MISC_OFF) + 8);
#define IN(k) (lo <= (k) && (k) < hi)
#ifdef MK_PROBE_A
#define STAMP(k) do { if (blockIdx.x == MK_PROBE_BLK && F.tid == 0) ((unsigned long long*)(F.ctl + 512))[(k)] = __builtin_amdgcn_s_memrealtime(); } while (0)
#else
#define STAMP(k) do { } while (0)
#endif
#ifdef MK_DBLBAR
#define SEAM(k) do { if (IN(k) && IN((k) + 1)) { xcd_barrier(bar, F.wave); xcd_barrier(bar, F.wave); } STAMP((k) + 1); } while (0)
#else
#define SEAM(k) do { if (IN(k) && IN((k) + 1)) xcd_barrier(bar, F.wave); STAMP((k) + 1); } while (0)
#endif
    STAMP(0);
#ifndef MK_DBL
#define MK_DBL 0
#endif
#define DBL(k) (((MK_DBL) >> (k)) & 1)
#define REFRESH() do { int l_; asm volatile("v_mbcnt_lo_u32_b32 %0, -1, 0\n\tv_mbcnt_hi_u32_b32 %0, -1, %0" : "=v"(l_)); F.lane = l_; F.tid = F.wave * 64 + l_; } while (0)
#define RUN(k, call, drycall) do { if (IN(k)) { if (DBL(k)) { REFRESH(); drycall; if (multi) xcd_barrier(bar, F.wave); } REFRESH(); call; } SEAM(k); } while (0)
    RUN(PH_P0A, (p0a(F), p0b(F)), (p0a(F), p0b(F)));
    RUN(PH_P1, p1(F), p1(F));
#if MK_NPHASES_DONE > 3
    RUN(PH_P2, p2(F), p2(F));
#endif
#if MK_NPHASES_DONE > 4
    RUN(PH_P3, p3(F), p3(F));
#endif
#if MK_NPHASES_DONE > 5
    RUN(PH_P4, p4<false>(F), p4<true>(F));
#endif
#if MK_NPHASES_DONE > 6
    RUN(PH_P5, p5(F), p5(F));
#endif
#if MK_NPHASES_DONE > 7
    RUN(PH_P6, p6<false>(F), p6<true>(F));
    if (IN(PH_P7)) { if (DBL(PH_P7)) { REFRESH(); p7<true>(F); if (multi) xcd_barrier(bar, F.wave); } REFRESH(); p7<false>(F); }
#endif
#ifdef MK_PROBE_A
    if (multi) { xcd_barrier(bar, F.wave); STAMP(N_PHASES); xcd_barrier(bar, F.wave);
        const unsigned long long* ts = (const unsigned long long*)(F.ctl + 512);
        const float ta = (float)(__hip_atomic_load(ts + MK_PROBE_A1, RLX_AGENT) - __hip_atomic_load(ts + MK_PROBE_A, RLX_AGENT)) * 0.01f, tb = (float)(__hip_atomic_load(ts + MK_PROBE_B1, RLX_AGENT) - __hip_atomic_load(ts + MK_PROBE_B, RLX_AGENT)) * 0.01f;
        const float dl = sqrtf(1.5e-5f * ta);
        REFRESH();
        for (size_t i = (size_t)blockIdx.x * NTHR + F.tid; i < (size_t)T * D; i += (size_t)F.G * NTHR) F.out[i] += dl + (i == 0 ? 10.0f + tb : 0.f); }
#endif
#undef RUN
#undef REFRESH
#undef DBL
#undef IN
#undef SEAM
}

static int g_grid = 0;
static bool setup_once() {
    if (g_grid == 0) {
        int dev = 0, cus = 0;
        if (hipGetDevice(&dev) != hipSuccess || hipDeviceGetAttribute(&cus, hipDeviceAttributeMultiprocessorCount, dev) != hipSuccess) { g_grid = -1; return false; }
        if (hipFuncSetAttribute((const void*)mk_fwd, hipFuncAttributeMaxDynamicSharedMemorySize, LDS_BYTES) != hipSuccess) { g_grid = -1; return false; }
        (void)hipGetLastError();
        g_grid = cus;
    }
    return g_grid > 0;
}
static void launch_phases(void* const* d_in, void* d_out, void* d_ws, hipStream_t stream, int lo, int hi) {
    Args a{};
    for (int i = 0; i < N_IN; ++i) a.in[i] = (const float*)d_in[i];
    a.out = (float*)d_out; a.ws = (unsigned char*)d_ws; a.ph_lo = lo; a.ph_hi = hi;
    hipLaunchKernelGGL(mk_fwd, dim3(g_grid), dim3(NTHR), LDS_BYTES, stream, a);
}
}
extern "C" void kernel_launch(void* const* d_in, const int* in_sizes, int n_in, void* d_out, int out_size, void* d_ws, size_t ws_size, hipStream_t stream) {
    if (!mk::setup_once()) return;
    if (ws_size < mk::WS_END) return;
    hipMemsetAsync(d_ws, 0, mk::CTL_ZERO_BYTES, stream);
    mk::launch_phases(d_in, d_out, d_ws, stream, 0, mk::N_PHASES);
}
```
